# Optimizing an MI355X kernel written in HIP

```python
import jax, jax.numpy as jnp
from jax import lax
import numpy as np

D_MODEL = 1024
BATCH = 1
SEQ = 16384
DEPTH = 2
DEC_BATCH = 32
DEC_SEQ = 8
PAST_LEN = 16384
PAGE_SIZE = 128

LRU_WIDTH = D_MODEL // 2
LRU_BLOCKS = 8
LRU_BD = LRU_WIDTH // LRU_BLOCKS
CONV_W = 4
LRU_C = 8.0
HG_HEADS = 4
HG_DK = 128
HG_DV = 128
HG_WIDTH = HG_HEADS * HG_DK
HG_CHUNK = 64
DIL_GROUPS = ((128, 1), (512, 4), (2048, 16))
N_GROUPS = 3
DIL_HPG = 4
DIL_DH = 64
DIL_HEADS = N_GROUPS * DIL_HPG
DIL_WIDTH = DIL_HEADS * DIL_DH
DIL_OUT = DIL_HPG * DIL_DH
DIL_QB = 128
N_BRANCH = 3
D_FF = 4 * D_MODEL
EPS = 1e-6
NEG = -1e30
SPLIT_SIZES = (LRU_WIDTH,) + (HG_WIDTH,) * 4 + (DIL_WIDTH,) * 3 + (N_BRANCH * D_MODEL,)
N_IN = sum(SPLIT_SIZES)
F32 = jnp.float32

kernel_name = 'hybrid_rglru_hgrn2_dilated_decode_step'


def _rmsnorm(x, g):
    xf = x.astype(F32)
    y = xf * lax.rsqrt(jnp.mean(xf * xf, axis=-1, keepdims=True) + EPS)
    return (y * g.astype(F32)).astype(x.dtype)


def _masked_softmax(s, valid):
    s = jnp.where(valid, s, NEG)
    m = jnp.max(s, axis=-1, keepdims=True)
    p = jnp.where(valid, jnp.exp(s - m), 0.0)
    l = jnp.sum(p, axis=-1, keepdims=True)
    return p / l, (m + jnp.log(l))[..., 0]


def _lin_comb(left, right):
    a1, b1 = left
    a2, b2 = right
    return a1 * a2, a2 * b1 + b2


def _rglru(u, conv_st, h0, pos0, conv_w, conv_b, wr, br, wi, bi, lam):
    bsz, t_len, width = u.shape
    ext = jnp.concatenate([conv_st.astype(u.dtype), u], axis=1)
    xc = conv_b + sum(ext[:, j:j + t_len] * conv_w[j] for j in range(CONV_W))
    conv_new = ext[:, t_len:]
    xf = xc.astype(F32)
    xb = xf.reshape(bsz, t_len, LRU_BLOCKS, LRU_BD)
    r = jax.nn.sigmoid(jnp.einsum('btnd,nde->btne', xb, wr.astype(F32)).reshape(bsz, t_len, width) + br.astype(F32))
    i = jax.nn.sigmoid(jnp.einsum('btnd,nde->btne', xb, wi.astype(F32)).reshape(bsz, t_len, width) + bi.astype(F32))
    log_a = -LRU_C * r * jax.nn.softplus(-lam.astype(F32))
    pos = pos0 + jnp.arange(t_len)
    mult = jnp.where((pos == 0)[None, :, None], 1.0, jnp.sqrt(-jnp.expm1(2.0 * log_a)))
    a_cum, b_cum = lax.associative_scan(_lin_comb, (jnp.exp(log_a), mult * i * xf), axis=1)
    hs = b_cum + a_cum * h0.astype(F32)[:, None]
    return hs.astype(u.dtype), conv_new, hs[:, -1].astype(h0.dtype)


def _chunk_gated_scan(q, k, v, log_f, s0):
    bsz, t_len, nh, dk = q.shape
    dv = v.shape[-1]
    c = min(HG_CHUNK, t_len)
    n = -(-t_len // c)
    pad = n * c - t_len

    def to_chunks(z):
        z = jnp.pad(z, ((0, 0), (0, pad), (0, 0), (0, 0)))
        return z.reshape(bsz, n, c, nh, z.shape[-1]).swapaxes(0, 1)

    causal = jnp.tril(jnp.ones((c, c), dtype=bool))[None, :, :, None, None]

    def step(state, blk):
        qc, kc, vc, gc = blk
        b = jnp.cumsum(gc, axis=1)
        diff = b[:, :, None] - b[:, None, :]
        decay = jnp.where(causal, jnp.exp(jnp.where(causal, diff, 0.0)), 0.0)
        attn = jnp.einsum('bthd,btshd,bshd->bhts', qc, decay, kc)
        o = jnp.einsum('bhts,bshv->bthv', attn, vc) + jnp.einsum('bthd,bhdv->bthv', qc * jnp.exp(b), state)
        b_last = b[:, -1]
        state = jnp.exp(b_last)[..., None] * state + jnp.einsum('bshd,bshv->bhdv', kc * jnp.exp(b_last[:, None] - b), vc)
        return state, o

    s_fin, o = lax.scan(step, s0, (to_chunks(q), to_chunks(k), to_chunks(v), to_chunks(log_f)))
    o = o.swapaxes(0, 1).reshape(bsz, n * c, nh, dv)[:, :t_len]
    return o, s_fin


def _hgrn2(q_raw, f_raw, i_raw, g_raw, s0, lb, norm_g):
    bsz, t_len, _ = q_raw.shape
    shp = (bsz, t_len, HG_HEADS, HG_DK)
    q = jax.nn.silu(q_raw.astype(F32)).reshape(shp)
    zf = f_raw.astype(F32)
    lbf = lb.astype(F32)
    log_f = jnp.log(lbf + (1.0 - lbf) * jax.nn.sigmoid(zf)).reshape(shp)
    k = ((1.0 - lbf) * jax.nn.sigmoid(-zf)).reshape(shp)
    v = i_raw.astype(F32).reshape(bsz, t_len, HG_HEADS, HG_DV)
    o, s_fin = _chunk_gated_scan(q, k, v, log_f, s0.astype(F32))
    o = o * lax.rsqrt(jnp.mean(o * o, axis=-1, keepdims=True) + EPS) * norm_g.astype(F32)
    o = o.reshape(bsz, t_len, HG_WIDTH) * jax.nn.silu(g_raw.astype(F32))
    return o.astype(q_raw.dtype), s_fin.astype(s0.dtype)


def _dilated_prompt(q, k, v, window, dil):
    bsz, s_len, nh, dh = q.shape
    reach = window // dil
    span = dil * DIL_QB
    s_pad = -(-s_len // span) * span
    m_len = s_pad // dil
    nb = m_len // DIL_QB

    def to_sub(z):
        z = jnp.pad(z.astype(F32), ((0, 0), (0, s_pad - s_len), (0, 0), (0, 0)))
        z = z.reshape(bsz, m_len, dil, nh, dh).transpose(0, 2, 1, 3, 4)
        return z.reshape(bsz, dil, nb, DIL_QB, nh, dh)

    def with_prev(z):
        prev = jnp.concatenate([jnp.zeros_like(z[:, :, :1]), z[:, :, :-1]], axis=2)
        return jnp.concatenate([prev, z], axis=3)

    qs = to_sub(q)
    kk = with_prev(to_sub(k))
    vv = with_prev(to_sub(v))
    s = jnp.einsum('brnqhd,brnkhd->brnhqk', qs, kk)
    qi = jnp.arange(DIL_QB)[:, None]
    kj = jnp.arange(2 * DIL_QB)[None, :] - DIL_QB
    dist = qi - kj
    blk = jnp.arange(nb)[:, None, None] * DIL_QB
    valid = (dist >= 0) & (dist <= reach) & (blk + kj >= 0)
    p, lse = _masked_softmax(s, valid[None, None, :, None])
    o = jnp.einsum('brnhqk,brnkhd->brnqhd', p, vv)
    o = o.reshape(bsz, dil, m_len, nh, dh).transpose(0, 2, 1, 3, 4).reshape(bsz, s_pad, nh, dh)
    lse = lse.transpose(0, 1, 2, 4, 3).reshape(bsz, dil, m_len, nh).transpose(0, 2, 1, 3).reshape(bsz, s_pad, nh)
    return o[:, :s_len], lse[:, :s_len]


def _dilated_decode(q, k, v, buf, window, dil):
    t_len = q.shape[1]
    w_len = buf.shape[1]
    kc = jnp.concatenate([buf[:, :, 0], k.astype(buf.dtype)], axis=1)
    vc = jnp.concatenate([buf[:, :, 1], v.astype(buf.dtype)], axis=1)
    n_keys = window // dil + 1
    idx = w_len + jnp.arange(t_len)[:, None] - dil * jnp.arange(n_keys)[None, :]
    valid = idx >= 0
    idx = jnp.maximum(idx, 0)
    kg = kc[:, idx].astype(F32)
    vg = vc[:, idx].astype(F32)
    s = jnp.einsum('bthd,btkhd->bthk', q, kg)
    p, lse = _masked_softmax(s, valid[None, :, None, :])
    o = jnp.einsum('bthk,btkhd->bthd', p, vg)
    new_buf = jnp.stack([kc, vc], axis=2)[:, t_len:]
    return o, lse, new_buf


def _dilated(q_c, k_c, v_c, bufs):
    bsz, t_len, _ = q_c.shape
    shp = (bsz, t_len, DIL_HEADS, DIL_DH)
    q = q_c.astype(F32).reshape(shp) * (DIL_DH ** -0.5)
    k = k_c.reshape(shp)
    v = v_c.reshape(shp)
    outs, lses, new_bufs = [], [], []
    for g, (window, dil) in enumerate(DIL_GROUPS):
        sl = slice(g * DIL_HPG, (g + 1) * DIL_HPG)
        if bufs is None:
            o, lse = _dilated_prompt(q[:, :, sl], k[:, :, sl], v[:, :, sl], window, dil)
            kv = jnp.stack([k[:, :, sl], v[:, :, sl]], axis=2)
            new_bufs.append(kv[:, t_len - min(window, t_len):])
        else:
            o, lse, nbuf = _dilated_decode(q[:, :, sl], k[:, :, sl], v[:, :, sl], bufs[g], window, dil)
            new_bufs.append(nbuf)
        outs.append(o)
        lses.append(lse)
    w = jax.nn.softmax(jnp.stack(lses, axis=0), axis=0)
    o = jnp.sum(w[..., None] * jnp.stack(outs, axis=0), axis=0)
    return o.reshape(bsz, t_len, DIL_OUT).astype(q_c.dtype), tuple(new_bufs)


def _layer(x, pos0, conv_st, lru_st, hg_st, bufs, lb, lw):
    (n_mix_pre, n_mix_post, n_mlp_pre, n_mlp_post, w_in, b_gate, conv_w, conv_b, lru_wr, lru_br,
     lru_wi, lru_bi, lru_lambda, hg_norm, w_br_a, w_br_b, w_br_c, w_out, w_up, w_down) = lw
    bsz, t_len, _ = x.shape
    h = _rmsnorm(x, n_mix_pre)
    z = h @ w_in
    cuts, acc = [], 0
    for size in SPLIT_SIZES[:-1]:
        acc += size
        cuts.append(acc)
    u_a, q_b, f_b, i_b, g_b, q_c, k_c, v_c, gate_pre = jnp.split(z, cuts, axis=-1)
    y_a, conv_new, lru_new = _rglru(u_a, conv_st, lru_st, pos0, conv_w, conv_b, lru_wr, lru_br, lru_wi, lru_bi, lru_lambda)
    y_b, hg_new = _hgrn2(q_b, f_b, i_b, g_b, hg_st, lb, hg_norm)
    y_c, bufs_new = _dilated(q_c, k_c, v_c, bufs)
    gates = jax.nn.sigmoid((gate_pre + b_gate).astype(F32)).astype(x.dtype).reshape(bsz, t_len, N_BRANCH, D_MODEL)
    mixed = gates[:, :, 0] * (y_a @ w_br_a) + gates[:, :, 1] * (y_b @ w_br_b) + gates[:, :, 2] * (y_c @ w_br_c)
    x = x + _rmsnorm(mixed @ w_out, n_mix_post)
    hm = _rmsnorm(x, n_mlp_pre)
    x = x + _rmsnorm(jnp.square(jax.nn.relu(hm @ w_up)) @ w_down, n_mlp_post)
    return x, conv_new, lru_new, hg_new, bufs_new


def setup_inputs(seed: int = 0) -> dict:
    key = jax.random.key(seed)
    keys = jax.random.split(key, 40)
    counter = [0]

    def nxt():
        counter[0] += 1
        return keys[counter[0] - 1]

    def nrm(shape, scale):
        return jax.random.normal(nxt(), shape, jnp.float32) * scale

    def gain(shape):
        return 1.0 + nrm(shape, 0.02)

    wc = [min(w, PAST_LEN) for w, _ in DIL_GROUPS]
    x_prompt = nrm((BATCH, SEQ, D_MODEL), 1.0)
    x_sample = nrm((DEC_BATCH, DEC_SEQ, D_MODEL), 1.0)
    state_conv = nrm((DEPTH, DEC_BATCH, CONV_W - 1, LRU_WIDTH), 1.0)
    state_lru = nrm((DEPTH, DEC_BATCH, LRU_WIDTH), 0.5)
    state_hgrn = nrm((DEPTH, DEC_BATCH, HG_HEADS, HG_DK, HG_DV), 0.3)
    cache_win128 = nrm((DEPTH, DEC_BATCH, wc[0], 2, DIL_HPG, DIL_DH), 1.0)
    cache_win512 = nrm((DEPTH, DEC_BATCH, wc[1], 2, DIL_HPG, DIL_DH), 1.0)
    cache_win2048 = nrm((DEPTH, DEC_BATCH, wc[2], 2, DIL_HPG, DIL_DH), 1.0)
    norm_mix_pre = gain((DEPTH, D_MODEL))
    norm_mix_post = gain((DEPTH, D_MODEL))
    norm_mlp_pre = gain((DEPTH, D_MODEL))
    norm_mlp_post = gain((DEPTH, D_MODEL))
    w_in = nrm((DEPTH, D_MODEL, N_IN), D_MODEL ** -0.5)
    b_gate = nrm((DEPTH, N_BRANCH * D_MODEL), 0.01)
    conv_w = nrm((DEPTH, CONV_W, LRU_WIDTH), CONV_W ** -0.5)
    conv_b = nrm((DEPTH, LRU_WIDTH), 0.01)
    lru_wr = nrm((DEPTH, LRU_BLOCKS, LRU_BD, LRU_BD), LRU_BD ** -0.5)
    lru_br = nrm((DEPTH, LRU_WIDTH), 0.01)
    lru_wi = nrm((DEPTH, LRU_BLOCKS, LRU_BD, LRU_BD), LRU_BD ** -0.5)
    lru_bi = nrm((DEPTH, LRU_WIDTH), 0.01)
    a0 = jax.random.uniform(nxt(), (DEPTH, LRU_WIDTH), jnp.float32, 0.9, 0.999)
    s_a = a0 ** (1.0 / LRU_C)
    lru_lambda = jnp.log(s_a) - jnp.log1p(-s_a)
    hgrn_lb_raw = nrm((DEPTH, HG_WIDTH), 0.5)
    hgrn_norm = gain((DEPTH, HG_DV))
    w_br_a = nrm((DEPTH, LRU_WIDTH, D_MODEL), LRU_WIDTH ** -0.5)
    w_br_b = nrm((DEPTH, HG_WIDTH, D_MODEL), HG_WIDTH ** -0.5)
    w_br_c = nrm((DEPTH, DIL_OUT, D_MODEL), DIL_OUT ** -0.5)
    w_out = nrm((DEPTH, D_MODEL, D_MODEL), D_MODEL ** -0.5)
    w_mlp_up = nrm((DEPTH, D_MODEL, D_FF), D_MODEL ** -0.5)
    w_mlp_down = nrm((DEPTH, D_FF, D_MODEL), D_FF ** -0.5)
    return {'x_prompt': x_prompt, 'x_sample': x_sample, 'state_conv': state_conv, 'state_lru': state_lru,
            'state_hgrn': state_hgrn, 'cache_win128': cache_win128, 'cache_win512': cache_win512,
            'cache_win2048': cache_win2048, 'norm_mix_pre': norm_mix_pre, 'norm_mix_post': norm_mix_post,
            'norm_mlp_pre': norm_mlp_pre, 'norm_mlp_post': norm_mlp_post, 'w_in': w_in, 'b_gate': b_gate,
            'conv_w': conv_w, 'conv_b': conv_b, 'lru_wr': lru_wr, 'lru_br': lru_br, 'lru_wi': lru_wi,
            'lru_bi': lru_bi, 'lru_lambda': lru_lambda, 'hgrn_lb_raw': hgrn_lb_raw, 'hgrn_norm': hgrn_norm,
            'w_br_a': w_br_a, 'w_br_b': w_br_b, 'w_br_c': w_br_c, 'w_out': w_out,
            'w_mlp_up': w_mlp_up, 'w_mlp_down': w_mlp_down}


def reference(x_prompt, x_sample, state_conv, state_lru, state_hgrn, cache_win128, cache_win512, cache_win2048,
              norm_mix_pre, norm_mix_post, norm_mlp_pre, norm_mlp_post, w_in, b_gate, conv_w, conv_b,
              lru_wr, lru_br, lru_wi, lru_bi, lru_lambda, hgrn_lb_raw, hgrn_norm, w_br_a, w_br_b, w_br_c,
              w_out, w_mlp_up, w_mlp_down):
    lb_soft = jax.nn.softmax(hgrn_lb_raw.astype(F32), axis=0)
    lb_all = jnp.cumsum(lb_soft, axis=0) - lb_soft[0]
    bp = x_prompt.shape[0]
    dt = x_prompt.dtype
    yp, ys = x_prompt, x_sample
    new_p = [[] for _ in range(6)]
    new_s = [[] for _ in range(6)]
    for l in range(DEPTH):
        lw = (norm_mix_pre[l], norm_mix_post[l], norm_mlp_pre[l], norm_mlp_post[l], w_in[l], b_gate[l],
              conv_w[l], conv_b[l], lru_wr[l], lru_br[l], lru_wi[l], lru_bi[l], lru_lambda[l], hgrn_norm[l],
              w_br_a[l], w_br_b[l], w_br_c[l], w_out[l], w_mlp_up[l], w_mlp_down[l])
        yp, c_p, h_p, s_p, b_p = _layer(
            yp, 0,
            jnp.zeros((bp, CONV_W - 1, LRU_WIDTH), dt),
            jnp.zeros((bp, LRU_WIDTH), dt),
            jnp.zeros((bp, HG_HEADS, HG_DK, HG_DV), dt),
            None, lb_all[l], lw)
        ys, c_s, h_s, s_s, b_s = _layer(
            ys, PAST_LEN, state_conv[l], state_lru[l], state_hgrn[l],
            (cache_win128[l], cache_win512[l], cache_win2048[l]), lb_all[l], lw)
        for lst, val in zip(new_p, (c_p, h_p, s_p) + b_p):
            lst.append(val)
        for lst, val in zip(new_s, (c_s, h_s, s_s) + b_s):
            lst.append(val)
    conv_p, lru_p, hgrn_p, win128_p, win512_p, win2048_p = [jnp.stack(v, axis=0) for v in new_p]
    conv_s, lru_s, hgrn_s, win128_s, win512_s, win2048_s = [jnp.stack(v, axis=0) for v in new_s]
    return (yp, ys, conv_p, conv_s, lru_p, lru_s, hgrn_p, hgrn_s,
            win128_p, win128_s, win512_p, win512_s, win2048_p, win2048_s)
```

```cpp
#include <hip/hip_runtime.h>
#include <stdint.h>

typedef unsigned short bf16_t;
#define DEV __device__ __forceinline__

DEV float bf2f(bf16_t b) { return __uint_as_float(((unsigned)b) << 16); }
DEV bf16_t f2bf(float f) { unsigned u = __float_as_uint(f); u += 0x7fffu + ((u >> 16) & 1u); return (bf16_t)(u >> 16); }
DEV float sigmoidf_(float x) { return 1.f / (1.f + expf(-x)); }
DEV float wave_sum(float v) {
#pragma unroll
    for (int o = 1; o < 64; o <<= 1) v += __shfl_xor(v, o);
    return v;
}
DEV float wave_max(float v) {
#pragma unroll
    for (int o = 1; o < 64; o <<= 1) v = fmaxf(v, __shfl_xor(v, o));
    return v;
}

constexpr int MP = 16384, MS = 256, MT = MP + MS;
constexpr int DM = 1024, NIN = 7936, DFF = 4096, YK = 1280;
constexpr int ZC_UA = 0, ZC_QB = 512, ZC_FB = 1024, ZC_IB = 1536, ZC_GB = 2048, ZC_QC = 2560, ZC_KC = 3328, ZC_VC = 4096, ZC_GATE = 4864;
constexpr int NB = 32, NT = 8;
constexpr size_t O_Y = 0, O_CONVP = 17039360, O_CONVS = 17042432, O_LRUP = 17140736, O_LRUS = 17141760, O_HGP = 17174528, O_HGS = 17305600,
                 O_W128P = 21499904, O_W128S = 21630976, O_W512P = 25825280, O_W512S = 26349568, O_W2048P = 43126784, O_W2048S = 45223936;
constexpr size_t MiB = 1u << 20;
constexpr size_t WS_W = 1 * MiB, WS_WL = 40 * MiB;
constexpr size_t W_IN = 0, W_BR = 16 * MiB, W_OUT = 19 * MiB, W_UP = 21 * MiB, W_DN = 29 * MiB;
constexpr size_t WS_XN = 82 * MiB, WS_Z = 116 * MiB, WS_Y = 368 * MiB, WS_MIX = 409 * MiB, WS_OB = 442 * MiB, WS_X1 = 475 * MiB, WS_X2 = 540 * MiB,
                 WS_HID = 605 * MiB, WS_XC = 735 * MiB, WS_LA = 768 * MiB, WS_LB = 801 * MiB, WS_HRAW = 834 * MiB;

__global__ void __launch_bounds__(256) k_wt(const float* __restrict__ src, int K, int N, bf16_t* __restrict__ dst, int P, int koff, const float* __restrict__ scale) {
    __shared__ float t[32][33];
    const int n0 = blockIdx.x * 32, k0 = blockIdx.y * 32, tx = threadIdx.x & 31, ty = threadIdx.x >> 5;
    for (int i = ty; i < 32; i += 8) t[i][tx] = src[(size_t)(k0 + i) * N + n0 + tx] * (scale ? scale[k0 + i] : 1.f);
    __syncthreads();
    for (int i = ty; i < 32; i += 8) dst[(size_t)(n0 + i) * P + koff + k0 + tx] = f2bf(t[tx][i]);
}

__global__ void __launch_bounds__(256) k_xn(const float* __restrict__ xp, const float* __restrict__ xs, bf16_t* __restrict__ XN) {
    const int row = blockIdx.x * 4 + (threadIdx.x >> 6), lane = threadIdx.x & 63;
    if (row >= MT) return;
    const float* x = row < MP ? xp + (size_t)row * DM : xs + (size_t)(row - MP) * DM;
    float v[16]; float s = 0.f;
#pragma unroll
    for (int j = 0; j < 16; ++j) { v[j] = x[lane + 64 * j]; s += v[j] * v[j]; }
    s = wave_sum(s);
    const float rinv = rsqrtf(s * (1.f / DM) + 1e-6f);
#pragma unroll
    for (int j = 0; j < 16; ++j) XN[(size_t)row * DM + lane + 64 * j] = f2bf(v[j] * rinv);
}

__global__ void __launch_bounds__(256) k_elt(const float* __restrict__ xp, const float* __restrict__ xs, const bf16_t* __restrict__ O, const float* __restrict__ g,
                                             float* __restrict__ xout, bf16_t* __restrict__ XN) {
    const int row = blockIdx.x * 4 + (threadIdx.x >> 6), lane = threadIdx.x & 63;
    if (row >= MT) return;
    const float* x = row < MP ? xp + (size_t)row * DM : xs + (size_t)(row - MP) * DM;
    float o[16], v[16]; float s = 0.f;
#pragma unroll
    for (int j = 0; j < 16; ++j) { o[j] = bf2f(O[(size_t)row * DM + lane + 64 * j]); s += o[j] * o[j]; }
    s = wave_sum(s);
    const float rinv = rsqrtf(s * (1.f / DM) + 1e-6f);
    float s2 = 0.f;
#pragma unroll
    for (int j = 0; j < 16; ++j) { v[j] = x[lane + 64 * j] + o[j] * rinv * g[lane + 64 * j]; s2 += v[j] * v[j]; }
    s2 = wave_sum(s2);
    const float rinv2 = rsqrtf(s2 * (1.f / DM) + 1e-6f);
#pragma unroll
    for (int j = 0; j < 16; ++j) { xout[(size_t)row * DM + lane + 64 * j] = v[j]; XN[(size_t)row * DM + lane + 64 * j] = f2bf(v[j] * rinv2); }
}

struct EpiZ {
    bf16_t* Z; const float* bgate;
    DEV void operator()(int m, int n, float v) const {
        float r = v;
        if (n >= ZC_GATE) r = sigmoidf_(v + bgate[n - ZC_GATE]);
        else if ((n >= ZC_QB && n < ZC_FB) || (n >= ZC_GB && n < ZC_QC)) r = v * sigmoidf_(v);
        else if (n >= ZC_QC && n < ZC_KC) r = v * 0.125f;
        Z[(size_t)m * NIN + n] = f2bf(r);
    }
};
struct EpiBf {
    bf16_t* O; int N;
    DEV void operator()(int m, int n, float v) const { O[(size_t)m * N + n] = f2bf(v); }
};
struct EpiRelu2 {
    bf16_t* O; int N;
    DEV void operator()(int m, int n, float v) const { float r = fmaxf(v, 0.f); O[(size_t)m * N + n] = f2bf(r * r); }
};
template <class Epi, bool GATED>
__global__ void __launch_bounds__(256) k_gemm(const bf16_t* __restrict__ A, const bf16_t* __restrict__ Bt, int M, int N, int K, Epi E, const bf16_t* __restrict__ Zg) {
    __shared__ float sA[32][65], sB[32][65];
    const int tx = threadIdx.x & 15, ty = threadIdx.x >> 4, m0 = blockIdx.y * 64, n0 = blockIdx.x * 64;
    float acc[4][4], tot[4][4];
#pragma unroll
    for (int i = 0; i < 4; ++i)
#pragma unroll
        for (int j = 0; j < 4; ++j) { acc[i][j] = 0.f; tot[i][j] = 0.f; }
    for (int k0 = 0; k0 < K; k0 += 32) {
        if (GATED && (k0 == 512 || k0 == 1024)) {
            const int seg = k0 == 512 ? 0 : 1;
#pragma unroll
            for (int i = 0; i < 4; ++i)
#pragma unroll
                for (int j = 0; j < 4; ++j) { tot[i][j] += acc[i][j] * bf2f(Zg[(size_t)(m0 + ty * 4 + i) * NIN + ZC_GATE + seg * 1024 + n0 + tx * 4 + j]); acc[i][j] = 0.f; }
        }
        for (int i = threadIdx.x; i < 2048; i += 256) { const int r = i >> 5, c = i & 31;
            sA[c][r] = bf2f(A[(size_t)(m0 + r) * K + k0 + c]); sB[c][r] = bf2f(Bt[(size_t)(n0 + r) * K + k0 + c]); }
        __syncthreads();
#pragma unroll 8
        for (int kk = 0; kk < 32; ++kk) {
            float a[4], b[4];
#pragma unroll
            for (int i = 0; i < 4; ++i) { a[i] = sA[kk][ty * 4 + i]; b[i] = sB[kk][tx * 4 + i]; }
#pragma unroll
            for (int i = 0; i < 4; ++i)
#pragma unroll
                for (int j = 0; j < 4; ++j) acc[i][j] += a[i] * b[j];
        }
        __syncthreads();
    }
#pragma unroll
    for (int i = 0; i < 4; ++i)
#pragma unroll
        for (int j = 0; j < 4; ++j) {
            const int m = m0 + ty * 4 + i, n = n0 + tx * 4 + j;
            float v = acc[i][j];
            if (GATED) v = tot[i][j] + v * bf2f(Zg[(size_t)m * NIN + ZC_GATE + 2 * 1024 + n]);
            E(m, n, v);
        }
}

__global__ void __launch_bounds__(256) k_conv(const bf16_t* __restrict__ Z, const float* __restrict__ st_conv  , const float* __restrict__ cw  ,
                                              const float* __restrict__ cb, float* __restrict__ XC) {
    const size_t idx = (size_t)blockIdx.x * 256 + threadIdx.x;
    if (idx >= (size_t)MT * 512) return;
    const int row = (int)(idx >> 9), c = (int)(idx & 511);
    float acc = cb[c];
    if (row < MP) {
#pragma unroll
        for (int j = 0; j < 4; ++j) { const int i = row - 3 + j; if (i >= 0) acc += cw[j * 512 + c] * bf2f(Z[(size_t)i * NIN + ZC_UA + c]); }
    } else {
        const int b = (row - MP) >> 3, t = (row - MP) & 7;
#pragma unroll
        for (int j = 0; j < 4; ++j) { const int i = t - 3 + j;
            const float u = i >= 0 ? bf2f(Z[(size_t)(MP + b * 8 + i) * NIN + ZC_UA + c]) : st_conv[((size_t)b * 3 + (3 + i)) * 512 + c];
            acc += cw[j * 512 + c] * u; }
    }
    XC[idx] = acc;
}
__global__ void __launch_bounds__(256) k_gates(const float* __restrict__ XC, const float* __restrict__ wr, const float* __restrict__ br, const float* __restrict__ wi,
                                               const float* __restrict__ bi, const float* __restrict__ lam, float* __restrict__ LA, float* __restrict__ LB) {
    const size_t idx = (size_t)blockIdx.x * 256 + threadIdx.x;
    if (idx >= (size_t)MT * 512) return;
    const int row = (int)(idx >> 9), c = (int)(idx & 511), n = c >> 6, e = c & 63;
    float rp = br[c], ip = bi[c];
    const float* x = XC + (size_t)row * 512 + n * 64;
    for (int d = 0; d < 64; ++d) { const float xv = x[d]; rp += xv * wr[((size_t)n * 64 + d) * 64 + e]; ip += xv * wi[((size_t)n * 64 + d) * 64 + e]; }
    const float r = sigmoidf_(rp), ig = sigmoidf_(ip);
    const float log_a = -8.f * r * log1pf(expf(-lam[c]));
    const float a = expf(log_a);
    const float mult = (row == 0) ? 1.f : sqrtf(-expm1f(2.f * log_a));
    LA[idx] = a; LB[idx] = mult * ig * XC[idx];
}
__global__ void __launch_bounds__(256) k_lru_scan(const float* __restrict__ LA, const float* __restrict__ LB, const float* __restrict__ st_lru  ,
                                                  const bf16_t* __restrict__ Z, bf16_t* __restrict__ Y, float* __restrict__ out, int layer) {
    const int idx = blockIdx.x * 256 + threadIdx.x;
    if (idx >= 33 * 512) return;
    const int seq = idx >> 9, c = idx & 511;
    float h; int row0, T;
    if (seq == 0) { h = 0.f; row0 = 0; T = MP; } else { h = st_lru[(size_t)(seq - 1) * 512 + c]; row0 = MP + (seq - 1) * 8; T = 8; }
    for (int t = 0; t < T; ++t) { const size_t i = (size_t)(row0 + t) * 512 + c; h = LA[i] * h + LB[i]; Y[(size_t)(row0 + t) * YK + c] = f2bf(h); }
    if (seq == 0) {
        out[O_LRUP + (size_t)layer * 512 + c] = h;
        for (int j = 0; j < 3; ++j) out[O_CONVP + ((size_t)layer * 3 + j) * 512 + c] = bf2f(Z[(size_t)(MP - 3 + j) * NIN + ZC_UA + c]);
    } else {
        const int b = seq - 1;
        out[O_LRUS + ((size_t)layer * 32 + b) * 512 + c] = h;
        for (int j = 0; j < 3; ++j) out[O_CONVS + (((size_t)layer * 32 + b) * 3 + j) * 512 + c] = bf2f(Z[(size_t)(MP + b * 8 + 5 + j) * NIN + ZC_UA + c]);
    }
}

__global__ void __launch_bounds__(256) k_hgrn_seq(const bf16_t* __restrict__ Z, const float* __restrict__ st_hg  , const float* __restrict__ lbraw  ,
                                                  float* __restrict__ HRAW, float* __restrict__ out, int layer) {
    const int w = blockIdx.x * 4 + (threadIdx.x >> 6), lane = threadIdx.x & 63;
    if (w >= 33 * 512) return;
    const int seq = w >> 9, h = (w >> 7) & 3, dv = w & 127;
    float lb0 = 0.f, lb1 = 0.f;
    if (layer == 1) { lb0 = sigmoidf_(lbraw[512 + h * 128 + lane] - lbraw[h * 128 + lane]); lb1 = sigmoidf_(lbraw[512 + h * 128 + lane + 64] - lbraw[h * 128 + lane + 64]); }
    float S0 = 0.f, S1 = 0.f; int row0 = 0, T = MP;
    if (seq > 0) { const int b = seq - 1; row0 = MP + b * 8; T = 8;
        S0 = st_hg[(((size_t)b * 4 + h) * 128 + lane) * 128 + dv]; S1 = st_hg[(((size_t)b * 4 + h) * 128 + lane + 64) * 128 + dv]; }
    for (int t = 0; t < T; ++t) {
        const bf16_t* z = Z + (size_t)(row0 + t) * NIN;
        const float q0 = bf2f(z[ZC_QB + h * 128 + lane]), q1 = bf2f(z[ZC_QB + h * 128 + lane + 64]);
        const float s0 = sigmoidf_(bf2f(z[ZC_FB + h * 128 + lane])), s1 = sigmoidf_(bf2f(z[ZC_FB + h * 128 + lane + 64]));
        const float v = bf2f(z[ZC_IB + h * 128 + dv]);
        const float f0 = lb0 + (1.f - lb0) * s0, f1 = lb1 + (1.f - lb1) * s1;
        const float k0 = (1.f - lb0) * (1.f - s0), k1 = (1.f - lb1) * (1.f - s1);
        S0 = f0 * S0 + k0 * v; S1 = f1 * S1 + k1 * v;
        const float o = wave_sum(S0 * q0 + S1 * q1);
        if (lane == 0) HRAW[(size_t)(row0 + t) * 512 + h * 128 + dv] = o;
    }
    if (seq == 0) { out[O_HGP + (((size_t)layer * 4 + h) * 128 + lane) * 128 + dv] = S0; out[O_HGP + (((size_t)layer * 4 + h) * 128 + lane + 64) * 128 + dv] = S1; }
    else { const int b = seq - 1;
        out[O_HGS + ((((size_t)layer * 32 + b) * 4 + h) * 128 + lane) * 128 + dv] = S0; out[O_HGS + ((((size_t)layer * 32 + b) * 4 + h) * 128 + lane + 64) * 128 + dv] = S1; }
}
__global__ void __launch_bounds__(256) k_hgrn_post(const float* __restrict__ HRAW, const bf16_t* __restrict__ Z, const float* __restrict__ ng  , bf16_t* __restrict__ Y) {
    const int w = blockIdx.x * 4 + (threadIdx.x >> 6), lane = threadIdx.x & 63;
    if (w >= MT * 4) return;
    const int row = w >> 2, h = w & 3;
    const float o0 = HRAW[(size_t)row * 512 + h * 128 + lane], o1 = HRAW[(size_t)row * 512 + h * 128 + lane + 64];
    const float s = wave_sum(o0 * o0 + o1 * o1);
    const float rinv = rsqrtf(s * (1.f / 128.f) + 1e-6f);
    Y[(size_t)row * YK + 512 + h * 128 + lane] = f2bf(o0 * rinv * ng[lane] * bf2f(Z[(size_t)row * NIN + ZC_GB + h * 128 + lane]));
    Y[(size_t)row * YK + 512 + h * 128 + lane + 64] = f2bf(o1 * rinv * ng[lane + 64] * bf2f(Z[(size_t)row * NIN + ZC_GB + h * 128 + lane + 64]));
}

DEV float dot_row_bf(const float (&q)[64], const bf16_t* __restrict__ p) {
    float s = 0.f;
#pragma unroll
    for (int d8 = 0; d8 < 8; ++d8) { const uint4 u = *(const uint4*)(p + d8 * 8); const unsigned w[4] = {u.x, u.y, u.z, u.w};
#pragma unroll
        for (int i = 0; i < 4; ++i) { s += q[d8 * 8 + 2 * i] * __uint_as_float(w[i] << 16); s += q[d8 * 8 + 2 * i + 1] * __uint_as_float(w[i] & 0xffff0000u); } }
    return s;
}
DEV float dot_row_f(const float (&q)[64], const float* __restrict__ p) {
    float s = 0.f;
#pragma unroll
    for (int d4 = 0; d4 < 16; ++d4) { const float4 u = *(const float4*)(p + d4 * 4); s += q[d4 * 4] * u.x + q[d4 * 4 + 1] * u.y + q[d4 * 4 + 2] * u.z + q[d4 * 4 + 3] * u.w; }
    return s;
}
__global__ void __launch_bounds__(256) k_attn(const bf16_t* __restrict__ Z, const float* __restrict__ c128, const float* __restrict__ c512, const float* __restrict__ c2048  ,
                                              bf16_t* __restrict__ Y) {
    const int w = blockIdx.x * 4 + (threadIdx.x >> 6), lane = threadIdx.x & 63;
    if (w >= MT * 4) return;
    const int row = w >> 2, hh = w & 3;
    const bool prompt = row < MP;
    const int b = prompt ? 0 : (row - MP) >> 3, t = prompt ? row : (row - MP) & 7;
    float og[3], lse[3];
#pragma unroll
    for (int g = 0; g < 3; ++g) {
        const int dil = g == 0 ? 1 : (g == 1 ? 4 : 16), Wc = 128 * dil, hd = g * 4 + hh;
        const float* cache = g == 0 ? c128 : (g == 1 ? c512 : c2048);
        float q[64];
        { const bf16_t* qp = Z + (size_t)row * NIN + ZC_QC + hd * 64;
#pragma unroll
          for (int d8 = 0; d8 < 8; ++d8) { const uint4 u = *(const uint4*)(qp + d8 * 8); const unsigned ww[4] = {u.x, u.y, u.z, u.w};
#pragma unroll
              for (int i = 0; i < 4; ++i) { q[d8 * 8 + 2 * i] = __uint_as_float(ww[i] << 16); q[d8 * 8 + 2 * i + 1] = __uint_as_float(ww[i] & 0xffff0000u); } } }
        float s[3]; bool val[3];
#pragma unroll
        for (int sl = 0; sl < 3; ++sl) {
            const int j = lane + 64 * sl;
            s[sl] = -1e30f; val[sl] = false;
            if (j <= 128) {
                if (prompt) { const int tk = t - dil * j; if (tk >= 0) { val[sl] = true; s[sl] = dot_row_bf(q, Z + (size_t)tk * NIN + ZC_KC + hd * 64); } }
                else { const int idx = dil * (128 - j) + t; val[sl] = true;
                    if (idx < Wc) s[sl] = dot_row_f(q, cache + ((size_t)b * Wc + idx) * 512 + hh * 64);
                    else s[sl] = dot_row_bf(q, Z + (size_t)(MP + b * 8 + idx - Wc) * NIN + ZC_KC + hd * 64); }
            }
        }
        const float m = wave_max(fmaxf(s[0], fmaxf(s[1], s[2])));
        float p[3];
#pragma unroll
        for (int sl = 0; sl < 3; ++sl) p[sl] = val[sl] ? expf(s[sl] - m) : 0.f;
        const float l = wave_sum(p[0] + p[1] + p[2]);
        float acc = 0.f;
        for (int j = 0; j <= 128; ++j) {
            const float pj = __shfl(j < 64 ? p[0] : (j < 128 ? p[1] : p[2]), j & 63);
            float v = 0.f;
            if (prompt) { const int tk = t - dil * j; if (tk >= 0) v = bf2f(Z[(size_t)tk * NIN + ZC_VC + hd * 64 + lane]); }
            else { const int idx = dil * (128 - j) + t;
                if (idx < Wc) v = cache[((size_t)b * Wc + idx) * 512 + 256 + hh * 64 + lane];
                else v = bf2f(Z[(size_t)(MP + b * 8 + idx - Wc) * NIN + ZC_VC + hd * 64 + lane]); }
            acc += pj * v;
        }
        og[g] = acc / l; lse[g] = m + logf(l);
    }
    const float mx = fmaxf(lse[0], fmaxf(lse[1], lse[2]));
    const float w0 = expf(lse[0] - mx), w1 = expf(lse[1] - mx), w2 = expf(lse[2] - mx);
    Y[(size_t)row * YK + 1024 + hh * 64 + lane] = f2bf((w0 * og[0] + w1 * og[1] + w2 * og[2]) / (w0 + w1 + w2));
}

__global__ void __launch_bounds__(256) k_cache(const bf16_t* __restrict__ Z, const float* __restrict__ cin  , float* __restrict__ outs  ,
                                               float* __restrict__ outp  , int Wc, int g) {
    const size_t n4s = (size_t)32 * Wc * 128, n4p = (size_t)Wc * 128;
    for (size_t i = (size_t)blockIdx.x * 256 + threadIdx.x; i < n4s + n4p; i += (size_t)gridDim.x * 256) {
        if (i < n4s) {
            const int e4 = (int)(i & 127); const size_t r = i >> 7; const int b = (int)(r / Wc), ri = (int)(r % Wc);
            float4 v;
            if (ri + 8 < Wc) v = *(const float4*)(cin + ((size_t)b * Wc + ri + 8) * 512 + e4 * 4);
            else { const int tt = ri + 8 - Wc, e = e4 * 4, kv = e >> 8, hh = (e >> 6) & 3, d = e & 63;
                const bf16_t* z = Z + (size_t)(MP + b * 8 + tt) * NIN + (kv ? ZC_VC : ZC_KC) + (g * 4 + hh) * 64 + d;
                v = make_float4(bf2f(z[0]), bf2f(z[1]), bf2f(z[2]), bf2f(z[3])); }
            *(float4*)(outs + r * 512 + e4 * 4) = v;
        } else {
            const size_t ip = i - n4s; const int e4 = (int)(ip & 127), ri = (int)(ip >> 7), e = e4 * 4, kv = e >> 8, hh = (e >> 6) & 3, d = e & 63;
            const bf16_t* z = Z + (size_t)(MP - Wc + ri) * NIN + (kv ? ZC_VC : ZC_KC) + (g * 4 + hh) * 64 + d;
            *(float4*)(outp + (size_t)ri * 512 + e4 * 4) = make_float4(bf2f(z[0]), bf2f(z[1]), bf2f(z[2]), bf2f(z[3]));
        }
    }
}

extern "C" void kernel_launch(void* const* d_in, const int* in_sizes, int n_in, void* d_out, int out_size, void* d_ws, size_t ws_size, hipStream_t stream) {
    const float* const* in = (const float* const*)d_in;
    float* out = (float*)d_out; unsigned char* ws = (unsigned char*)d_ws;
    bf16_t* XN = (bf16_t*)(ws + WS_XN); bf16_t* Z = (bf16_t*)(ws + WS_Z); bf16_t* Y = (bf16_t*)(ws + WS_Y); bf16_t* MIX = (bf16_t*)(ws + WS_MIX);
    bf16_t* OB = (bf16_t*)(ws + WS_OB); float* X1 = (float*)(ws + WS_X1); float* X2 = (float*)(ws + WS_X2); bf16_t* HID = (bf16_t*)(ws + WS_HID);
    float* XC = (float*)(ws + WS_XC); float* LA = (float*)(ws + WS_LA); float* LBb = (float*)(ws + WS_LB); float* HRAW = (float*)(ws + WS_HRAW);
    for (int l = 0; l < 2; ++l) {
        unsigned char* wl = ws + WS_W + l * WS_WL;
        k_wt<<<dim3(NIN / 32, DM / 32), 256, 0, stream>>>(in[12] + (size_t)l * DM * NIN, DM, NIN, (bf16_t*)(wl + W_IN), DM, 0, in[8] + l * DM);
        k_wt<<<dim3(DM / 32, 512 / 32), 256, 0, stream>>>(in[23] + (size_t)l * 512 * DM, 512, DM, (bf16_t*)(wl + W_BR), YK, 0, nullptr);
        k_wt<<<dim3(DM / 32, 512 / 32), 256, 0, stream>>>(in[24] + (size_t)l * 512 * DM, 512, DM, (bf16_t*)(wl + W_BR), YK, 512, nullptr);
        k_wt<<<dim3(DM / 32, 256 / 32), 256, 0, stream>>>(in[25] + (size_t)l * 256 * DM, 256, DM, (bf16_t*)(wl + W_BR), YK, 1024, nullptr);
        k_wt<<<dim3(DM / 32, DM / 32), 256, 0, stream>>>(in[26] + (size_t)l * DM * DM, DM, DM, (bf16_t*)(wl + W_OUT), DM, 0, nullptr);
        k_wt<<<dim3(DFF / 32, DM / 32), 256, 0, stream>>>(in[27] + (size_t)l * DM * DFF, DM, DFF, (bf16_t*)(wl + W_UP), DM, 0, in[10] + l * DM);
        k_wt<<<dim3(DM / 32, DFF / 32), 256, 0, stream>>>(in[28] + (size_t)l * DFF * DM, DFF, DM, (bf16_t*)(wl + W_DN), DFF, 0, nullptr);
    }
    k_xn<<<MT / 4, 256, 0, stream>>>(in[0], in[1], XN);
    const int Wcs[3] = {128, 512, 2048};
    const size_t ocs[3] = {O_W128S, O_W512S, O_W2048S}, ocp[3] = {O_W128P, O_W512P, O_W2048P};
    for (int l = 0; l < 2; ++l) {
        unsigned char* wl = ws + WS_W + l * WS_WL;
        k_gemm<EpiZ, false><<<dim3(NIN / 64, MT / 64), 256, 0, stream>>>(XN, (const bf16_t*)(wl + W_IN), MT, NIN, DM, EpiZ{Z, in[13] + (size_t)l * 3072}, nullptr);
        for (int g = 0; g < 3; ++g) {
            const int Wc = Wcs[g];
            k_cache<<<2048, 256, 0, stream>>>(Z, in[5 + g] + (size_t)l * 32 * Wc * 512, out + ocs[g] + (size_t)l * 32 * Wc * 512, out + ocp[g] + (size_t)l * Wc * 512, Wc, g);
        }
        k_conv<<<MT * 512 / 256, 256, 0, stream>>>(Z, in[2] + (size_t)l * 32 * 3 * 512, in[14] + (size_t)l * 4 * 512, in[15] + (size_t)l * 512, XC);
        k_gates<<<MT * 512 / 256, 256, 0, stream>>>(XC, in[16] + (size_t)l * 8 * 64 * 64, in[17] + (size_t)l * 512, in[18] + (size_t)l * 8 * 64 * 64, in[19] + (size_t)l * 512,
                                                    in[20] + (size_t)l * 512, LA, LBb);
        k_lru_scan<<<33 * 512 / 256, 256, 0, stream>>>(LA, LBb, in[3] + (size_t)l * 32 * 512, Z, Y, out, l);
        k_hgrn_seq<<<33 * 512 / 4, 256, 0, stream>>>(Z, in[4] + (size_t)l * 32 * 4 * 128 * 128, in[21], HRAW, out, l);
        k_hgrn_post<<<MT, 256, 0, stream>>>(HRAW, Z, in[22] + (size_t)l * 128, Y);
        k_attn<<<MT, 256, 0, stream>>>(Z, in[5] + (size_t)l * 32 * 128 * 512, in[6] + (size_t)l * 32 * 512 * 512, in[7] + (size_t)l * 32 * 2048 * 512, Y);
        k_gemm<EpiBf, true><<<dim3(DM / 64, MT / 64), 256, 0, stream>>>(Y, (const bf16_t*)(wl + W_BR), MT, DM, YK, EpiBf{MIX, DM}, Z);
        k_gemm<EpiBf, false><<<dim3(DM / 64, MT / 64), 256, 0, stream>>>(MIX, (const bf16_t*)(wl + W_OUT), MT, DM, DM, EpiBf{OB, DM}, nullptr);
        const float* xp = l == 0 ? in[0] : X2; const float* xs = l == 0 ? in[1] : X2 + (size_t)MP * DM;
        k_elt<<<MT / 4, 256, 0, stream>>>(xp, xs, OB, in[9] + (size_t)l * DM, X1, XN);
        k_gemm<EpiRelu2, false><<<dim3(DFF / 64, MT / 64), 256, 0, stream>>>(XN, (const bf16_t*)(wl + W_UP), MT, DFF, DM, EpiRelu2{HID, DFF}, nullptr);
        k_gemm<EpiBf, false><<<dim3(DM / 64, MT / 64), 256, 0, stream>>>(HID, (const bf16_t*)(wl + W_DN), MT, DM, DFF, EpiBf{OB, DM}, nullptr);
        float* xo = l == 0 ? X2 : out;
        k_elt<<<MT / 4, 256, 0, stream>>>(X1, X1 + (size_t)MP * DM, OB, in[11] + (size_t)l * DM, xo, XN);
    }
}
```

```cpp
#include <hip/hip_runtime.h>
#include <stdint.h>

typedef unsigned short bf16_t;
#define DEV __device__ __forceinline__

DEV float bf2f(bf16_t b) { return __uint_as_float(((unsigned)b) << 16); }
DEV bf16_t f2bf(float f) { unsigned u = __float_as_uint(f); u += 0x7fffu + ((u >> 16) & 1u); return (bf16_t)(u >> 16); }
DEV float sigmoidf_(float x) { return 1.f / (1.f + expf(-x)); }
DEV float wave_sum(float v) {
#pragma unroll
    for (int o = 1; o < 64; o <<= 1) v += __shfl_xor(v, o);
    return v;
}
DEV float wave_max(float v) {
#pragma unroll
    for (int o = 1; o < 64; o <<= 1) v = fmaxf(v, __shfl_xor(v, o));
    return v;
}

constexpr int MP = 16384, MS = 256, MT = MP + MS;
constexpr int DM = 1024, NIN = 7936, DFF = 4096, YK = 1280;
constexpr int ZC_UA = 0, ZC_QB = 512, ZC_FB = 1024, ZC_IB = 1536, ZC_GB = 2048, ZC_QC = 2560, ZC_KC = 3328, ZC_VC = 4096, ZC_GATE = 4864;
constexpr int NB = 32, NT = 8;
constexpr size_t O_Y = 0, O_CONVP = 17039360, O_CONVS = 17042432, O_LRUP = 17140736, O_LRUS = 17141760, O_HGP = 17174528, O_HGS = 17305600,
                 O_W128P = 21499904, O_W128S = 21630976, O_W512P = 25825280, O_W512S = 26349568, O_W2048P = 43126784, O_W2048S = 45223936;
constexpr size_t MiB = 1u << 20;
constexpr size_t WS_W = 1 * MiB, WS_WL = 40 * MiB;
constexpr size_t W_IN = 0, W_BR = 16 * MiB, W_OUT = 19 * MiB, W_UP = 21 * MiB, W_DN = 29 * MiB;
constexpr size_t WS_XN = 82 * MiB, WS_Z = 116 * MiB, WS_Y = 368 * MiB, WS_MIX = 409 * MiB, WS_OB = 442 * MiB, WS_X1 = 475 * MiB, WS_X2 = 540 * MiB,
                 WS_HID = 605 * MiB, WS_XC = 735 * MiB, WS_LA = 768 * MiB, WS_LB = 801 * MiB, WS_HRAW = 834 * MiB;

#include <hip/hip_cooperative_groups.h>
namespace pg8 {
#define PG8_LAS __attribute__((address_space(3)))
typedef unsigned short bf16_t;
typedef short bf16x8 __attribute__((ext_vector_type(8)));
typedef float f32x4 __attribute__((ext_vector_type(4)));
typedef unsigned u32x4 __attribute__((ext_vector_type(4)));
constexpr int BM = 256, BK = 64, HALF = 128, HTB = HALF * BK * 2  , STAGE_BYTES = 8 * HTB, NXCD = 8, WGM = 8;

__host__ __device__ __forceinline__ int lds_byte(int r, int c) { const int st = (r >> 4) * 2 + (c >> 5), rr = r & 15, cc = c & 31, ob = rr * 64 + cc * 2; return st * 1024 + (ob ^ (((ob >> 9) & 1) << 5)); }
__host__ __device__ __forceinline__ void stage_rc(int b, int& R, int& C) { const int st = b / 1024, sb = b % 1024, swz = sb ^ (((sb >> 9) & 1) << 5); R = (st >> 1) * 16 + swz / 64; C = (st & 1) * 32 + (swz % 64) / 2; }
__host__ __device__ __forceinline__ int perm32(int rho) { const int n = rho >> 4, i = rho & 15; return 8 * (i >> 2) + 4 * n + (i & 3); }

struct Unit { int pm, pn; };
struct Gemm { const bf16_t* A; const bf16_t* Bt; int M, N, K; };

struct StaticOrder {
    int nM, nN, nwg, G, c;
    __host__ __device__ void init(int M, int N, int G_, int c_) { nM = M / BM; nN = N / BM; nwg = nM * nN; G = G_; c = c_; }
    __host__ __device__ bool next(int i, Unit& u) const {
        const long L = (long)i * G + c; if (L >= nwg) return false;
        int wgid = (int)L; { const int q = nwg / NXCD, r = nwg % NXCD, xcd = wgid % NXCD, off = wgid / NXCD; wgid = (xcd < r ? xcd * (q + 1) : r * (q + 1) + (xcd - r) * q) + off; }
        const int nig = WGM * nN, gid = wgid / nig, fm = gid * WGM, gsz = (nM - fm) < WGM ? (nM - fm) : WGM;
        u.pm = fm + ((wgid % nig) % gsz); u.pn = (wgid % nig) / gsz; return true;
    }
    __device__ __forceinline__ void a_ready(const Unit&) const {}
    __device__ __forceinline__ void done(const Unit&) const {}
};
__device__ __forceinline__ unsigned cvt_pk_bf16(float lo, float hi) { unsigned r; asm volatile("v_cvt_pk_bf16_f32 %0, %1, %2" : "=v"(r) : "v"(lo), "v"(hi)); return r; }
__device__ __forceinline__ float fsig(float x) { return __builtin_amdgcn_rcpf(1.f + __expf(-x)); }
__device__ __forceinline__ float bflo(unsigned w) { return __uint_as_float(w << 16); }
__device__ __forceinline__ float bfhi(unsigned w) { return __uint_as_float(w & 0xffff0000u); }
constexpr int ZP = 7936;
struct EpiZ {
    static constexpr bool PERM = true, AFTER_DRAIN = false, HOOK = false;
    bf16_t* Z; const float* bgate;
    __device__ __forceinline__ void operator()(const f32x4 (&acc)[2][2][4][2], const Unit& u, int wr, int wc, int fr, int fq) const {
        const int colt = u.pn * BM;
        const int mode = colt >= 4864 ? 3 : (((colt >= 512 && colt < 1024) || (colt >= 2048 && colt < 2560)) ? 1 : ((colt >= 2560 && colt < 3328) ? 2 : 0));
        const int row0 = u.pm * BM + wr * 64 + fr, col0 = colt + wc * 32 + 8 * fq;
        f32x4 bv[2][2];
#pragma unroll
        for (int bj = 0; bj < 2; ++bj)
#pragma unroll
            for (int n = 0; n < 2; ++n) bv[bj][n] = mode == 3 ? *(const f32x4*)(bgate + (col0 - 4864) + bj * HALF + 4 * n) : (f32x4){0.f, 0.f, 0.f, 0.f};
#pragma unroll
        for (int ai = 0; ai < 2; ++ai)
#pragma unroll
            for (int m = 0; m < 4; ++m) { bf16_t* rowp = Z + (size_t)(row0 + ai * HALF + m * 16) * ZP + col0;
#pragma unroll
                for (int bj = 0; bj < 2; ++bj) { f32x4 v0 = acc[ai][bj][m][0] + bv[bj][0], v1 = acc[ai][bj][m][1] + bv[bj][1];
                    if (mode == 3) {
#pragma unroll
                        for (int j = 0; j < 4; ++j) { v0[j] = fsig(v0[j]); v1[j] = fsig(v1[j]); } }
                    else if (mode == 1) {
#pragma unroll
                        for (int j = 0; j < 4; ++j) { v0[j] = v0[j] * fsig(v0[j]); v1[j] = v1[j] * fsig(v1[j]); } }
                    else if (mode == 2) { v0 = v0 * 0.125f; v1 = v1 * 0.125f; }
                    u32x4 w; w.x = cvt_pk_bf16(v0[0], v0[1]); w.y = cvt_pk_bf16(v0[2], v0[3]); w.z = cvt_pk_bf16(v1[0], v1[1]); w.w = cvt_pk_bf16(v1[2], v1[3]);
                    *(u32x4*)(rowp + bj * HALF) = w; } }
    }
};
template <int ACT  > struct EpiBf {
    static constexpr bool PERM = true, AFTER_DRAIN = false, HOOK = false;
    bf16_t* O; int ldc;
    __device__ __forceinline__ void operator()(const f32x4 (&acc)[2][2][4][2], const Unit& u, int wr, int wc, int fr, int fq) const {
        const int row0 = u.pm * BM + wr * 64 + fr, col0 = u.pn * BM + wc * 32 + 8 * fq;
#pragma unroll
        for (int ai = 0; ai < 2; ++ai)
#pragma unroll
            for (int m = 0; m < 4; ++m) { bf16_t* rowp = O + (size_t)(row0 + ai * HALF + m * 16) * ldc + col0;
#pragma unroll
                for (int bj = 0; bj < 2; ++bj) { f32x4 v0 = acc[ai][bj][m][0], v1 = acc[ai][bj][m][1];
                    if (ACT == 1) {
#pragma unroll
                        for (int j = 0; j < 4; ++j) { const float a = fmaxf(v0[j], 0.f), b = fmaxf(v1[j], 0.f); v0[j] = a * a; v1[j] = b * b; } }
                    u32x4 w; w.x = cvt_pk_bf16(v0[0], v0[1]); w.y = cvt_pk_bf16(v0[2], v0[3]); w.z = cvt_pk_bf16(v1[0], v1[1]); w.w = cvt_pk_bf16(v1[2], v1[3]);
                    *(u32x4*)(rowp + bj * HALF) = w; } }
    }
};
struct EpiMix {
    static constexpr bool PERM = true, AFTER_DRAIN = false, HOOK = true;
    const bf16_t* Z; bf16_t* O;
    __device__ __forceinline__ void hook(f32x4 (&acc)[2][2][4][2], const Unit& u, int wr, int wc, int fr, int fq, int t) const {
        const int seg = t == 8 ? 0 : 1;
        int row0 = u.pm * BM + wr * 64 + fr; const int col0 = u.pn * BM + wc * 32 + 8 * fq;
        asm volatile("" : "+v"(row0));
#pragma unroll
        for (int ai = 0; ai < 2; ++ai)
#pragma unroll
            for (int m = 0; m < 4; ++m) { const bf16_t* gp = (const bf16_t*)((const char*)Z + (unsigned)(((row0 + ai * HALF + m * 16) * ZP + 4864 + seg * 1024 + col0) * 2));
#pragma unroll
                for (int bj = 0; bj < 2; ++bj) { const u32x4 ga = *(const u32x4*)(gp + bj * HALF), gb = *(const u32x4*)(gp + 1024 + bj * HALF);
                    f32x4 r0, r1;
                    r0[0] = fmaxf(bflo(ga.x), 1e-30f) * __builtin_amdgcn_rcpf(fmaxf(bflo(gb.x), 1e-30f)); r0[1] = fmaxf(bfhi(ga.x), 1e-30f) * __builtin_amdgcn_rcpf(fmaxf(bfhi(gb.x), 1e-30f));
                    r0[2] = fmaxf(bflo(ga.y), 1e-30f) * __builtin_amdgcn_rcpf(fmaxf(bflo(gb.y), 1e-30f)); r0[3] = fmaxf(bfhi(ga.y), 1e-30f) * __builtin_amdgcn_rcpf(fmaxf(bfhi(gb.y), 1e-30f));
                    r1[0] = fmaxf(bflo(ga.z), 1e-30f) * __builtin_amdgcn_rcpf(fmaxf(bflo(gb.z), 1e-30f)); r1[1] = fmaxf(bfhi(ga.z), 1e-30f) * __builtin_amdgcn_rcpf(fmaxf(bfhi(gb.z), 1e-30f));
                    r1[2] = fmaxf(bflo(ga.w), 1e-30f) * __builtin_amdgcn_rcpf(fmaxf(bflo(gb.w), 1e-30f)); r1[3] = fmaxf(bfhi(ga.w), 1e-30f) * __builtin_amdgcn_rcpf(fmaxf(bfhi(gb.w), 1e-30f));
                    acc[ai][bj][m][0] = acc[ai][bj][m][0] * r0; acc[ai][bj][m][1] = acc[ai][bj][m][1] * r1;
                    asm volatile("" ::: "memory"); } }
    }
    __device__ __forceinline__ void operator()(const f32x4 (&acc)[2][2][4][2], const Unit& u, int wr, int wc, int fr, int fq) const {
        int row0 = u.pm * BM + wr * 64 + fr; const int col0 = u.pn * BM + wc * 32 + 8 * fq;
        asm volatile("" : "+v"(row0));
#pragma unroll
        for (int ai = 0; ai < 2; ++ai)
#pragma unroll
            for (int m = 0; m < 4; ++m) { const int row = row0 + ai * HALF + m * 16; const bf16_t* gp = (const bf16_t*)((const char*)Z + (unsigned)((row * ZP + 4864 + 2048 + col0) * 2)); bf16_t* rowp = (bf16_t*)((char*)O + (unsigned)((row * 1024 + col0) * 2));
#pragma unroll
                for (int bj = 0; bj < 2; ++bj) { const u32x4 g = *(const u32x4*)(gp + bj * HALF);
                    f32x4 v0 = acc[ai][bj][m][0], v1 = acc[ai][bj][m][1];
                    v0[0] *= fmaxf(bflo(g.x), 1e-30f); v0[1] *= fmaxf(bfhi(g.x), 1e-30f); v0[2] *= fmaxf(bflo(g.y), 1e-30f); v0[3] *= fmaxf(bfhi(g.y), 1e-30f);
                    v1[0] *= fmaxf(bflo(g.z), 1e-30f); v1[1] *= fmaxf(bfhi(g.z), 1e-30f); v1[2] *= fmaxf(bflo(g.w), 1e-30f); v1[3] *= fmaxf(bfhi(g.w), 1e-30f);
                    u32x4 w; w.x = cvt_pk_bf16(v0[0], v0[1]); w.y = cvt_pk_bf16(v0[2], v0[3]); w.z = cvt_pk_bf16(v1[0], v1[1]); w.w = cvt_pk_bf16(v1[2], v1[3]);
                    *(u32x4*)(rowp + bj * HALF) = w; }
                asm volatile("" ::: "memory"); }
    }
};
template <class Epi, class Sched, bool ALIGN_EPI = false, bool SP2 = false>
__device__ __forceinline__ void gemm_phase(PG8_LAS unsigned char* lds, const Gemm g, const Sched& S, const Epi& E) {
    int tid_ = threadIdx.x; asm volatile("" : "+v"(tid_));
    const int tid = tid_, wid = __builtin_amdgcn_readfirstlane(tid >> 6), lane = tid & 63, wr = wid >> 2, wc = wid & 3, fr = lane & 15, fq = lane >> 4;
    const int K = g.K, nt = K / BK;
    unsigned voffA[2], voffB[2];
#pragma unroll
    for (int i = 0; i < 2; ++i) { int R, C; stage_rc(tid * 16 + i * 8192, R, C); const int Rb = Epi::PERM ? ((R & ~31) + perm32(R & 31)) : R;
        voffA[i] = (unsigned)(R * K + C) * 2u; voffB[i] = (unsigned)(Rb * K + C) * 2u; }
    const size_t kstep = (size_t)(BK * 2);
    const size_t hstep = (size_t)HALF * K * 2;
    const size_t tstep = 2 * hstep;
    const unsigned ldsw = (unsigned)wid * 1024u;
    const int aoff = lds_byte(wr * 64 + fr, fq * 8), boff = lds_byte(wc * 32 + fr, fq * 8);
#define PG8_SA(b, h) (((b) * 2 + (h)) * HTB)
#define PG8_SB(b, h) ((4 + (b) * 2 + (h)) * HTB)
#define PG8_STAGE(bufoff, gbase, voff) do { _Pragma("unroll") for (int _i = 0; _i < 2; ++_i) \
        __builtin_amdgcn_global_load_lds((const unsigned*)((const char*)(gbase) + (voff)[_i]), (PG8_LAS unsigned*)(lds + (bufoff) + ldsw + _i * 8192), 16, 0, 0); } while (0)
#define PG8_LDA(dst, b, h) do { _Pragma("unroll") for (int m = 0; m < 4; ++m) _Pragma("unroll") for (int k = 0; k < 2; ++k) dst[m][k] = *(const PG8_LAS bf16x8*)(lds + PG8_SA(b, h) + aoff + m * 2048 + k * 1024); } while (0)
#define PG8_LDB(dst, b, h) do { _Pragma("unroll") for (int n = 0; n < 2; ++n) _Pragma("unroll") for (int k = 0; k < 2; ++k) dst[n][k] = *(const PG8_LAS bf16x8*)(lds + PG8_SB(b, h) + boff + n * 2048 + k * 1024); } while (0)
#define PG8_MMA(ai, bj, At, Bt) do { __builtin_amdgcn_s_setprio(1); _Pragma("unroll") for (int m = 0; m < 4; ++m) _Pragma("unroll") for (int n = 0; n < 2; ++n) _Pragma("unroll") for (int k = 0; k < 2; ++k) \
        acc[ai][bj][m][n] = __builtin_amdgcn_mfma_f32_16x16x32_bf16(Bt[n][k], At[m][k], acc[ai][bj][m][n], 0, 0, 0); __builtin_amdgcn_s_setprio(0); } while (0)
#define PG8_WAIT_V(n) asm volatile("s_waitcnt vmcnt(" #n ")" ::: "memory")
#define PG8_WAIT_L(n) asm volatile("s_waitcnt lgkmcnt(" #n ")" ::: "memory")
#define PG8_BAR __builtin_amdgcn_s_barrier()
#define PG8_SCHED __builtin_amdgcn_sched_barrier(0)
    Unit cur, nxt; int ui = 0;
    if (!S.next(0, cur)) return;
    f32x4 acc[2][2][4][2];
#pragma unroll
    for (int a = 0; a < 2; ++a)
#pragma unroll
        for (int b = 0; b < 2; ++b)
#pragma unroll
            for (int m = 0; m < 4; ++m)
#pragma unroll
                for (int n = 0; n < 2; ++n) acc[a][b][m][n] = (f32x4){0.f, 0.f, 0.f, 0.f};
    bf16x8 At[4][2], B0[2][2], B1[2][2];
    const char* cA = (const char*)g.A + (size_t)cur.pm * tstep; const char* cB = (const char*)g.Bt + (size_t)cur.pn * tstep;
    S.a_ready(cur);
    if constexpr (SP2) {
        PG8_STAGE(PG8_SB(0, 0), cB, voffB); PG8_STAGE(PG8_SB(0, 1), cB + hstep, voffB); PG8_STAGE(PG8_SA(0, 0), cA, voffA); PG8_STAGE(PG8_SA(0, 1), cA + hstep, voffA);
        if (wr == 1) PG8_BAR;
        PG8_WAIT_V(2); PG8_BAR;
        PG8_STAGE(PG8_SB(1, 0), cB + kstep, voffB); PG8_STAGE(PG8_SA(1, 0), cA + kstep, voffA); PG8_STAGE(PG8_SB(1, 1), cB + hstep + kstep, voffB);
        PG8_WAIT_V(6); PG8_BAR;
    } else {
        PG8_STAGE(PG8_SB(0, 0), cB, voffB); PG8_STAGE(PG8_SA(0, 0), cA, voffA); PG8_STAGE(PG8_SB(0, 1), cB + hstep, voffB); PG8_STAGE(PG8_SA(0, 1), cA + hstep, voffA);
        if (wr == 1) PG8_BAR;
        PG8_WAIT_V(4); PG8_BAR;
        PG8_STAGE(PG8_SB(1, 0), cB + kstep, voffB); PG8_STAGE(PG8_SA(1, 0), cA + kstep, voffA); PG8_STAGE(PG8_SB(1, 1), cB + hstep + kstep, voffB);
        PG8_WAIT_V(6); PG8_BAR;
    }
    for (;;) {
        const bool has_next = S.next(ui + 1, nxt);
        const char* nA = has_next ? (const char*)g.A + (size_t)nxt.pm * tstep : cA; const char* nB = has_next ? (const char*)g.Bt + (size_t)nxt.pn * tstep : cB;
        for (int t = 0; t < nt; t += 2) {
            if constexpr (Epi::HOOK) { if (t == 8 || t == 16) { PG8_SCHED; E.hook(acc, cur, wr, wc, fr, fq, t); PG8_SCHED; } }
            const bool last = (t == nt - 2);
            const char* a1 = cA + (size_t)(t + 1) * kstep;
            const char* a2 = last ? nA : cA + (size_t)(t + 2) * kstep; const char* b2 = last ? nB : cB + (size_t)(t + 2) * kstep;
            const char* a3 = a2 + kstep; const char* b3 = b2 + kstep;
            if (last && has_next) S.a_ready(nxt);
            if constexpr (SP2) {
            PG8_LDB(B0, 0, 0); PG8_LDB(B1, 0, 1); PG8_SCHED; PG8_LDA(At, 0, 0); PG8_STAGE(PG8_SA(1, 1), a1 + hstep, voffA);
            PG8_WAIT_V(8); PG8_WAIT_L(0); PG8_BAR; PG8_MMA(0, 0, At, B0); PG8_MMA(0, 1, At, B1); PG8_BAR; PG8_SCHED;
            PG8_LDA(At, 0, 1); PG8_STAGE(PG8_SB(0, 0), b2, voffB); PG8_STAGE(PG8_SB(0, 1), b2 + hstep, voffB); PG8_STAGE(PG8_SA(0, 0), a2, voffA);
            PG8_WAIT_V(8); PG8_WAIT_L(0); PG8_BAR; PG8_MMA(1, 0, At, B0); PG8_MMA(1, 1, At, B1); PG8_BAR; PG8_SCHED;
            PG8_LDB(B0, 1, 0); PG8_LDB(B1, 1, 1); PG8_SCHED; PG8_LDA(At, 1, 0); PG8_STAGE(PG8_SA(0, 1), a2 + hstep, voffA);
            PG8_WAIT_V(8); PG8_WAIT_L(0); PG8_BAR; PG8_MMA(0, 0, At, B0); PG8_MMA(0, 1, At, B1); PG8_BAR; PG8_SCHED;
            PG8_LDA(At, 1, 1); PG8_STAGE(PG8_SB(1, 0), b3, voffB); PG8_STAGE(PG8_SB(1, 1), b3 + hstep, voffB); PG8_STAGE(PG8_SA(1, 0), a3, voffA);
            PG8_WAIT_V(8); PG8_WAIT_L(0); PG8_BAR; PG8_MMA(1, 0, At, B0); PG8_MMA(1, 1, At, B1); PG8_BAR; PG8_SCHED;
            } else {
            PG8_LDB(B0, 0, 0); PG8_SCHED; PG8_LDA(At, 0, 0); PG8_STAGE(PG8_SA(1, 1), a1 + hstep, voffA);
            PG8_WAIT_L(8); PG8_BAR; PG8_WAIT_L(0); PG8_MMA(0, 0, At, B0); PG8_BAR; PG8_SCHED;
            PG8_LDB(B1, 0, 1); PG8_STAGE(PG8_SB(0, 0), b2, voffB);
            PG8_BAR; PG8_WAIT_L(0); PG8_MMA(0, 1, At, B1); PG8_BAR;
            PG8_LDA(At, 0, 1); PG8_STAGE(PG8_SA(0, 0), a2, voffA);
            PG8_BAR; PG8_WAIT_L(0); PG8_MMA(1, 0, At, B0); PG8_BAR; PG8_SCHED;
            PG8_STAGE(PG8_SB(0, 1), b2 + hstep, voffB);
            PG8_WAIT_V(6); PG8_BAR; PG8_MMA(1, 1, At, B1); PG8_BAR;
            PG8_LDB(B0, 1, 0); PG8_SCHED; PG8_LDA(At, 1, 0); PG8_STAGE(PG8_SA(0, 1), a2 + hstep, voffA);
            PG8_WAIT_L(8); PG8_BAR; PG8_WAIT_L(0); PG8_MMA(0, 0, At, B0); PG8_BAR; PG8_SCHED;
            PG8_LDB(B1, 1, 1); PG8_STAGE(PG8_SB(1, 0), b3, voffB);
            PG8_BAR; PG8_WAIT_L(0); PG8_MMA(0, 1, At, B1); PG8_BAR;
            PG8_LDA(At, 1, 1); PG8_STAGE(PG8_SA(1, 0), a3, voffA);
            PG8_BAR; PG8_WAIT_L(0); PG8_MMA(1, 0, At, B0); PG8_BAR; PG8_SCHED;
            PG8_STAGE(PG8_SB(1, 1), b3 + hstep, voffB);
            PG8_WAIT_V(6); PG8_BAR; PG8_MMA(1, 1, At, B1); PG8_BAR;
            }
        }
        if constexpr (ALIGN_EPI) { if (wr == 0) PG8_BAR; }
        if constexpr (!Epi::AFTER_DRAIN) { E(acc, cur, wr, wc, fr, fq); S.done(cur); }
        if (!has_next) break;
#pragma unroll
        for (int a = 0; a < 2; ++a)
#pragma unroll
            for (int b = 0; b < 2; ++b)
#pragma unroll
                for (int m = 0; m < 4; ++m)
#pragma unroll
                    for (int n = 0; n < 2; ++n) acc[a][b][m][n] = (f32x4){0.f, 0.f, 0.f, 0.f};
        cur = nxt; cA = nA; cB = nB; ++ui;
        if constexpr (ALIGN_EPI) { if (wr == 1) PG8_BAR; }
    }
    PG8_WAIT_V(0);
    if constexpr (!ALIGN_EPI) { if (wr == 0) PG8_BAR; }
    PG8_BAR;
    if constexpr (Epi::AFTER_DRAIN) { E.fused(acc, cur, wr, wc, fr, fq, lds, wid, lane); S.done(cur); }
#undef PG8_SA
#undef PG8_SB
#undef PG8_STAGE
#undef PG8_LDA
#undef PG8_LDB
#undef PG8_MMA
#undef PG8_WAIT_V
#undef PG8_WAIT_L
#undef PG8_BAR
#undef PG8_SCHED
}
}
namespace cg = cooperative_groups;
#define LAS __attribute__((address_space(3)))
constexpr int NWAVES = 8, LDS_BYTES = 147456, RING_OFF = 0;
constexpr int PH_PRO = 0, PH_LAYER0 = 1, PH_PER_LAYER = 10, PH_END = PH_LAYER0 + 2 * PH_PER_LAYER;
constexpr int P_G1 = 0, P_MIX1 = 1, P_MIX2 = 2, P_MIX3 = 3, P_G2 = 4, P_G3 = 5, P_E1 = 6, P_G4 = 7, P_G5 = 8, P_E2 = 9;
struct Args { const float* in[29]; float* out; unsigned char* ws; int ph_lo, ph_hi; };
static_assert(sizeof(Args) == 31 * 8 + 8, "Args has no padding");

__global__ void __launch_bounds__(NWAVES * 64, 2) mega(Args args) {
    extern __shared__ __attribute__((aligned(16))) unsigned char lds_raw[];
    LAS unsigned char* lds = (LAS unsigned char*)lds_raw;
    cg::grid_group grid = cg::this_grid();
    unsigned char* ws = args.ws;
    bf16_t* XN = (bf16_t*)(ws + WS_XN); bf16_t* Z = (bf16_t*)(ws + WS_Z); bf16_t* Y = (bf16_t*)(ws + WS_Y); bf16_t* MIX = (bf16_t*)(ws + WS_MIX);
    bf16_t* OB = (bf16_t*)(ws + WS_OB); bf16_t* HID = (bf16_t*)(ws + WS_HID);
    const int G = gridDim.x, c = blockIdx.x;
    const int lo = args.ph_lo, hi = args.ph_hi;
#ifndef PHMASK
#define PHMASK 0xffffffff
#endif
#define PHM(k) ((PHMASK >> (k)) & 1)
#define IN(k) (lo <= (k) && (k) < hi)
#define SEAM(k) do { if (IN(k) && IN((k) + 1)) grid.sync(); } while (0)
    for (int l = 0; l < 2; ++l) {
        const int pb = PH_LAYER0 + l * PH_PER_LAYER;
        unsigned char* wl = ws + WS_W + (size_t)l * WS_WL;
        if (PHM(P_G1) && IN(pb + P_G1)) {
            pg8::Gemm g{XN, (const bf16_t*)(wl + W_IN), MT, NIN, DM}; pg8::StaticOrder S; S.init(MT, NIN, G, c);
            pg8::EpiZ E{Z, args.in[13] + (size_t)l * 3072};
            pg8::gemm_phase<pg8::EpiZ, pg8::StaticOrder, true, true>(lds + RING_OFF, g, S, E);
        }
        SEAM(pb + P_G1);
        if (PHM(P_G2) && IN(pb + P_G2)) {
            pg8::Gemm g{Y, (const bf16_t*)(wl + W_BR), MT, DM, YK}; pg8::StaticOrder S; S.init(MT, DM, G, c);
            pg8::EpiMix E{Z, MIX};
            pg8::gemm_phase<pg8::EpiMix, pg8::StaticOrder, true, true>(lds + RING_OFF, g, S, E);
        }
        SEAM(pb + P_G2);
        if (PHM(P_G3) && IN(pb + P_G3)) {
            pg8::Gemm g{MIX, (const bf16_t*)(wl + W_OUT), MT, DM, DM}; pg8::StaticOrder S; S.init(MT, DM, G, c);
            pg8::EpiBf<0> E{OB, DM};
            pg8::gemm_phase<pg8::EpiBf<0>, pg8::StaticOrder, true, true>(lds + RING_OFF, g, S, E);
        }
        SEAM(pb + P_G3);
        if (PHM(P_G4) && IN(pb + P_G4)) {
            pg8::Gemm g{XN, (const bf16_t*)(wl + W_UP), MT, DFF, DM}; pg8::StaticOrder S; S.init(MT, DFF, G, c);
            pg8::EpiBf<1> E{HID, DFF};
            pg8::gemm_phase<pg8::EpiBf<1>, pg8::StaticOrder, true, true>(lds + RING_OFF, g, S, E);
        }
        SEAM(pb + P_G4);
        if (PHM(P_G5) && IN(pb + P_G5)) {
            pg8::Gemm g{HID, (const bf16_t*)(wl + W_DN), MT, DM, DFF}; pg8::StaticOrder S; S.init(MT, DM, G, c);
            pg8::EpiBf<0> E{OB, DM};
            pg8::gemm_phase<pg8::EpiBf<0>, pg8::StaticOrder, true, true>(lds + RING_OFF, g, S, E);
        }
        SEAM(pb + P_G5);
    }
#undef IN
#undef SEAM
}
__global__ void __launch_bounds__(256) k_wt(const float* __restrict__ src, int K, int N, bf16_t* __restrict__ dst, int P, int koff, const float* __restrict__ scale) {
    __shared__ float t[32][33];
    const int n0 = blockIdx.x * 32, k0 = blockIdx.y * 32, tx = threadIdx.x & 31, ty = threadIdx.x >> 5;
    for (int i = ty; i < 32; i += 8) t[i][tx] = src[(size_t)(k0 + i) * N + n0 + tx] * (scale ? scale[k0 + i] : 1.f);
    __syncthreads();
    for (int i = ty; i < 32; i += 8) dst[(size_t)(n0 + i) * P + koff + k0 + tx] = f2bf(t[tx][i]);
}

__global__ void __launch_bounds__(256) k_xn(const float* __restrict__ xp, const float* __restrict__ xs, bf16_t* __restrict__ XN) {
    const int row = blockIdx.x * 4 + (threadIdx.x >> 6), lane = threadIdx.x & 63;
    if (row >= MT) return;
    const float* x = row < MP ? xp + (size_t)row * DM : xs + (size_t)(row - MP) * DM;
    float v[16]; float s = 0.f;
#pragma unroll
    for (int j = 0; j < 16; ++j) { v[j] = x[lane + 64 * j]; s += v[j] * v[j]; }
    s = wave_sum(s);
    const float rinv = rsqrtf(s * (1.f / DM) + 1e-6f);
#pragma unroll
    for (int j = 0; j < 16; ++j) XN[(size_t)row * DM + lane + 64 * j] = f2bf(v[j] * rinv);
}

__global__ void __launch_bounds__(256) k_elt(const float* __restrict__ xp, const float* __restrict__ xs, const bf16_t* __restrict__ O, const float* __restrict__ g,
                                             float* __restrict__ xout, bf16_t* __restrict__ XN) {
    const int row = blockIdx.x * 4 + (threadIdx.x >> 6), lane = threadIdx.x & 63;
    if (row >= MT) return;
    const float* x = row < MP ? xp + (size_t)row * DM : xs + (size_t)(row - MP) * DM;
    float o[16], v[16]; float s = 0.f;
#pragma unroll
    for (int j = 0; j < 16; ++j) { o[j] = bf2f(O[(size_t)row * DM + lane + 64 * j]); s += o[j] * o[j]; }
    s = wave_sum(s);
    const float rinv = rsqrtf(s * (1.f / DM) + 1e-6f);
    float s2 = 0.f;
#pragma unroll
    for (int j = 0; j < 16; ++j) { v[j] = x[lane + 64 * j] + o[j] * rinv * g[lane + 64 * j]; s2 += v[j] * v[j]; }
    s2 = wave_sum(s2);
    const float rinv2 = rsqrtf(s2 * (1.f / DM) + 1e-6f);
#pragma unroll
    for (int j = 0; j < 16; ++j) { xout[(size_t)row * DM + lane + 64 * j] = v[j]; XN[(size_t)row * DM + lane + 64 * j] = f2bf(v[j] * rinv2); }
}

struct NEpiZ {
    bf16_t* Z; const float* bgate;
    DEV void operator()(int m, int n, float v) const {
        float r = v;
        if (n >= ZC_GATE) r = sigmoidf_(v + bgate[n - ZC_GATE]);
        else if ((n >= ZC_QB && n < ZC_FB) || (n >= ZC_GB && n < ZC_QC)) r = v * sigmoidf_(v);
        else if (n >= ZC_QC && n < ZC_KC) r = v * 0.125f;
        Z[(size_t)m * NIN + n] = f2bf(r);
    }
};
struct NEpiBf {
    bf16_t* O; int N;
    DEV void operator()(int m, int n, float v) const { O[(size_t)m * N + n] = f2bf(v); }
};
struct NEpiRelu2 {
    bf16_t* O; int N;
    DEV void operator()(int m, int n, float v) const { float r = fmaxf(v, 0.f); O[(size_t)m * N + n] = f2bf(r * r); }
};
template <class Epi, bool GATED>
__global__ void __launch_bounds__(256) k_gemm(const bf16_t* __restrict__ A, const bf16_t* __restrict__ Bt, int M, int N, int K, Epi E, const bf16_t* __restrict__ Zg) {
    __shared__ float sA[32][65], sB[32][65];
    const int tx = threadIdx.x & 15, ty = threadIdx.x >> 4, m0 = blockIdx.y * 64, n0 = blockIdx.x * 64;
    float acc[4][4], tot[4][4];
#pragma unroll
    for (int i = 0; i < 4; ++i)
#pragma unroll
        for (int j = 0; j < 4; ++j) { acc[i][j] = 0.f; tot[i][j] = 0.f; }
    for (int k0 = 0; k0 < K; k0 += 32) {
        if (GATED && (k0 == 512 || k0 == 1024)) {
            const int seg = k0 == 512 ? 0 : 1;
#pragma unroll
            for (int i = 0; i < 4; ++i)
#pragma unroll
                for (int j = 0; j < 4; ++j) { tot[i][j] += acc[i][j] * bf2f(Zg[(size_t)(m0 + ty * 4 + i) * NIN + ZC_GATE + seg * 1024 + n0 + tx * 4 + j]); acc[i][j] = 0.f; }
        }
        for (int i = threadIdx.x; i < 2048; i += 256) { const int r = i >> 5, c = i & 31;
            sA[c][r] = bf2f(A[(size_t)(m0 + r) * K + k0 + c]); sB[c][r] = bf2f(Bt[(size_t)(n0 + r) * K + k0 + c]); }
        __syncthreads();
#pragma unroll 8
        for (int kk = 0; kk < 32; ++kk) {
            float a[4], b[4];
#pragma unroll
            for (int i = 0; i < 4; ++i) { a[i] = sA[kk][ty * 4 + i]; b[i] = sB[kk][tx * 4 + i]; }
#pragma unroll
            for (int i = 0; i < 4; ++i)
#pragma unroll
                for (int j = 0; j < 4; ++j) acc[i][j] += a[i] * b[j];
        }
        __syncthreads();
    }
#pragma unroll
    for (int i = 0; i < 4; ++i)
#pragma unroll
        for (int j = 0; j < 4; ++j) {
            const int m = m0 + ty * 4 + i, n = n0 + tx * 4 + j;
            float v = acc[i][j];
            if (GATED) v = tot[i][j] + v * bf2f(Zg[(size_t)m * NIN + ZC_GATE + 2 * 1024 + n]);
            E(m, n, v);
        }
}

__global__ void __launch_bounds__(256) k_conv(const bf16_t* __restrict__ Z, const float* __restrict__ st_conv  , const float* __restrict__ cw  ,
                                              const float* __restrict__ cb, float* __restrict__ XC) {
    const size_t idx = (size_t)blockIdx.x * 256 + threadIdx.x;
    if (idx >= (size_t)MT * 512) return;
    const int row = (int)(idx >> 9), c = (int)(idx & 511);
    float acc = cb[c];
    if (row < MP) {
#pragma unroll
        for (int j = 0; j < 4; ++j) { const int i = row - 3 + j; if (i >= 0) acc += cw[j * 512 + c] * bf2f(Z[(size_t)i * NIN + ZC_UA + c]); }
    } else {
        const int b = (row - MP) >> 3, t = (row - MP) & 7;
#pragma unroll
        for (int j = 0; j < 4; ++j) { const int i = t - 3 + j;
            const float u = i >= 0 ? bf2f(Z[(size_t)(MP + b * 8 + i) * NIN + ZC_UA + c]) : st_conv[((size_t)b * 3 + (3 + i)) * 512 + c];
            acc += cw[j * 512 + c] * u; }
    }
    XC[idx] = acc;
}
__global__ void __launch_bounds__(256) k_gates(const float* __restrict__ XC, const float* __restrict__ wr, const float* __restrict__ br, const float* __restrict__ wi,
                                               const float* __restrict__ bi, const float* __restrict__ lam, float* __restrict__ LA, float* __restrict__ LB) {
    const size_t idx = (size_t)blockIdx.x * 256 + threadIdx.x;
    if (idx >= (size_t)MT * 512) return;
    const int row = (int)(idx >> 9), c = (int)(idx & 511), n = c >> 6, e = c & 63;
    float rp = br[c], ip = bi[c];
    const float* x = XC + (size_t)row * 512 + n * 64;
    for (int d = 0; d < 64; ++d) { const float xv = x[d]; rp += xv * wr[((size_t)n * 64 + d) * 64 + e]; ip += xv * wi[((size_t)n * 64 + d) * 64 + e]; }
    const float r = sigmoidf_(rp), ig = sigmoidf_(ip);
    const float log_a = -8.f * r * log1pf(expf(-lam[c]));
    const float a = expf(log_a);
    const float mult = (row == 0) ? 1.f : sqrtf(-expm1f(2.f * log_a));
    LA[idx] = a; LB[idx] = mult * ig * XC[idx];
}
__global__ void __launch_bounds__(256) k_lru_scan(const float* __restrict__ LA, const float* __restrict__ LB, const float* __restrict__ st_lru  ,
                                                  const bf16_t* __restrict__ Z, bf16_t* __restrict__ Y, float* __restrict__ out, int layer) {
    const int idx = blockIdx.x * 256 + threadIdx.x;
    if (idx >= 33 * 512) return;
    const int seq = idx >> 9, c = idx & 511;
    float h; int row0, T;
    if (seq == 0) { h = 0.f; row0 = 0; T = MP; } else { h = st_lru[(size_t)(seq - 1) * 512 + c]; row0 = MP + (seq - 1) * 8; T = 8; }
    for (int t = 0; t < T; ++t) { const size_t i = (size_t)(row0 + t) * 512 + c; h = LA[i] * h + LB[i]; Y[(size_t)(row0 + t) * YK + c] = f2bf(h); }
    if (seq == 0) {
        out[O_LRUP + (size_t)layer * 512 + c] = h;
        for (int j = 0; j < 3; ++j) out[O_CONVP + ((size_t)layer * 3 + j) * 512 + c] = bf2f(Z[(size_t)(MP - 3 + j) * NIN + ZC_UA + c]);
    } else {
        const int b = seq - 1;
        out[O_LRUS + ((size_t)layer * 32 + b) * 512 + c] = h;
        for (int j = 0; j < 3; ++j) out[O_CONVS + (((size_t)layer * 32 + b) * 3 + j) * 512 + c] = bf2f(Z[(size_t)(MP + b * 8 + 5 + j) * NIN + ZC_UA + c]);
    }
}

__global__ void __launch_bounds__(256) k_hgrn_seq(const bf16_t* __restrict__ Z, const float* __restrict__ st_hg  , const float* __restrict__ lbraw  ,
                                                  float* __restrict__ HRAW, float* __restrict__ out, int layer) {
    const int w = blockIdx.x * 4 + (threadIdx.x >> 6), lane = threadIdx.x & 63;
    if (w >= 33 * 512) return;
    const int seq = w >> 9, h = (w >> 7) & 3, dv = w & 127;
    float lb0 = 0.f, lb1 = 0.f;
    if (layer == 1) { lb0 = sigmoidf_(lbraw[512 + h * 128 + lane] - lbraw[h * 128 + lane]); lb1 = sigmoidf_(lbraw[512 + h * 128 + lane + 64] - lbraw[h * 128 + lane + 64]); }
    float S0 = 0.f, S1 = 0.f; int row0 = 0, T = MP;
    if (seq > 0) { const int b = seq - 1; row0 = MP + b * 8; T = 8;
        S0 = st_hg[(((size_t)b * 4 + h) * 128 + lane) * 128 + dv]; S1 = st_hg[(((size_t)b * 4 + h) * 128 + lane + 64) * 128 + dv]; }
    for (int t = 0; t < T; ++t) {
        const bf16_t* z = Z + (size_t)(row0 + t) * NIN;
        const float q0 = bf2f(z[ZC_QB + h * 128 + lane]), q1 = bf2f(z[ZC_QB + h * 128 + lane + 64]);
        const float s0 = sigmoidf_(bf2f(z[ZC_FB + h * 128 + lane])), s1 = sigmoidf_(bf2f(z[ZC_FB + h * 128 + lane + 64]));
        const float v = bf2f(z[ZC_IB + h * 128 + dv]);
        const float f0 = lb0 + (1.f - lb0) * s0, f1 = lb1 + (1.f - lb1) * s1;
        const float k0 = (1.f - lb0) * (1.f - s0), k1 = (1.f - lb1) * (1.f - s1);
        S0 = f0 * S0 + k0 * v; S1 = f1 * S1 + k1 * v;
        const float o = wave_sum(S0 * q0 + S1 * q1);
        if (lane == 0) HRAW[(size_t)(row0 + t) * 512 + h * 128 + dv] = o;
    }
    if (seq == 0) { out[O_HGP + (((size_t)layer * 4 + h) * 128 + lane) * 128 + dv] = S0; out[O_HGP + (((size_t)layer * 4 + h) * 128 + lane + 64) * 128 + dv] = S1; }
    else { const int b = seq - 1;
        out[O_HGS + ((((size_t)layer * 32 + b) * 4 + h) * 128 + lane) * 128 + dv] = S0; out[O_HGS + ((((size_t)layer * 32 + b) * 4 + h) * 128 + lane + 64) * 128 + dv] = S1; }
}
__global__ void __launch_bounds__(256) k_hgrn_post(const float* __restrict__ HRAW, const bf16_t* __restrict__ Z, const float* __restrict__ ng  , bf16_t* __restrict__ Y) {
    const int w = blockIdx.x * 4 + (threadIdx.x >> 6), lane = threadIdx.x & 63;
    if (w >= MT * 4) return;
    const int row = w >> 2, h = w & 3;
    const float o0 = HRAW[(size_t)row * 512 + h * 128 + lane], o1 = HRAW[(size_t)row * 512 + h * 128 + lane + 64];
    const float s = wave_sum(o0 * o0 + o1 * o1);
    const float rinv = rsqrtf(s * (1.f / 128.f) + 1e-6f);
    Y[(size_t)row * YK + 512 + h * 128 + lane] = f2bf(o0 * rinv * ng[lane] * bf2f(Z[(size_t)row * NIN + ZC_GB + h * 128 + lane]));
    Y[(size_t)row * YK + 512 + h * 128 + lane + 64] = f2bf(o1 * rinv * ng[lane + 64] * bf2f(Z[(size_t)row * NIN + ZC_GB + h * 128 + lane + 64]));
}

DEV float dot_row_bf(const float (&q)[64], const bf16_t* __restrict__ p) {
    float s = 0.f;
#pragma unroll
    for (int d8 = 0; d8 < 8; ++d8) { const uint4 u = *(const uint4*)(p + d8 * 8); const unsigned w[4] = {u.x, u.y, u.z, u.w};
#pragma unroll
        for (int i = 0; i < 4; ++i) { s += q[d8 * 8 + 2 * i] * __uint_as_float(w[i] << 16); s += q[d8 * 8 + 2 * i + 1] * __uint_as_float(w[i] & 0xffff0000u); } }
    return s;
}
DEV float dot_row_f(const float (&q)[64], const float* __restrict__ p) {
    float s = 0.f;
#pragma unroll
    for (int d4 = 0; d4 < 16; ++d4) { const float4 u = *(const float4*)(p + d4 * 4); s += q[d4 * 4] * u.x + q[d4 * 4 + 1] * u.y + q[d4 * 4 + 2] * u.z + q[d4 * 4 + 3] * u.w; }
    return s;
}
__global__ void __launch_bounds__(256) k_attn(const bf16_t* __restrict__ Z, const float* __restrict__ c128, const float* __restrict__ c512, const float* __restrict__ c2048  ,
                                              bf16_t* __restrict__ Y) {
    const int w = blockIdx.x * 4 + (threadIdx.x >> 6), lane = threadIdx.x & 63;
    if (w >= MT * 4) return;
    const int row = w >> 2, hh = w & 3;
    const bool prompt = row < MP;
    const int b = prompt ? 0 : (row - MP) >> 3, t = prompt ? row : (row - MP) & 7;
    float og[3], lse[3];
#pragma unroll
    for (int g = 0; g < 3; ++g) {
        const int dil = g == 0 ? 1 : (g == 1 ? 4 : 16), Wc = 128 * dil, hd = g * 4 + hh;
        const float* cache = g == 0 ? c128 : (g == 1 ? c512 : c2048);
        float q[64];
        { const bf16_t* qp = Z + (size_t)row * NIN + ZC_QC + hd * 64;
#pragma unroll
          for (int d8 = 0; d8 < 8; ++d8) { const uint4 u = *(const uint4*)(qp + d8 * 8); const unsigned ww[4] = {u.x, u.y, u.z, u.w};
#pragma unroll
              for (int i = 0; i < 4; ++i) { q[d8 * 8 + 2 * i] = __uint_as_float(ww[i] << 16); q[d8 * 8 + 2 * i + 1] = __uint_as_float(ww[i] & 0xffff0000u); } } }
        float s[3]; bool val[3];
#pragma unroll
        for (int sl = 0; sl < 3; ++sl) {
            const int j = lane + 64 * sl;
            s[sl] = -1e30f; val[sl] = false;
            if (j <= 128) {
                if (prompt) { const int tk = t - dil * j; if (tk >= 0) { val[sl] = true; s[sl] = dot_row_bf(q, Z + (size_t)tk * NIN + ZC_KC + hd * 64); } }
                else { const int idx = dil * (128 - j) + t; val[sl] = true;
                    if (idx < Wc) s[sl] = dot_row_f(q, cache + ((size_t)b * Wc + idx) * 512 + hh * 64);
                    else s[sl] = dot_row_bf(q, Z + (size_t)(MP + b * 8 + idx - Wc) * NIN + ZC_KC + hd * 64); }
            }
        }
        const float m = wave_max(fmaxf(s[0], fmaxf(s[1], s[2])));
        float p[3];
#pragma unroll
        for (int sl = 0; sl < 3; ++sl) p[sl] = val[sl] ? expf(s[sl] - m) : 0.f;
        const float l = wave_sum(p[0] + p[1] + p[2]);
        float acc = 0.f;
        for (int j = 0; j <= 128; ++j) {
            const float pj = __shfl(j < 64 ? p[0] : (j < 128 ? p[1] : p[2]), j & 63);
            float v = 0.f;
            if (prompt) { const int tk = t - dil * j; if (tk >= 0) v = bf2f(Z[(size_t)tk * NIN + ZC_VC + hd * 64 + lane]); }
            else { const int idx = dil * (128 - j) + t;
                if (idx < Wc) v = cache[((size_t)b * Wc + idx) * 512 + 256 + hh * 64 + lane];
                else v = bf2f(Z[(size_t)(MP + b * 8 + idx - Wc) * NIN + ZC_VC + hd * 64 + lane]); }
            acc += pj * v;
        }
        og[g] = acc / l; lse[g] = m + logf(l);
    }
    const float mx = fmaxf(lse[0], fmaxf(lse[1], lse[2]));
    const float w0 = expf(lse[0] - mx), w1 = expf(lse[1] - mx), w2 = expf(lse[2] - mx);
    Y[(size_t)row * YK + 1024 + hh * 64 + lane] = f2bf((w0 * og[0] + w1 * og[1] + w2 * og[2]) / (w0 + w1 + w2));
}

__global__ void __launch_bounds__(256) k_cache(const bf16_t* __restrict__ Z, const float* __restrict__ cin  , float* __restrict__ outs  ,
                                               float* __restrict__ outp  , int Wc, int g) {
    const size_t n4s = (size_t)32 * Wc * 128, n4p = (size_t)Wc * 128;
    for (size_t i = (size_t)blockIdx.x * 256 + threadIdx.x; i < n4s + n4p; i += (size_t)gridDim.x * 256) {
        if (i < n4s) {
            const int e4 = (int)(i & 127); const size_t r = i >> 7; const int b = (int)(r / Wc), ri = (int)(r % Wc);
            float4 v;
            if (ri + 8 < Wc) v = *(const float4*)(cin + ((size_t)b * Wc + ri + 8) * 512 + e4 * 4);
            else { const int tt = ri + 8 - Wc, e = e4 * 4, kv = e >> 8, hh = (e >> 6) & 3, d = e & 63;
                const bf16_t* z = Z + (size_t)(MP + b * 8 + tt) * NIN + (kv ? ZC_VC : ZC_KC) + (g * 4 + hh) * 64 + d;
                v = make_float4(bf2f(z[0]), bf2f(z[1]), bf2f(z[2]), bf2f(z[3])); }
            *(float4*)(outs + r * 512 + e4 * 4) = v;
        } else {
            const size_t ip = i - n4s; const int e4 = (int)(ip & 127), ri = (int)(ip >> 7), e = e4 * 4, kv = e >> 8, hh = (e >> 6) & 3, d = e & 63;
            const bf16_t* z = Z + (size_t)(MP - Wc + ri) * NIN + (kv ? ZC_VC : ZC_KC) + (g * 4 + hh) * 64 + d;
            *(float4*)(outp + (size_t)ri * 512 + e4 * 4) = make_float4(bf2f(z[0]), bf2f(z[1]), bf2f(z[2]), bf2f(z[3]));
        }
    }
}

extern "C" void kernel_launch(void* const* d_in, const int* in_sizes, int n_in, void* d_out, int out_size, void* d_ws, size_t ws_size, hipStream_t stream) {
    const float* const* in = (const float* const*)d_in;
    float* out = (float*)d_out; unsigned char* ws = (unsigned char*)d_ws;
    bf16_t* XN = (bf16_t*)(ws + WS_XN); bf16_t* Z = (bf16_t*)(ws + WS_Z); bf16_t* Y = (bf16_t*)(ws + WS_Y); bf16_t* MIX = (bf16_t*)(ws + WS_MIX);
    bf16_t* OB = (bf16_t*)(ws + WS_OB); float* X1 = (float*)(ws + WS_X1); float* X2 = (float*)(ws + WS_X2); bf16_t* HID = (bf16_t*)(ws + WS_HID);
    float* XC = (float*)(ws + WS_XC); float* LA = (float*)(ws + WS_LA); float* LBb = (float*)(ws + WS_LB); float* HRAW = (float*)(ws + WS_HRAW);
    static int grid = 0;
    if (grid == 0) {
        int dev = 0, cus = 0, per_cu = 0;
        hipGetDevice(&dev); hipDeviceGetAttribute(&cus, hipDeviceAttributeMultiprocessorCount, dev);
        hipFuncSetAttribute((const void*)mega, hipFuncAttributeMaxDynamicSharedMemorySize, LDS_BYTES);
        hipOccupancyMaxActiveBlocksPerMultiprocessor(&per_cu, (const void*)mega, NWAVES * 64, LDS_BYTES);
        if (per_cu < 1) per_cu = 1;
        grid = cus * 1;
        (void)hipGetLastError();
    }
    Args a{};
    for (int i = 0; i < 29; ++i) a.in[i] = (const float*)d_in[i];
    a.out = out; a.ws = ws;
    auto run = [&](int lo, int hi) { a.ph_lo = lo; a.ph_hi = hi; hipLaunchKernelGGL(mega, dim3(grid), dim3(NWAVES * 64), LDS_BYTES, stream, a); };
    for (int l = 0; l < 2; ++l) {
        unsigned char* wl = ws + WS_W + l * WS_WL;
        k_wt<<<dim3(NIN / 32, DM / 32), 256, 0, stream>>>(in[12] + (size_t)l * DM * NIN, DM, NIN, (bf16_t*)(wl + W_IN), DM, 0, in[8] + l * DM);
        k_wt<<<dim3(DM / 32, 512 / 32), 256, 0, stream>>>(in[23] + (size_t)l * 512 * DM, 512, DM, (bf16_t*)(wl + W_BR), YK, 0, nullptr);
        k_wt<<<dim3(DM / 32, 512 / 32), 256, 0, stream>>>(in[24] + (size_t)l * 512 * DM, 512, DM, (bf16_t*)(wl + W_BR), YK, 512, nullptr);
        k_wt<<<dim3(DM / 32, 256 / 32), 256, 0, stream>>>(in[25] + (size_t)l * 256 * DM, 256, DM, (bf16_t*)(wl + W_BR), YK, 1024, nullptr);
        k_wt<<<dim3(DM / 32, DM / 32), 256, 0, stream>>>(in[26] + (size_t)l * DM * DM, DM, DM, (bf16_t*)(wl + W_OUT), DM, 0, nullptr);
        k_wt<<<dim3(DFF / 32, DM / 32), 256, 0, stream>>>(in[27] + (size_t)l * DM * DFF, DM, DFF, (bf16_t*)(wl + W_UP), DM, 0, in[10] + l * DM);
        k_wt<<<dim3(DM / 32, DFF / 32), 256, 0, stream>>>(in[28] + (size_t)l * DFF * DM, DFF, DM, (bf16_t*)(wl + W_DN), DFF, 0, nullptr);
    }
    k_xn<<<MT / 4, 256, 0, stream>>>(in[0], in[1], XN);
    const int Wcs[3] = {128, 512, 2048};
    const size_t ocs[3] = {O_W128S, O_W512S, O_W2048S}, ocp[3] = {O_W128P, O_W512P, O_W2048P};
    for (int l = 0; l < 2; ++l) {
        unsigned char* wl = ws + WS_W + l * WS_WL;
        run(PH_LAYER0 + l * PH_PER_LAYER + P_G1, PH_LAYER0 + l * PH_PER_LAYER + P_G1 + 1);
        for (int g = 0; g < 3; ++g) {
            const int Wc = Wcs[g];
            k_cache<<<2048, 256, 0, stream>>>(Z, in[5 + g] + (size_t)l * 32 * Wc * 512, out + ocs[g] + (size_t)l * 32 * Wc * 512, out + ocp[g] + (size_t)l * Wc * 512, Wc, g);
        }
        k_conv<<<MT * 512 / 256, 256, 0, stream>>>(Z, in[2] + (size_t)l * 32 * 3 * 512, in[14] + (size_t)l * 4 * 512, in[15] + (size_t)l * 512, XC);
        k_gates<<<MT * 512 / 256, 256, 0, stream>>>(XC, in[16] + (size_t)l * 8 * 64 * 64, in[17] + (size_t)l * 512, in[18] + (size_t)l * 8 * 64 * 64, in[19] + (size_t)l * 512,
                                                    in[20] + (size_t)l * 512, LA, LBb);
        k_lru_scan<<<33 * 512 / 256, 256, 0, stream>>>(LA, LBb, in[3] + (size_t)l * 32 * 512, Z, Y, out, l);
        k_hgrn_seq<<<33 * 512 / 4, 256, 0, stream>>>(Z, in[4] + (size_t)l * 32 * 4 * 128 * 128, in[21], HRAW, out, l);
        k_hgrn_post<<<MT, 256, 0, stream>>>(HRAW, Z, in[22] + (size_t)l * 128, Y);
        k_attn<<<MT, 256, 0, stream>>>(Z, in[5] + (size_t)l * 32 * 128 * 512, in[6] + (size_t)l * 32 * 512 * 512, in[7] + (size_t)l * 32 * 2048 * 512, Y);
        run(PH_LAYER0 + l * PH_PER_LAYER + P_G2, PH_LAYER0 + l * PH_PER_LAYER + P_G2 + 1);
        run(PH_LAYER0 + l * PH_PER_LAYER + P_G3, PH_LAYER0 + l * PH_PER_LAYER + P_G3 + 1);
        const float* xp = l == 0 ? in[0] : X2; const float* xs = l == 0 ? in[1] : X2 + (size_t)MP * DM;
        k_elt<<<MT / 4, 256, 0, stream>>>(xp, xs, OB, in[9] + (size_t)l * DM, X1, XN);
        run(PH_LAYER0 + l * PH_PER_LAYER + P_G4, PH_LAYER0 + l * PH_PER_LAYER + P_G4 + 1);
        run(PH_LAYER0 + l * PH_PER_LAYER + P_G5, PH_LAYER0 + l * PH_PER_LAYER + P_G5 + 1);
        float* xo = l == 0 ? X2 : out;
        k_elt<<<MT / 4, 256, 0, stream>>>(X1, X1 + (size_t)MP * DM, OB, in[11] + (size_t)l * DM, xo, XN);
    }
}
```

```cpp
#include <hip/hip_runtime.h>
#include <stdint.h>

typedef unsigned short bf16_t;
#define DEV __device__ __forceinline__

DEV float bf2f(bf16_t b) { return __uint_as_float(((unsigned)b) << 16); }
DEV bf16_t f2bf(float f) { unsigned u = __float_as_uint(f); u += 0x7fffu + ((u >> 16) & 1u); return (bf16_t)(u >> 16); }
DEV float sigmoidf_(float x) { return 1.f / (1.f + expf(-x)); }
DEV float wave_sum(float v) {
#pragma unroll
    for (int o = 1; o < 64; o <<= 1) v += __shfl_xor(v, o);
    return v;
}
DEV float wave_max(float v) {
#pragma unroll
    for (int o = 1; o < 64; o <<= 1) v = fmaxf(v, __shfl_xor(v, o));
    return v;
}

constexpr int MP = 16384, MS = 256, MT = MP + MS;
constexpr int DM = 1024, NIN = 7936, DFF = 4096, YK = 1280;
constexpr int ZC_UA = 0, ZC_QB = 512, ZC_FB = 1024, ZC_IB = 1536, ZC_GB = 2048, ZC_QC = 2560, ZC_KC = 3328, ZC_VC = 4096, ZC_GATE = 4864;
constexpr int NB = 32, NT = 8;
constexpr size_t O_Y = 0, O_CONVP = 17039360, O_CONVS = 17042432, O_LRUP = 17140736, O_LRUS = 17141760, O_HGP = 17174528, O_HGS = 17305600,
                 O_W128P = 21499904, O_W128S = 21630976, O_W512P = 25825280, O_W512S = 26349568, O_W2048P = 43126784, O_W2048S = 45223936;
constexpr size_t MiB = 1u << 20;
constexpr size_t WS_W = 1 * MiB, WS_WL = 40 * MiB;
constexpr size_t W_IN = 0, W_BR = 16 * MiB, W_OUT = 19 * MiB, W_UP = 21 * MiB, W_DN = 29 * MiB;
constexpr size_t WS_XN = 82 * MiB, WS_Z = 116 * MiB, WS_Y = 368 * MiB, WS_MIX = 409 * MiB, WS_OB = 442 * MiB, WS_X1 = 475 * MiB, WS_X2 = 540 * MiB,
                 WS_HID = 605 * MiB, WS_XC = 735 * MiB, WS_LA = 768 * MiB, WS_LB = 801 * MiB, WS_HRAW = 834 * MiB;

#include <hip/hip_cooperative_groups.h>
namespace pg8 {
#define PG8_LAS __attribute__((address_space(3)))
typedef unsigned short bf16_t;
typedef short bf16x8 __attribute__((ext_vector_type(8)));
typedef float f32x4 __attribute__((ext_vector_type(4)));
typedef unsigned u32x4 __attribute__((ext_vector_type(4)));
constexpr int BM = 256, BK = 64, HALF = 128, HTB = HALF * BK * 2  , STAGE_BYTES = 8 * HTB, NXCD = 8, WGM = 8;

__host__ __device__ __forceinline__ int lds_byte(int r, int c) { const int st = (r >> 4) * 2 + (c >> 5), rr = r & 15, cc = c & 31, ob = rr * 64 + cc * 2; return st * 1024 + (ob ^ (((ob >> 9) & 1) << 5)); }
__host__ __device__ __forceinline__ void stage_rc(int b, int& R, int& C) { const int st = b / 1024, sb = b % 1024, swz = sb ^ (((sb >> 9) & 1) << 5); R = (st >> 1) * 16 + swz / 64; C = (st & 1) * 32 + (swz % 64) / 2; }
__host__ __device__ __forceinline__ int perm32(int rho) { const int n = rho >> 4, i = rho & 15; return 8 * (i >> 2) + 4 * n + (i & 3); }

struct Unit { int pm, pn; };
struct Gemm { const bf16_t* A; const bf16_t* Bt; int M, N, K; };

struct StaticOrder {
    int nM, nN, nwg, G, c;
    __host__ __device__ void init(int M, int N, int G_, int c_) { nM = M / BM; nN = N / BM; nwg = nM * nN; G = G_; c = c_; }
    __host__ __device__ bool next(int i, Unit& u) const {
        const long L = (long)i * G + c; if (L >= nwg) return false;
        int wgid = (int)L; { const int q = nwg / NXCD, r = nwg % NXCD, xcd = wgid % NXCD, off = wgid / NXCD; wgid = (xcd < r ? xcd * (q + 1) : r * (q + 1) + (xcd - r) * q) + off; }
        const int nig = WGM * nN, gid = wgid / nig, fm = gid * WGM, gsz = (nM - fm) < WGM ? (nM - fm) : WGM;
        u.pm = fm + ((wgid % nig) % gsz); u.pn = (wgid % nig) / gsz; return true;
    }
    __device__ __forceinline__ void a_ready(const Unit&) const {}
    __device__ __forceinline__ void done(const Unit&) const {}
};
__device__ __forceinline__ unsigned cvt_pk_bf16(float lo, float hi) { unsigned r; asm volatile("v_cvt_pk_bf16_f32 %0, %1, %2" : "=v"(r) : "v"(lo), "v"(hi)); return r; }
__device__ __forceinline__ float fsig(float x) { return __builtin_amdgcn_rcpf(1.f + __expf(-x)); }
__device__ __forceinline__ float bflo(unsigned w) { return __uint_as_float(w << 16); }
__device__ __forceinline__ float bfhi(unsigned w) { return __uint_as_float(w & 0xffff0000u); }
constexpr int ZP = 7936;
struct EpiZ {
    static constexpr bool PERM = true, AFTER_DRAIN = false, HOOK = false;
    bf16_t* Z; const float* bgate;
    __device__ __forceinline__ void operator()(const f32x4 (&acc)[2][2][4][2], const Unit& u, int wr, int wc, int fr, int fq) const {
        const int colt = u.pn * BM;
        const int mode = colt >= 4864 ? 3 : (((colt >= 512 && colt < 1024) || (colt >= 2048 && colt < 2560)) ? 1 : ((colt >= 2560 && colt < 3328) ? 2 : 0));
        const int row0 = u.pm * BM + wr * 64 + fr, col0 = colt + wc * 32 + 8 * fq;
        f32x4 bv[2][2];
#pragma unroll
        for (int bj = 0; bj < 2; ++bj)
#pragma unroll
            for (int n = 0; n < 2; ++n) bv[bj][n] = mode == 3 ? *(const f32x4*)(bgate + (col0 - 4864) + bj * HALF + 4 * n) : (f32x4){0.f, 0.f, 0.f, 0.f};
#pragma unroll
        for (int ai = 0; ai < 2; ++ai)
#pragma unroll
            for (int m = 0; m < 4; ++m) { bf16_t* rowp = Z + (size_t)(row0 + ai * HALF + m * 16) * ZP + col0;
#pragma unroll
                for (int bj = 0; bj < 2; ++bj) { f32x4 v0 = acc[ai][bj][m][0] + bv[bj][0], v1 = acc[ai][bj][m][1] + bv[bj][1];
                    if (mode == 3) {
#pragma unroll
                        for (int j = 0; j < 4; ++j) { v0[j] = fsig(v0[j]); v1[j] = fsig(v1[j]); } }
                    else if (mode == 1) {
#pragma unroll
                        for (int j = 0; j < 4; ++j) { v0[j] = v0[j] * fsig(v0[j]); v1[j] = v1[j] * fsig(v1[j]); } }
                    else if (mode == 2) { v0 = v0 * 0.125f; v1 = v1 * 0.125f; }
                    u32x4 w; w.x = cvt_pk_bf16(v0[0], v0[1]); w.y = cvt_pk_bf16(v0[2], v0[3]); w.z = cvt_pk_bf16(v1[0], v1[1]); w.w = cvt_pk_bf16(v1[2], v1[3]);
                    *(u32x4*)(rowp + bj * HALF) = w; } }
    }
};
template <int ACT  > struct EpiBf {
    static constexpr bool PERM = true, AFTER_DRAIN = false, HOOK = false;
    bf16_t* O; int ldc;
    __device__ __forceinline__ void operator()(const f32x4 (&acc)[2][2][4][2], const Unit& u, int wr, int wc, int fr, int fq) const {
        const int row0 = u.pm * BM + wr * 64 + fr, col0 = u.pn * BM + wc * 32 + 8 * fq;
#pragma unroll
        for (int ai = 0; ai < 2; ++ai)
#pragma unroll
            for (int m = 0; m < 4; ++m) { bf16_t* rowp = O + (size_t)(row0 + ai * HALF + m * 16) * ldc + col0;
#pragma unroll
                for (int bj = 0; bj < 2; ++bj) { f32x4 v0 = acc[ai][bj][m][0], v1 = acc[ai][bj][m][1];
                    if (ACT == 1) {
#pragma unroll
                        for (int j = 0; j < 4; ++j) { const float a = fmaxf(v0[j], 0.f), b = fmaxf(v1[j], 0.f); v0[j] = a * a; v1[j] = b * b; } }
                    u32x4 w; w.x = cvt_pk_bf16(v0[0], v0[1]); w.y = cvt_pk_bf16(v0[2], v0[3]); w.z = cvt_pk_bf16(v1[0], v1[1]); w.w = cvt_pk_bf16(v1[2], v1[3]);
                    *(u32x4*)(rowp + bj * HALF) = w; } }
    }
};
struct EpiMix {
    static constexpr bool PERM = true, AFTER_DRAIN = false, HOOK = true;
    const bf16_t* Z; bf16_t* O;
    __device__ __forceinline__ void hook(f32x4 (&acc)[2][2][4][2], const Unit& u, int wr, int wc, int fr, int fq, int t) const {
        const int seg = t == 8 ? 0 : 1;
        int row0 = u.pm * BM + wr * 64 + fr; const int col0 = u.pn * BM + wc * 32 + 8 * fq;
        asm volatile("" : "+v"(row0));
#pragma unroll
        for (int ai = 0; ai < 2; ++ai)
#pragma unroll
            for (int m = 0; m < 4; ++m) { const bf16_t* gp = (const bf16_t*)((const char*)Z + (unsigned)(((row0 + ai * HALF + m * 16) * ZP + 4864 + seg * 1024 + col0) * 2));
#pragma unroll
                for (int bj = 0; bj < 2; ++bj) { const u32x4 ga = *(const u32x4*)(gp + bj * HALF), gb = *(const u32x4*)(gp + 1024 + bj * HALF);
                    f32x4 r0, r1;
                    r0[0] = fmaxf(bflo(ga.x), 1e-30f) * __builtin_amdgcn_rcpf(fmaxf(bflo(gb.x), 1e-30f)); r0[1] = fmaxf(bfhi(ga.x), 1e-30f) * __builtin_amdgcn_rcpf(fmaxf(bfhi(gb.x), 1e-30f));
                    r0[2] = fmaxf(bflo(ga.y), 1e-30f) * __builtin_amdgcn_rcpf(fmaxf(bflo(gb.y), 1e-30f)); r0[3] = fmaxf(bfhi(ga.y), 1e-30f) * __builtin_amdgcn_rcpf(fmaxf(bfhi(gb.y), 1e-30f));
                    r1[0] = fmaxf(bflo(ga.z), 1e-30f) * __builtin_amdgcn_rcpf(fmaxf(bflo(gb.z), 1e-30f)); r1[1] = fmaxf(bfhi(ga.z), 1e-30f) * __builtin_amdgcn_rcpf(fmaxf(bfhi(gb.z), 1e-30f));
                    r1[2] = fmaxf(bflo(ga.w), 1e-30f) * __builtin_amdgcn_rcpf(fmaxf(bflo(gb.w), 1e-30f)); r1[3] = fmaxf(bfhi(ga.w), 1e-30f) * __builtin_amdgcn_rcpf(fmaxf(bfhi(gb.w), 1e-30f));
                    acc[ai][bj][m][0] = acc[ai][bj][m][0] * r0; acc[ai][bj][m][1] = acc[ai][bj][m][1] * r1;
                    asm volatile("" ::: "memory"); } }
    }
    __device__ __forceinline__ void operator()(const f32x4 (&acc)[2][2][4][2], const Unit& u, int wr, int wc, int fr, int fq) const {
        int row0 = u.pm * BM + wr * 64 + fr; const int col0 = u.pn * BM + wc * 32 + 8 * fq;
        asm volatile("" : "+v"(row0));
#pragma unroll
        for (int ai = 0; ai < 2; ++ai)
#pragma unroll
            for (int m = 0; m < 4; ++m) { const int row = row0 + ai * HALF + m * 16; const bf16_t* gp = (const bf16_t*)((const char*)Z + (unsigned)((row * ZP + 4864 + 2048 + col0) * 2)); bf16_t* rowp = (bf16_t*)((char*)O + (unsigned)((row * 1024 + col0) * 2));
#pragma unroll
                for (int bj = 0; bj < 2; ++bj) { const u32x4 g = *(const u32x4*)(gp + bj * HALF);
                    f32x4 v0 = acc[ai][bj][m][0], v1 = acc[ai][bj][m][1];
                    v0[0] *= fmaxf(bflo(g.x), 1e-30f); v0[1] *= fmaxf(bfhi(g.x), 1e-30f); v0[2] *= fmaxf(bflo(g.y), 1e-30f); v0[3] *= fmaxf(bfhi(g.y), 1e-30f);
                    v1[0] *= fmaxf(bflo(g.z), 1e-30f); v1[1] *= fmaxf(bfhi(g.z), 1e-30f); v1[2] *= fmaxf(bflo(g.w), 1e-30f); v1[3] *= fmaxf(bfhi(g.w), 1e-30f);
                    u32x4 w; w.x = cvt_pk_bf16(v0[0], v0[1]); w.y = cvt_pk_bf16(v0[2], v0[3]); w.z = cvt_pk_bf16(v1[0], v1[1]); w.w = cvt_pk_bf16(v1[2], v1[3]);
                    *(u32x4*)(rowp + bj * HALF) = w; }
                asm volatile("" ::: "memory"); }
    }
};
template <class Epi, class Sched, bool ALIGN_EPI = false, bool SP2 = false>
__device__ __forceinline__ void gemm_phase(PG8_LAS unsigned char* lds, const Gemm g, const Sched& S, const Epi& E) {
    int tid_ = threadIdx.x; asm volatile("" : "+v"(tid_));
    const int tid = tid_, wid = __builtin_amdgcn_readfirstlane(tid >> 6), lane = tid & 63, wr = wid >> 2, wc = wid & 3, fr = lane & 15, fq = lane >> 4;
    const int K = g.K, nt = K / BK;
    unsigned voffA[2], voffB[2];
#pragma unroll
    for (int i = 0; i < 2; ++i) { int R, C; stage_rc(tid * 16 + i * 8192, R, C); const int Rb = Epi::PERM ? ((R & ~31) + perm32(R & 31)) : R;
        voffA[i] = (unsigned)(R * K + C) * 2u; voffB[i] = (unsigned)(Rb * K + C) * 2u; }
    const size_t kstep = (size_t)(BK * 2);
    const size_t hstep = (size_t)HALF * K * 2;
    const size_t tstep = 2 * hstep;
    const unsigned ldsw = (unsigned)wid * 1024u;
    const int aoff = lds_byte(wr * 64 + fr, fq * 8), boff = lds_byte(wc * 32 + fr, fq * 8);
#define PG8_SA(b, h) (((b) * 2 + (h)) * HTB)
#define PG8_SB(b, h) ((4 + (b) * 2 + (h)) * HTB)
#define PG8_STAGE(bufoff, gbase, voff) do { _Pragma("unroll") for (int _i = 0; _i < 2; ++_i) \
        __builtin_amdgcn_global_load_lds((const unsigned*)((const char*)(gbase) + (voff)[_i]), (PG8_LAS unsigned*)(lds + (bufoff) + ldsw + _i * 8192), 16, 0, 0); } while (0)
#define PG8_LDA(dst, b, h) do { _Pragma("unroll") for (int m = 0; m < 4; ++m) _Pragma("unroll") for (int k = 0; k < 2; ++k) dst[m][k] = *(const PG8_LAS bf16x8*)(lds + PG8_SA(b, h) + aoff + m * 2048 + k * 1024); } while (0)
#define PG8_LDB(dst, b, h) do { _Pragma("unroll") for (int n = 0; n < 2; ++n) _Pragma("unroll") for (int k = 0; k < 2; ++k) dst[n][k] = *(const PG8_LAS bf16x8*)(lds + PG8_SB(b, h) + boff + n * 2048 + k * 1024); } while (0)
#define PG8_MMA(ai, bj, At, Bt) do { __builtin_amdgcn_s_setprio(1); _Pragma("unroll") for (int m = 0; m < 4; ++m) _Pragma("unroll") for (int n = 0; n < 2; ++n) _Pragma("unroll") for (int k = 0; k < 2; ++k) \
        acc[ai][bj][m][n] = __builtin_amdgcn_mfma_f32_16x16x32_bf16(Bt[n][k], At[m][k], acc[ai][bj][m][n], 0, 0, 0); __builtin_amdgcn_s_setprio(0); } while (0)
#define PG8_WAIT_V(n) asm volatile("s_waitcnt vmcnt(" #n ")" ::: "memory")
#define PG8_WAIT_L(n) asm volatile("s_waitcnt lgkmcnt(" #n ")" ::: "memory")
#define PG8_BAR __builtin_amdgcn_s_barrier()
#define PG8_SCHED __builtin_amdgcn_sched_barrier(0)
    Unit cur, nxt; int ui = 0;
    if (!S.next(0, cur)) return;
    f32x4 acc[2][2][4][2];
#pragma unroll
    for (int a = 0; a < 2; ++a)
#pragma unroll
        for (int b = 0; b < 2; ++b)
#pragma unroll
            for (int m = 0; m < 4; ++m)
#pragma unroll
                for (int n = 0; n < 2; ++n) acc[a][b][m][n] = (f32x4){0.f, 0.f, 0.f, 0.f};
    bf16x8 At[4][2], B0[2][2], B1[2][2];
    const char* cA = (const char*)g.A + (size_t)cur.pm * tstep; const char* cB = (const char*)g.Bt + (size_t)cur.pn * tstep;
    S.a_ready(cur);
    if constexpr (SP2) {
        PG8_STAGE(PG8_SB(0, 0), cB, voffB); PG8_STAGE(PG8_SB(0, 1), cB + hstep, voffB); PG8_STAGE(PG8_SA(0, 0), cA, voffA); PG8_STAGE(PG8_SA(0, 1), cA + hstep, voffA);
        if (wr == 1) PG8_BAR;
        PG8_WAIT_V(2); PG8_BAR;
        PG8_STAGE(PG8_SB(1, 0), cB + kstep, voffB); PG8_STAGE(PG8_SA(1, 0), cA + kstep, voffA); PG8_STAGE(PG8_SB(1, 1), cB + hstep + kstep, voffB);
        PG8_WAIT_V(6); PG8_BAR;
    } else {
        PG8_STAGE(PG8_SB(0, 0), cB, voffB); PG8_STAGE(PG8_SA(0, 0), cA, voffA); PG8_STAGE(PG8_SB(0, 1), cB + hstep, voffB); PG8_STAGE(PG8_SA(0, 1), cA + hstep, voffA);
        if (wr == 1) PG8_BAR;
        PG8_WAIT_V(4); PG8_BAR;
        PG8_STAGE(PG8_SB(1, 0), cB + kstep, voffB); PG8_STAGE(PG8_SA(1, 0), cA + kstep, voffA); PG8_STAGE(PG8_SB(1, 1), cB + hstep + kstep, voffB);
        PG8_WAIT_V(6); PG8_BAR;
    }
    for (;;) {
        const bool has_next = S.next(ui + 1, nxt);
        const char* nA = has_next ? (const char*)g.A + (size_t)nxt.pm * tstep : cA; const char* nB = has_next ? (const char*)g.Bt + (size_t)nxt.pn * tstep : cB;
        for (int t = 0; t < nt; t += 2) {
            if constexpr (Epi::HOOK) { if (t == 8 || t == 16) { PG8_SCHED; E.hook(acc, cur, wr, wc, fr, fq, t); PG8_SCHED; } }
            const bool last = (t == nt - 2);
            const char* a1 = cA + (size_t)(t + 1) * kstep;
            const char* a2 = last ? nA : cA + (size_t)(t + 2) * kstep; const char* b2 = last ? nB : cB + (size_t)(t + 2) * kstep;
            const char* a3 = a2 + kstep; const char* b3 = b2 + kstep;
            if (last && has_next) S.a_ready(nxt);
            if constexpr (SP2) {
            PG8_LDB(B0, 0, 0); PG8_LDB(B1, 0, 1); PG8_SCHED; PG8_LDA(At, 0, 0); PG8_STAGE(PG8_SA(1, 1), a1 + hstep, voffA);
            PG8_WAIT_V(8); PG8_WAIT_L(0); PG8_BAR; PG8_MMA(0, 0, At, B0); PG8_MMA(0, 1, At, B1); PG8_BAR; PG8_SCHED;
            PG8_LDA(At, 0, 1); PG8_STAGE(PG8_SB(0, 0), b2, voffB); PG8_STAGE(PG8_SB(0, 1), b2 + hstep, voffB); PG8_STAGE(PG8_SA(0, 0), a2, voffA);
            PG8_WAIT_V(8); PG8_WAIT_L(0); PG8_BAR; PG8_MMA(1, 0, At, B0); PG8_MMA(1, 1, At, B1); PG8_BAR; PG8_SCHED;
            PG8_LDB(B0, 1, 0); PG8_LDB(B1, 1, 1); PG8_SCHED; PG8_LDA(At, 1, 0); PG8_STAGE(PG8_SA(0, 1), a2 + hstep, voffA);
            PG8_WAIT_V(8); PG8_WAIT_L(0); PG8_BAR; PG8_MMA(0, 0, At, B0); PG8_MMA(0, 1, At, B1); PG8_BAR; PG8_SCHED;
            PG8_LDA(At, 1, 1); PG8_STAGE(PG8_SB(1, 0), b3, voffB); PG8_STAGE(PG8_SB(1, 1), b3 + hstep, voffB); PG8_STAGE(PG8_SA(1, 0), a3, voffA);
            PG8_WAIT_V(8); PG8_WAIT_L(0); PG8_BAR; PG8_MMA(1, 0, At, B0); PG8_MMA(1, 1, At, B1); PG8_BAR; PG8_SCHED;
            } else {
            PG8_LDB(B0, 0, 0); PG8_SCHED; PG8_LDA(At, 0, 0); PG8_STAGE(PG8_SA(1, 1), a1 + hstep, voffA);
            PG8_WAIT_L(8); PG8_BAR; PG8_WAIT_L(0); PG8_MMA(0, 0, At, B0); PG8_BAR; PG8_SCHED;
            PG8_LDB(B1, 0, 1); PG8_STAGE(PG8_SB(0, 0), b2, voffB);
            PG8_BAR; PG8_WAIT_L(0); PG8_MMA(0, 1, At, B1); PG8_BAR;
            PG8_LDA(At, 0, 1); PG8_STAGE(PG8_SA(0, 0), a2, voffA);
            PG8_BAR; PG8_WAIT_L(0); PG8_MMA(1, 0, At, B0); PG8_BAR; PG8_SCHED;
            PG8_STAGE(PG8_SB(0, 1), b2 + hstep, voffB);
            PG8_WAIT_V(6); PG8_BAR; PG8_MMA(1, 1, At, B1); PG8_BAR;
            PG8_LDB(B0, 1, 0); PG8_SCHED; PG8_LDA(At, 1, 0); PG8_STAGE(PG8_SA(0, 1), a2 + hstep, voffA);
            PG8_WAIT_L(8); PG8_BAR; PG8_WAIT_L(0); PG8_MMA(0, 0, At, B0); PG8_BAR; PG8_SCHED;
            PG8_LDB(B1, 1, 1); PG8_STAGE(PG8_SB(1, 0), b3, voffB);
            PG8_BAR; PG8_WAIT_L(0); PG8_MMA(0, 1, At, B1); PG8_BAR;
            PG8_LDA(At, 1, 1); PG8_STAGE(PG8_SA(1, 0), a3, voffA);
            PG8_BAR; PG8_WAIT_L(0); PG8_MMA(1, 0, At, B0); PG8_BAR; PG8_SCHED;
            PG8_STAGE(PG8_SB(1, 1), b3 + hstep, voffB);
            PG8_WAIT_V(6); PG8_BAR; PG8_MMA(1, 1, At, B1); PG8_BAR;
            }
        }
        if constexpr (ALIGN_EPI) { if (wr == 0) PG8_BAR; }
        if constexpr (!Epi::AFTER_DRAIN) { E(acc, cur, wr, wc, fr, fq); S.done(cur); }
        if (!has_next) break;
#pragma unroll
        for (int a = 0; a < 2; ++a)
#pragma unroll
            for (int b = 0; b < 2; ++b)
#pragma unroll
                for (int m = 0; m < 4; ++m)
#pragma unroll
                    for (int n = 0; n < 2; ++n) acc[a][b][m][n] = (f32x4){0.f, 0.f, 0.f, 0.f};
        cur = nxt; cA = nA; cB = nB; ++ui;
        if constexpr (ALIGN_EPI) { if (wr == 1) PG8_BAR; }
    }
    PG8_WAIT_V(0);
    if constexpr (!ALIGN_EPI) { if (wr == 0) PG8_BAR; }
    PG8_BAR;
    if constexpr (Epi::AFTER_DRAIN) { E.fused(acc, cur, wr, wc, fr, fq, lds, wid, lane); S.done(cur); }
#undef PG8_SA
#undef PG8_SB
#undef PG8_STAGE
#undef PG8_LDA
#undef PG8_LDB
#undef PG8_MMA
#undef PG8_WAIT_V
#undef PG8_WAIT_L
#undef PG8_BAR
#undef PG8_SCHED
}
}
#define LAS __attribute__((address_space(3)))
constexpr int NWAVES = 8;
constexpr size_t WS_LAGG = 870 * MiB;
constexpr size_t WS_LHIN = 871 * MiB;
constexpr size_t WS_LRUW = 872 * MiB;
typedef float f32x4v __attribute__((ext_vector_type(4)));
typedef unsigned u32x4v __attribute__((ext_vector_type(4)));
typedef unsigned u32x2v __attribute__((ext_vector_type(2)));
DEV unsigned pk2(float lo, float hi) { return (unsigned)f2bf(lo) | ((unsigned)f2bf(hi) << 16); }
DEV int tid_opaque() { int t = threadIdx.x; asm volatile("" : "+v"(t)); return t; }
DEV void lds_wait() { asm volatile("s_waitcnt lgkmcnt(0)" ::: "memory"); }

DEV void wt_item(const float* __restrict__ W, int N, bf16_t* __restrict__ WT, int P, int koff, const float* __restrict__ scale, LAS float* scr, int item, int lane) {
    const int nblk = N / 32, kb = item / nblk, nb = item % nblk, k0 = 64 * kb, n0 = 32 * nb;
#pragma unroll 8
    for (int i = 0; i < 32; ++i) { const int kk = 2 * i + (lane >> 5); scr[kk * 33 + (lane & 31)] = W[(size_t)(k0 + kk) * N + n0 + (lane & 31)] * (scale ? scale[k0 + kk] : 1.f); }
    lds_wait();
    const int c = lane & 7;
#pragma unroll
    for (int j = 0; j < 4; ++j) { const int n = (lane >> 3) + 8 * j; const LAS float* s = scr + (8 * c) * 33 + n;
        u32x4v o; o.x = pk2(s[0 * 33], s[1 * 33]); o.y = pk2(s[2 * 33], s[3 * 33]); o.z = pk2(s[4 * 33], s[5 * 33]); o.w = pk2(s[6 * 33], s[7 * 33]);
        *(u32x4v*)(WT + (size_t)(n0 + n) * P + koff + k0 + 8 * c) = o; }
    lds_wait();
}
DEV void xn_row(const float* __restrict__ x, bf16_t* __restrict__ o, int lane) {
    const f32x4v* xr = (const f32x4v*)x + lane; f32x4v v[4]; float s = 0.f;
#pragma unroll
    for (int j = 0; j < 4; ++j) { v[j] = xr[64 * j]; s += (v[j].x * v[j].x + v[j].y * v[j].y) + (v[j].z * v[j].z + v[j].w * v[j].w); }
    const float rinv = rsqrtf(wave_sum(s) * (1.f / DM) + 1e-6f);
    u32x2v* o8 = (u32x2v*)o + lane;
#pragma unroll
    for (int j = 0; j < 4; ++j) { u32x2v w; w.x = pk2(v[j].x * rinv, v[j].y * rinv); w.y = pk2(v[j].z * rinv, v[j].w * rinv); o8[64 * j] = w; }
}
DEV void elt_row(const float* __restrict__ x, const bf16_t* __restrict__ O, const float* __restrict__ g, float* __restrict__ xout, bf16_t* __restrict__ xn, int lane) {
    const u32x2v* orow = (const u32x2v*)O + lane; f32x4v o[4]; float s = 0.f;
#pragma unroll
    for (int j = 0; j < 4; ++j) { const u32x2v w = orow[64 * j]; o[j].x = __uint_as_float(w.x << 16); o[j].y = __uint_as_float(w.x & 0xffff0000u); o[j].z = __uint_as_float(w.y << 16); o[j].w = __uint_as_float(w.y & 0xffff0000u);
        s += (o[j].x * o[j].x + o[j].y * o[j].y) + (o[j].z * o[j].z + o[j].w * o[j].w); }
    const float rinv = rsqrtf(wave_sum(s) * (1.f / DM) + 1e-6f);
    const f32x4v* xr = (const f32x4v*)x + lane; const f32x4v* gr = (const f32x4v*)g + lane; f32x4v v[4]; float s2 = 0.f;
#pragma unroll
    for (int j = 0; j < 4; ++j) { v[j] = xr[64 * j] + o[j] * rinv * gr[64 * j]; s2 += (v[j].x * v[j].x + v[j].y * v[j].y) + (v[j].z * v[j].z + v[j].w * v[j].w); }
    const float rinv2 = rsqrtf(wave_sum(s2) * (1.f / DM) + 1e-6f);
    f32x4v* xo = (f32x4v*)xout + lane; u32x2v* o8 = (u32x2v*)xn + lane;
#pragma unroll
    for (int j = 0; j < 4; ++j) { xo[64 * j] = v[j]; u32x2v w; w.x = pk2(v[j].x * rinv2, v[j].y * rinv2); w.y = pk2(v[j].z * rinv2, v[j].w * rinv2); o8[64 * j] = w; }
}
DEV void phase_prologue(const float* const* in, float* out, unsigned char* ws, LAS unsigned char* lds, int G, int c) {
    const int tid = tid_opaque(), lane = tid & 63, wave = tid >> 6, gw = c * NWAVES + wave, NGW = G * NWAVES;
    LAS float* scr = (LAS float*)(lds + wave * 16384);
    constexpr int I_IN = 16 * 248, I_BA = 8 * 32, I_BC = 4 * 32, I_OUT = 16 * 32, I_UP = 16 * 128, I_DN = 64 * 32, I_L = I_IN + 2 * I_BA + I_BC + I_OUT + I_UP + I_DN;
    for (int it = gw; it < 2 * I_L; it += NGW) {
        const int l = it / I_L; int r = it % I_L; unsigned char* wl = ws + WS_W + (size_t)l * WS_WL;
        if (r < I_IN) { wt_item(in[12] + (size_t)l * DM * NIN, NIN, (bf16_t*)(wl + W_IN), DM, 0, in[8] + l * DM, scr, r, lane); continue; } r -= I_IN;
        if (r < I_BA) { wt_item(in[23] + (size_t)l * 512 * DM, DM, (bf16_t*)(wl + W_BR), YK, 0, nullptr, scr, r, lane); continue; } r -= I_BA;
        if (r < I_BA) { wt_item(in[24] + (size_t)l * 512 * DM, DM, (bf16_t*)(wl + W_BR), YK, 512, nullptr, scr, r, lane); continue; } r -= I_BA;
        if (r < I_BC) { wt_item(in[25] + (size_t)l * 256 * DM, DM, (bf16_t*)(wl + W_BR), YK, 1024, nullptr, scr, r, lane); continue; } r -= I_BC;
        if (r < I_OUT) { wt_item(in[26] + (size_t)l * DM * DM, DM, (bf16_t*)(wl + W_OUT), DM, 0, nullptr, scr, r, lane); continue; } r -= I_OUT;
        if (r < I_UP) { wt_item(in[27] + (size_t)l * DM * DFF, DFF, (bf16_t*)(wl + W_UP), DM, 0, in[10] + l * DM, scr, r, lane); continue; } r -= I_UP;
        wt_item(in[28] + (size_t)l * DFF * DM, DM, (bf16_t*)(wl + W_DN), DFF, 0, nullptr, scr, r, lane);
    }
    bf16_t* XN = (bf16_t*)(ws + WS_XN);
    for (int m = gw; m < MT; m += NGW) xn_row(m < MP ? in[0] + (size_t)m * DM : in[1] + (size_t)(m - MP) * DM, XN + (size_t)m * DM, lane);
    { float* lw = (float*)(ws + WS_LRUW);
      for (int i = c * (NWAVES * 64) + tid; i < 2 * 2 * 8 * 4096; i += G * NWAVES * 64) { const int d = i & 63, e = (i >> 6) & 63, n = (i >> 12) & 7, k = (i >> 15) & 1, l = i >> 16;
          lw[i] = in[k ? 18 : 16][((size_t)(l * 8 + n) * 64 + d) * 64 + e]; } }
    const size_t gt = (size_t)c * (NWAVES * 64) + tid, NT_ = (size_t)G * NWAVES * 64;
#pragma unroll
    for (int g = 0; g < 3; ++g) {
        const int Wc = g == 0 ? 128 : (g == 1 ? 512 : 2048);
        const size_t o_s = g == 0 ? O_W128S : (g == 1 ? O_W512S : O_W2048S);
        const f32x4v* src = (const f32x4v*)in[5 + g] + 1024; f32x4v* dst = (f32x4v*)(out + o_s);
        const size_t n4 = (size_t)2 * 32 * Wc * 128; const unsigned blk4 = (unsigned)Wc * 128, lim4 = (unsigned)(Wc - 8) * 128;
        for (size_t i = gt; i < n4; i += 4 * NT_) {
            f32x4v v[4];
#pragma unroll
            for (int k = 0; k < 4; ++k) { const size_t j = i + (size_t)k * NT_; if (j < n4 && (unsigned)(j % blk4) < lim4) v[k] = __builtin_nontemporal_load(src + j); }
#pragma unroll
            for (int k = 0; k < 4; ++k) { const size_t j = i + (size_t)k * NT_; if (j < n4 && (unsigned)(j % blk4) < lim4) __builtin_nontemporal_store(v[k], dst + j); }
        }
    }
}
DEV void phase_elt(const float* xp, const float* xs, const bf16_t* O, const float* g, float* xout, bf16_t* XN, int G, int c) {
    const int tid = tid_opaque(), lane = tid & 63, wave = tid >> 6, gw = c * NWAVES + wave, NGW = G * NWAVES;
    for (int m = gw; m < MT; m += NGW) elt_row(m < MP ? xp + (size_t)m * DM : xs + (size_t)(m - MP) * DM, O + (size_t)m * DM, g, xout + (size_t)m * DM, XN + (size_t)m * DM, lane);
}

template <bool FINAL>
DEV void lru_item(const float* const* in, float* out, unsigned char* ws, LAS unsigned char* lds, int l, bool sample, int idx) {
    const int c = tid_opaque(), n = c >> 6, e = c & 63;
    const bf16_t* Z = (const bf16_t*)(ws + WS_Z); bf16_t* Y = (bf16_t*)(ws + WS_Y);
    LAS float* xc = (LAS float*)lds;
    const int T = sample ? 8 : 64, row0 = sample ? MP + idx * 8 : idx * 64;
    const float* cw = in[14] + (size_t)l * 4 * 512; const float cb = in[15][l * 512 + c];
    const float w0 = cw[c], w1 = cw[512 + c], w2 = cw[1024 + c], w3 = cw[1536 + c];
    float u0, u1, u2;
    if (sample) { const float* st = in[2] + ((size_t)l * 32 + idx) * 3 * 512; u0 = st[c]; u1 = st[512 + c]; u2 = st[1024 + c]; }
    else if (idx == 0) { u0 = 0.f; u1 = 0.f; u2 = 0.f; }
    else { u0 = bf2f(Z[(size_t)(row0 - 3) * NIN + c]); u1 = bf2f(Z[(size_t)(row0 - 2) * NIN + c]); u2 = bf2f(Z[(size_t)(row0 - 1) * NIN + c]); }
#pragma unroll 8
    for (int t = 0; t < T; ++t) { const float u3 = bf2f(Z[(size_t)(row0 + t) * NIN + c]);
        xc[t * 512 + c] = cb + w0 * u0 + w1 * u1 + w2 * u2 + w3 * u3; u0 = u1; u1 = u2; u2 = u3; }
    if (FINAL) {
        if (sample) { float* o = out + O_CONVS + ((size_t)l * 32 + idx) * 3 * 512; o[c] = u0; o[512 + c] = u1; o[1024 + c] = u2; }
        else if (idx == 255) { float* o = out + O_CONVP + (size_t)l * 3 * 512; o[c] = u0; o[512 + c] = u1; o[1024 + c] = u2; }
    }
    float wr[64], wi[64];
    { const f32x4v* pr = (const f32x4v*)((const float*)(ws + WS_LRUW) + ((size_t)(l * 2 + 0) * 8 + n) * 4096 + e * 64); const f32x4v* pi = pr + 8 * 4096 / 4;
#pragma unroll
      for (int d4 = 0; d4 < 16; ++d4) { const f32x4v a = pr[d4], b = pi[d4];
          wr[4 * d4] = a.x; wr[4 * d4 + 1] = a.y; wr[4 * d4 + 2] = a.z; wr[4 * d4 + 3] = a.w; wi[4 * d4] = b.x; wi[4 * d4 + 1] = b.y; wi[4 * d4 + 2] = b.z; wi[4 * d4 + 3] = b.w; } }
    const float br = in[17][l * 512 + c], bi = in[19][l * 512 + c];
    const float sp = -8.f * log1pf(expf(-in[20][l * 512 + c]));
    float h = 0.f, ap = 1.f;
    if (FINAL) h = sample ? in[3][((size_t)l * 32 + idx) * 512 + c] : ((const float*)(ws + WS_LHIN))[(size_t)idx * 512 + c];
    __syncthreads();
#pragma unroll 1
    for (int t = 0; t < T; ++t) {
        const LAS f32x4v* xv = (const LAS f32x4v*)(xc + t * 512 + n * 64);
        float rp = br, ip = bi;
#pragma unroll
        for (int d4 = 0; d4 < 16; ++d4) { const f32x4v x = xv[d4];
            rp += x.x * wr[4 * d4] + x.y * wr[4 * d4 + 1] + x.z * wr[4 * d4 + 2] + x.w * wr[4 * d4 + 3];
            ip += x.x * wi[4 * d4] + x.y * wi[4 * d4 + 1] + x.z * wi[4 * d4 + 2] + x.w * wi[4 * d4 + 3];
            if ((d4 & 3) == 3) asm volatile("" ::: "memory"); }
        const float r = __builtin_amdgcn_rcpf(1.f + __expf(-rp)), ig = __builtin_amdgcn_rcpf(1.f + __expf(-ip));
        const float log_a = sp * r, a = __expf(log_a);
        const float x2 = 2.f * log_a;
        const float em = x2 > -0.25f ? -x2 * (1.f + x2 * (0.5f + x2 * (0.16666667f + x2 * (0.041666668f + x2 * (0.0083333333f + x2 * 0.0013888889f))))) : 1.f - a * a;
        const float mult = (!sample && idx == 0 && t == 0) ? 1.f : __builtin_sqrtf(em);
        h = a * h + mult * ig * xc[t * 512 + c]; ap *= a;
        if (FINAL) Y[(size_t)(row0 + t) * YK + c] = f2bf(h);
    }
    if (FINAL) { if (sample) out[O_LRUS + ((size_t)l * 32 + idx) * 512 + c] = h; }
    else { float* ag = (float*)(ws + WS_LAGG) + (size_t)idx * 1024; ag[c] = ap; ag[512 + c] = h; }
    __syncthreads();
}
DEV void lru_scan(float* out, unsigned char* ws, int l) {
    const int c = tid_opaque(); const float* ag = (const float*)(ws + WS_LAGG); float* hin = (float*)(ws + WS_LHIN);
    float h = 0.f;
#pragma unroll 8
    for (int j = 0; j < 256; ++j) { const float a = ag[(size_t)j * 1024 + c], b = ag[(size_t)j * 1024 + 512 + c]; hin[(size_t)j * 512 + c] = h; h = a * h + b; }
    out[O_LRUP + (size_t)l * 512 + c] = h;
}
namespace cg = cooperative_groups;
constexpr int LDS_BYTES = 147456, RING_OFF = 0;
constexpr int PH_PRO = 0, PH_LAYER0 = 1, PH_PER_LAYER = 10, PH_END = PH_LAYER0 + 2 * PH_PER_LAYER;
constexpr int P_G1 = 0, P_MIX1 = 1, P_MIX2 = 2, P_MIX3 = 3, P_G2 = 4, P_G3 = 5, P_E1 = 6, P_G4 = 7, P_G5 = 8, P_E2 = 9;
struct Args { const float* in[29]; float* out; unsigned char* ws; int ph_lo, ph_hi; };
static_assert(sizeof(Args) == 31 * 8 + 8, "Args has no padding");

__global__ void __launch_bounds__(NWAVES * 64, 2) mega(Args args) {
    extern __shared__ __attribute__((aligned(16))) unsigned char lds_raw[];
    LAS unsigned char* lds = (LAS unsigned char*)lds_raw;
    cg::grid_group grid = cg::this_grid();
    unsigned char* ws = args.ws;
    bf16_t* XN = (bf16_t*)(ws + WS_XN); bf16_t* Z = (bf16_t*)(ws + WS_Z); bf16_t* Y = (bf16_t*)(ws + WS_Y); bf16_t* MIX = (bf16_t*)(ws + WS_MIX);
    bf16_t* OB = (bf16_t*)(ws + WS_OB); bf16_t* HID = (bf16_t*)(ws + WS_HID);
    const int G = gridDim.x, c = blockIdx.x;
    const int lo = args.ph_lo, hi = args.ph_hi;
#ifndef PHMASK
#define PHMASK 0xffffffff
#endif
#define PHM(k) ((PHMASK >> (k)) & 1)
#define IN(k) (lo <= (k) && (k) < hi)
#define SEAM(k) do { if (IN(k) && IN((k) + 1)) grid.sync(); } while (0)
    float* X1 = (float*)(ws + WS_X1); float* X2 = (float*)(ws + WS_X2);
    if (IN(PH_PRO)) phase_prologue(args.in, args.out, ws, lds, G, c);
    SEAM(PH_PRO);
    for (int l = 0; l < 2; ++l) {
        const int pb = PH_LAYER0 + l * PH_PER_LAYER;
        unsigned char* wl = ws + WS_W + (size_t)l * WS_WL;
        if (PHM(P_G1) && IN(pb + P_G1)) {
            pg8::Gemm g{XN, (const bf16_t*)(wl + W_IN), MT, NIN, DM}; pg8::StaticOrder S; S.init(MT, NIN, G, c);
            pg8::EpiZ E{Z, args.in[13] + (size_t)l * 3072};
            pg8::gemm_phase<pg8::EpiZ, pg8::StaticOrder, true, true>(lds + RING_OFF, g, S, E);
        }
        SEAM(pb + P_G1);
        if (PHM(P_MIX1) && IN(pb + P_MIX1)) {
            for (int it = c; it < 288; it += G) { if (it < 256) lru_item<false>(args.in, args.out, ws, lds, l, false, it); else lru_item<true>(args.in, args.out, ws, lds, l, true, it - 256); }
        }
        SEAM(pb + P_MIX1);
        if (PHM(P_MIX2) && IN(pb + P_MIX2)) { if (c == 0) lru_scan(args.out, ws, l); }
        SEAM(pb + P_MIX2);
        if (PHM(P_MIX3) && IN(pb + P_MIX3)) {
            for (int it = c; it < 256; it += G) lru_item<true>(args.in, args.out, ws, lds, l, false, it);
        }
        SEAM(pb + P_MIX3);
        if (PHM(P_G2) && IN(pb + P_G2)) {
            pg8::Gemm g{Y, (const bf16_t*)(wl + W_BR), MT, DM, YK}; pg8::StaticOrder S; S.init(MT, DM, G, c);
            pg8::EpiMix E{Z, MIX};
            pg8::gemm_phase<pg8::EpiMix, pg8::StaticOrder, true, true>(lds + RING_OFF, g, S, E);
        }
        SEAM(pb + P_G2);
        if (PHM(P_G3) && IN(pb + P_G3)) {
            pg8::Gemm g{MIX, (const bf16_t*)(wl + W_OUT), MT, DM, DM}; pg8::StaticOrder S; S.init(MT, DM, G, c);
            pg8::EpiBf<0> E{OB, DM};
            pg8::gemm_phase<pg8::EpiBf<0>, pg8::StaticOrder, true, true>(lds + RING_OFF, g, S, E);
        }
        SEAM(pb + P_G3);
        if (PHM(P_E1) && IN(pb + P_E1)) phase_elt(l == 0 ? args.in[0] : X2, l == 0 ? args.in[1] : X2 + (size_t)MP * DM, OB, args.in[9] + (size_t)l * DM, X1, XN, G, c);
        SEAM(pb + P_E1);
        if (PHM(P_G4) && IN(pb + P_G4)) {
            pg8::Gemm g{XN, (const bf16_t*)(wl + W_UP), MT, DFF, DM}; pg8::StaticOrder S; S.init(MT, DFF, G, c);
            pg8::EpiBf<1> E{HID, DFF};
            pg8::gemm_phase<pg8::EpiBf<1>, pg8::StaticOrder, true, true>(lds + RING_OFF, g, S, E);
        }
        SEAM(pb + P_G4);
        if (PHM(P_G5) && IN(pb + P_G5)) {
            pg8::Gemm g{HID, (const bf16_t*)(wl + W_DN), MT, DM, DFF}; pg8::StaticOrder S; S.init(MT, DM, G, c);
            pg8::EpiBf<0> E{OB, DM};
            pg8::gemm_phase<pg8::EpiBf<0>, pg8::StaticOrder, true, true>(lds + RING_OFF, g, S, E);
        }
        SEAM(pb + P_G5);
        if (PHM(P_E2) && IN(pb + P_E2)) phase_elt(X1, X1 + (size_t)MP * DM, OB, args.in[11] + (size_t)l * DM, l == 0 ? X2 : args.out, XN, G, c);
        SEAM(pb + P_E2);
    }
#undef IN
#undef SEAM
}
__global__ void __launch_bounds__(256) k_wt(const float* __restrict__ src, int K, int N, bf16_t* __restrict__ dst, int P, int koff, const float* __restrict__ scale) {
    __shared__ float t[32][33];
    const int n0 = blockIdx.x * 32, k0 = blockIdx.y * 32, tx = threadIdx.x & 31, ty = threadIdx.x >> 5;
    for (int i = ty; i < 32; i += 8) t[i][tx] = src[(size_t)(k0 + i) * N + n0 + tx] * (scale ? scale[k0 + i] : 1.f);
    __syncthreads();
    for (int i = ty; i < 32; i += 8) dst[(size_t)(n0 + i) * P + koff + k0 + tx] = f2bf(t[tx][i]);
}

__global__ void __launch_bounds__(256) k_xn(const float* __restrict__ xp, const float* __restrict__ xs, bf16_t* __restrict__ XN) {
    const int row = blockIdx.x * 4 + (threadIdx.x >> 6), lane = threadIdx.x & 63;
    if (row >= MT) return;
    const float* x = row < MP ? xp + (size_t)row * DM : xs + (size_t)(row - MP) * DM;
    float v[16]; float s = 0.f;
#pragma unroll
    for (int j = 0; j < 16; ++j) { v[j] = x[lane + 64 * j]; s += v[j] * v[j]; }
    s = wave_sum(s);
    const float rinv = rsqrtf(s * (1.f / DM) + 1e-6f);
#pragma unroll
    for (int j = 0; j < 16; ++j) XN[(size_t)row * DM + lane + 64 * j] = f2bf(v[j] * rinv);
}

__global__ void __launch_bounds__(256) k_elt(const float* __restrict__ xp, const float* __restrict__ xs, const bf16_t* __restrict__ O, const float* __restrict__ g,
                                             float* __restrict__ xout, bf16_t* __restrict__ XN) {
    const int row = blockIdx.x * 4 + (threadIdx.x >> 6), lane = threadIdx.x & 63;
    if (row >= MT) return;
    const float* x = row < MP ? xp + (size_t)row * DM : xs + (size_t)(row - MP) * DM;
    float o[16], v[16]; float s = 0.f;
#pragma unroll
    for (int j = 0; j < 16; ++j) { o[j] = bf2f(O[(size_t)row * DM + lane + 64 * j]); s += o[j] * o[j]; }
    s = wave_sum(s);
    const float rinv = rsqrtf(s * (1.f / DM) + 1e-6f);
    float s2 = 0.f;
#pragma unroll
    for (int j = 0; j < 16; ++j) { v[j] = x[lane + 64 * j] + o[j] * rinv * g[lane + 64 * j]; s2 += v[j] * v[j]; }
    s2 = wave_sum(s2);
    const float rinv2 = rsqrtf(s2 * (1.f / DM) + 1e-6f);
#pragma unroll
    for (int j = 0; j < 16; ++j) { xout[(size_t)row * DM + lane + 64 * j] = v[j]; XN[(size_t)row * DM + lane + 64 * j] = f2bf(v[j] * rinv2); }
}

struct NEpiZ {
    bf16_t* Z; const float* bgate;
    DEV void operator()(int m, int n, float v) const {
        float r = v;
        if (n >= ZC_GATE) r = sigmoidf_(v + bgate[n - ZC_GATE]);
        else if ((n >= ZC_QB && n < ZC_FB) || (n >= ZC_GB && n < ZC_QC)) r = v * sigmoidf_(v);
        else if (n >= ZC_QC && n < ZC_KC) r = v * 0.125f;
        Z[(size_t)m * NIN + n] = f2bf(r);
    }
};
struct NEpiBf {
    bf16_t* O; int N;
    DEV void operator()(int m, int n, float v) const { O[(size_t)m * N + n] = f2bf(v); }
};
struct NEpiRelu2 {
    bf16_t* O; int N;
    DEV void operator()(int m, int n, float v) const { float r = fmaxf(v, 0.f); O[(size_t)m * N + n] = f2bf(r * r); }
};
template <class Epi, bool GATED>
__global__ void __launch_bounds__(256) k_gemm(const bf16_t* __restrict__ A, const bf16_t* __restrict__ Bt, int M, int N, int K, Epi E, const bf16_t* __restrict__ Zg) {
    __shared__ float sA[32][65], sB[32][65];
    const int tx = threadIdx.x & 15, ty = threadIdx.x >> 4, m0 = blockIdx.y * 64, n0 = blockIdx.x * 64;
    float acc[4][4], tot[4][4];
#pragma unroll
    for (int i = 0; i < 4; ++i)
#pragma unroll
        for (int j = 0; j < 4; ++j) { acc[i][j] = 0.f; tot[i][j] = 0.f; }
    for (int k0 = 0; k0 < K; k0 += 32) {
        if (GATED && (k0 == 512 || k0 == 1024)) {
            const int seg = k0 == 512 ? 0 : 1;
#pragma unroll
            for (int i = 0; i < 4; ++i)
#pragma unroll
                for (int j = 0; j < 4; ++j) { tot[i][j] += acc[i][j] * bf2f(Zg[(size_t)(m0 + ty * 4 + i) * NIN + ZC_GATE + seg * 1024 + n0 + tx * 4 + j]); acc[i][j] = 0.f; }
        }
        for (int i = threadIdx.x; i < 2048; i += 256) { const int r = i >> 5, c = i & 31;
            sA[c][r] = bf2f(A[(size_t)(m0 + r) * K + k0 + c]); sB[c][r] = bf2f(Bt[(size_t)(n0 + r) * K + k0 + c]); }
        __syncthreads();
#pragma unroll 8
        for (int kk = 0; kk < 32; ++kk) {
            float a[4], b[4];
#pragma unroll
            for (int i = 0; i < 4; ++i) { a[i] = sA[kk][ty * 4 + i]; b[i] = sB[kk][tx * 4 + i]; }
#pragma unroll
            for (int i = 0; i < 4; ++i)
#pragma unroll
                for (int j = 0; j < 4; ++j) acc[i][j] += a[i] * b[j];
        }
        __syncthreads();
    }
#pragma unroll
    for (int i = 0; i < 4; ++i)
#pragma unroll
        for (int j = 0; j < 4; ++j) {
            const int m = m0 + ty * 4 + i, n = n0 + tx * 4 + j;
            float v = acc[i][j];
            if (GATED) v = tot[i][j] + v * bf2f(Zg[(size_t)m * NIN + ZC_GATE + 2 * 1024 + n]);
            E(m, n, v);
        }
}

__global__ void __launch_bounds__(256) k_conv(const bf16_t* __restrict__ Z, const float* __restrict__ st_conv  , const float* __restrict__ cw  ,
                                              const float* __restrict__ cb, float* __restrict__ XC) {
    const size_t idx = (size_t)blockIdx.x * 256 + threadIdx.x;
    if (idx >= (size_t)MT * 512) return;
    const int row = (int)(idx >> 9), c = (int)(idx & 511);
    float acc = cb[c];
    if (row < MP) {
#pragma unroll
        for (int j = 0; j < 4; ++j) { const int i = row - 3 + j; if (i >= 0) acc += cw[j * 512 + c] * bf2f(Z[(size_t)i * NIN + ZC_UA + c]); }
    } else {
        const int b = (row - MP) >> 3, t = (row - MP) & 7;
#pragma unroll
        for (int j = 0; j < 4; ++j) { const int i = t - 3 + j;
            const float u = i >= 0 ? bf2f(Z[(size_t)(MP + b * 8 + i) * NIN + ZC_UA + c]) : st_conv[((size_t)b * 3 + (3 + i)) * 512 + c];
            acc += cw[j * 512 + c] * u; }
    }
    XC[idx] = acc;
}
__global__ void __launch_bounds__(256) k_gates(const float* __restrict__ XC, const float* __restrict__ wr, const float* __restrict__ br, const float* __restrict__ wi,
                                               const float* __restrict__ bi, const float* __restrict__ lam, float* __restrict__ LA, float* __restrict__ LB) {
    const size_t idx = (size_t)blockIdx.x * 256 + threadIdx.x;
    if (idx >= (size_t)MT * 512) return;
    const int row = (int)(idx >> 9), c = (int)(idx & 511), n = c >> 6, e = c & 63;
    float rp = br[c], ip = bi[c];
    const float* x = XC + (size_t)row * 512 + n * 64;
    for (int d = 0; d < 64; ++d) { const float xv = x[d]; rp += xv * wr[((size_t)n * 64 + d) * 64 + e]; ip += xv * wi[((size_t)n * 64 + d) * 64 + e]; }
    const float r = sigmoidf_(rp), ig = sigmoidf_(ip);
    const float log_a = -8.f * r * log1pf(expf(-lam[c]));
    const float a = expf(log_a);
    const float mult = (row == 0) ? 1.f : sqrtf(-expm1f(2.f * log_a));
    LA[idx] = a; LB[idx] = mult * ig * XC[idx];
}
__global__ void __launch_bounds__(256) k_lru_scan(const float* __restrict__ LA, const float* __restrict__ LB, const float* __restrict__ st_lru  ,
                                                  const bf16_t* __restrict__ Z, bf16_t* __restrict__ Y, float* __restrict__ out, int layer) {
    const int idx = blockIdx.x * 256 + threadIdx.x;
    if (idx >= 33 * 512) return;
    const int seq = idx >> 9, c = idx & 511;
    float h; int row0, T;
    if (seq == 0) { h = 0.f; row0 = 0; T = MP; } else { h = st_lru[(size_t)(seq - 1) * 512 + c]; row0 = MP + (seq - 1) * 8; T = 8; }
    for (int t = 0; t < T; ++t) { const size_t i = (size_t)(row0 + t) * 512 + c; h = LA[i] * h + LB[i]; Y[(size_t)(row0 + t) * YK + c] = f2bf(h); }
    if (seq == 0) {
        out[O_LRUP + (size_t)layer * 512 + c] = h;
        for (int j = 0; j < 3; ++j) out[O_CONVP + ((size_t)layer * 3 + j) * 512 + c] = bf2f(Z[(size_t)(MP - 3 + j) * NIN + ZC_UA + c]);
    } else {
        const int b = seq - 1;
        out[O_LRUS + ((size_t)layer * 32 + b) * 512 + c] = h;
        for (int j = 0; j < 3; ++j) out[O_CONVS + (((size_t)layer * 32 + b) * 3 + j) * 512 + c] = bf2f(Z[(size_t)(MP + b * 8 + 5 + j) * NIN + ZC_UA + c]);
    }
}

__global__ void __launch_bounds__(256) k_hgrn_seq(const bf16_t* __restrict__ Z, const float* __restrict__ st_hg  , const float* __restrict__ lbraw  ,
                                                  float* __restrict__ HRAW, float* __restrict__ out, int layer) {
    const int w = blockIdx.x * 4 + (threadIdx.x >> 6), lane = threadIdx.x & 63;
    if (w >= 33 * 512) return;
    const int seq = w >> 9, h = (w >> 7) & 3, dv = w & 127;
    float lb0 = 0.f, lb1 = 0.f;
    if (layer == 1) { lb0 = sigmoidf_(lbraw[512 + h * 128 + lane] - lbraw[h * 128 + lane]); lb1 = sigmoidf_(lbraw[512 + h * 128 + lane + 64] - lbraw[h * 128 + lane + 64]); }
    float S0 = 0.f, S1 = 0.f; int row0 = 0, T = MP;
    if (seq > 0) { const int b = seq - 1; row0 = MP + b * 8; T = 8;
        S0 = st_hg[(((size_t)b * 4 + h) * 128 + lane) * 128 + dv]; S1 = st_hg[(((size_t)b * 4 + h) * 128 + lane + 64) * 128 + dv]; }
    for (int t = 0; t < T; ++t) {
        const bf16_t* z = Z + (size_t)(row0 + t) * NIN;
        const float q0 = bf2f(z[ZC_QB + h * 128 + lane]), q1 = bf2f(z[ZC_QB + h * 128 + lane + 64]);
        const float s0 = sigmoidf_(bf2f(z[ZC_FB + h * 128 + lane])), s1 = sigmoidf_(bf2f(z[ZC_FB + h * 128 + lane + 64]));
        const float v = bf2f(z[ZC_IB + h * 128 + dv]);
        const float f0 = lb0 + (1.f - lb0) * s0, f1 = lb1 + (1.f - lb1) * s1;
        const float k0 = (1.f - lb0) * (1.f - s0), k1 = (1.f - lb1) * (1.f - s1);
        S0 = f0 * S0 + k0 * v; S1 = f1 * S1 + k1 * v;
        const float o = wave_sum(S0 * q0 + S1 * q1);
        if (lane == 0) HRAW[(size_t)(row0 + t) * 512 + h * 128 + dv] = o;
    }
    if (seq == 0) { out[O_HGP + (((size_t)layer * 4 + h) * 128 + lane) * 128 + dv] = S0; out[O_HGP + (((size_t)layer * 4 + h) * 128 + lane + 64) * 128 + dv] = S1; }
    else { const int b = seq - 1;
        out[O_HGS + ((((size_t)layer * 32 + b) * 4 + h) * 128 + lane) * 128 + dv] = S0; out[O_HGS + ((((size_t)layer * 32 + b) * 4 + h) * 128 + lane + 64) * 128 + dv] = S1; }
}
__global__ void __launch_bounds__(256) k_hgrn_post(const float* __restrict__ HRAW, const bf16_t* __restrict__ Z, const float* __restrict__ ng  , bf16_t* __restrict__ Y) {
    const int w = blockIdx.x * 4 + (threadIdx.x >> 6), lane = threadIdx.x & 63;
    if (w >= MT * 4) return;
    const int row = w >> 2, h = w & 3;
    const float o0 = HRAW[(size_t)row * 512 + h * 128 + lane], o1 = HRAW[(size_t)row * 512 + h * 128 + lane + 64];
    const float s = wave_sum(o0 * o0 + o1 * o1);
    const float rinv = rsqrtf(s * (1.f / 128.f) + 1e-6f);
    Y[(size_t)row * YK + 512 + h * 128 + lane] = f2bf(o0 * rinv * ng[lane] * bf2f(Z[(size_t)row * NIN + ZC_GB + h * 128 + lane]));
    Y[(size_t)row * YK + 512 + h * 128 + lane + 64] = f2bf(o1 * rinv * ng[lane + 64] * bf2f(Z[(size_t)row * NIN + ZC_GB + h * 128 + lane + 64]));
}

DEV float dot_row_bf(const float (&q)[64], const bf16_t* __restrict__ p) {
    float s = 0.f;
#pragma unroll
    for (int d8 = 0; d8 < 8; ++d8) { const uint4 u = *(const uint4*)(p + d8 * 8); const unsigned w[4] = {u.x, u.y, u.z, u.w};
#pragma unroll
        for (int i = 0; i < 4; ++i) { s += q[d8 * 8 + 2 * i] * __uint_as_float(w[i] << 16); s += q[d8 * 8 + 2 * i + 1] * __uint_as_float(w[i] & 0xffff0000u); } }
    return s;
}
DEV float dot_row_f(const float (&q)[64], const float* __restrict__ p) {
    float s = 0.f;
#pragma unroll
    for (int d4 = 0; d4 < 16; ++d4) { const float4 u = *(const float4*)(p + d4 * 4); s += q[d4 * 4] * u.x + q[d4 * 4 + 1] * u.y + q[d4 * 4 + 2] * u.z + q[d4 * 4 + 3] * u.w; }
    return s;
}
__global__ void __launch_bounds__(256) k_attn(const bf16_t* __restrict__ Z, const float* __restrict__ c128, const float* __restrict__ c512, const float* __restrict__ c2048  ,
                                              bf16_t* __restrict__ Y) {
    const int w = blockIdx.x * 4 + (threadIdx.x >> 6), lane = threadIdx.x & 63;
    if (w >= MT * 4) return;
    const int row = w >> 2, hh = w & 3;
    const bool prompt = row < MP;
    const int b = prompt ? 0 : (row - MP) >> 3, t = prompt ? row : (row - MP) & 7;
    float og[3], lse[3];
#pragma unroll
    for (int g = 0; g < 3; ++g) {
        const int dil = g == 0 ? 1 : (g == 1 ? 4 : 16), Wc = 128 * dil, hd = g * 4 + hh;
        const float* cache = g == 0 ? c128 : (g == 1 ? c512 : c2048);
        float q[64];
        { const bf16_t* qp = Z + (size_t)row * NIN + ZC_QC + hd * 64;
#pragma unroll
          for (int d8 = 0; d8 < 8; ++d8) { const uint4 u = *(const uint4*)(qp + d8 * 8); const unsigned ww[4] = {u.x, u.y, u.z, u.w};
#pragma unroll
              for (int i = 0; i < 4; ++i) { q[d8 * 8 + 2 * i] = __uint_as_float(ww[i] << 16); q[d8 * 8 + 2 * i + 1] = __uint_as_float(ww[i] & 0xffff0000u); } } }
        float s[3]; bool val[3];
#pragma unroll
        for (int sl = 0; sl < 3; ++sl) {
            const int j = lane + 64 * sl;
            s[sl] = -1e30f; val[sl] = false;
            if (j <= 128) {
                if (prompt) { const int tk = t - dil * j; if (tk >= 0) { val[sl] = true; s[sl] = dot_row_bf(q, Z + (size_t)tk * NIN + ZC_KC + hd * 64); } }
                else { const int idx = dil * (128 - j) + t; val[sl] = true;
                    if (idx < Wc) s[sl] = dot_row_f(q, cache + ((size_t)b * Wc + idx) * 512 + hh * 64);
                    else s[sl] = dot_row_bf(q, Z + (size_t)(MP + b * 8 + idx - Wc) * NIN + ZC_KC + hd * 64); }
            }
        }
        const float m = wave_max(fmaxf(s[0], fmaxf(s[1], s[2])));
        float p[3];
#pragma unroll
        for (int sl = 0; sl < 3; ++sl) p[sl] = val[sl] ? expf(s[sl] - m) : 0.f;
        const float l = wave_sum(p[0] + p[1] + p[2]);
        float acc = 0.f;
        for (int j = 0; j <= 128; ++j) {
            const float pj = __shfl(j < 64 ? p[0] : (j < 128 ? p[1] : p[2]), j & 63);
            float v = 0.f;
            if (prompt) { const int tk = t - dil * j; if (tk >= 0) v = bf2f(Z[(size_t)tk * NIN + ZC_VC + hd * 64 + lane]); }
            else { const int idx = dil * (128 - j) + t;
                if (idx < Wc) v = cache[((size_t)b * Wc + idx) * 512 + 256 + hh * 64 + lane];
                else v = bf2f(Z[(size_t)(MP + b * 8 + idx - Wc) * NIN + ZC_VC + hd * 64 + lane]); }
            acc += pj * v;
        }
        og[g] = acc / l; lse[g] = m + logf(l);
    }
    const float mx = fmaxf(lse[0], fmaxf(lse[1], lse[2]));
    const float w0 = expf(lse[0] - mx), w1 = expf(lse[1] - mx), w2 = expf(lse[2] - mx);
    Y[(size_t)row * YK + 1024 + hh * 64 + lane] = f2bf((w0 * og[0] + w1 * og[1] + w2 * og[2]) / (w0 + w1 + w2));
}

__global__ void __launch_bounds__(256) k_cache(const bf16_t* __restrict__ Z, const float* __restrict__ cin  , float* __restrict__ outs  ,
                                               float* __restrict__ outp  , int Wc, int g, int bulk) {
    const size_t n4s = (size_t)32 * Wc * 128, n4p = (size_t)Wc * 128;
    for (size_t i = (size_t)blockIdx.x * 256 + threadIdx.x; i < n4s + n4p; i += (size_t)gridDim.x * 256) {
        if (i < n4s) {
            const int e4 = (int)(i & 127); const size_t r = i >> 7; const int b = (int)(r / Wc), ri = (int)(r % Wc);
            float4 v;
            if (ri + 8 < Wc) { if (!bulk) continue; v = *(const float4*)(cin + ((size_t)b * Wc + ri + 8) * 512 + e4 * 4); }
            else { const int tt = ri + 8 - Wc, e = e4 * 4, kv = e >> 8, hh = (e >> 6) & 3, d = e & 63;
                const bf16_t* z = Z + (size_t)(MP + b * 8 + tt) * NIN + (kv ? ZC_VC : ZC_KC) + (g * 4 + hh) * 64 + d;
                v = make_float4(bf2f(z[0]), bf2f(z[1]), bf2f(z[2]), bf2f(z[3])); }
            *(float4*)(outs + r * 512 + e4 * 4) = v;
        } else {
            const size_t ip = i - n4s; const int e4 = (int)(ip & 127), ri = (int)(ip >> 7), e = e4 * 4, kv = e >> 8, hh = (e >> 6) & 3, d = e & 63;
            const bf16_t* z = Z + (size_t)(MP - Wc + ri) * NIN + (kv ? ZC_VC : ZC_KC) + (g * 4 + hh) * 64 + d;
            *(float4*)(outp + (size_t)ri * 512 + e4 * 4) = make_float4(bf2f(z[0]), bf2f(z[1]), bf2f(z[2]), bf2f(z[3]));
        }
    }
}

extern "C" void kernel_launch(void* const* d_in, const int* in_sizes, int n_in, void* d_out, int out_size, void* d_ws, size_t ws_size, hipStream_t stream) {
    const float* const* in = (const float* const*)d_in;
    float* out = (float*)d_out; unsigned char* ws = (unsigned char*)d_ws;
    bf16_t* XN = (bf16_t*)(ws + WS_XN); bf16_t* Z = (bf16_t*)(ws + WS_Z); bf16_t* Y = (bf16_t*)(ws + WS_Y); bf16_t* MIX = (bf16_t*)(ws + WS_MIX);
    bf16_t* OB = (bf16_t*)(ws + WS_OB); float* X1 = (float*)(ws + WS_X1); float* X2 = (float*)(ws + WS_X2); bf16_t* HID = (bf16_t*)(ws + WS_HID);
    float* XC = (float*)(ws + WS_XC); float* LA = (float*)(ws + WS_LA); float* LBb = (float*)(ws + WS_LB); float* HRAW = (float*)(ws + WS_HRAW);
    static int grid = 0;
    if (grid == 0) {
        int dev = 0, cus = 0, per_cu = 0;
        hipGetDevice(&dev); hipDeviceGetAttribute(&cus, hipDeviceAttributeMultiprocessorCount, dev);
        hipFuncSetAttribute((const void*)mega, hipFuncAttributeMaxDynamicSharedMemorySize, LDS_BYTES);
        hipOccupancyMaxActiveBlocksPerMultiprocessor(&per_cu, (const void*)mega, NWAVES * 64, LDS_BYTES);
        if (per_cu < 1) per_cu = 1;
        grid = cus * 1;
        (void)hipGetLastError();
    }
    Args a{};
    for (int i = 0; i < 29; ++i) a.in[i] = (const float*)d_in[i];
    a.out = out; a.ws = ws;
    auto run = [&](int lo, int hi) { a.ph_lo = lo; a.ph_hi = hi; hipLaunchKernelGGL(mega, dim3(grid), dim3(NWAVES * 64), LDS_BYTES, stream, a); };
    for (int l = 0; l < 2; ++l) {
        unsigned char* wl = ws + WS_W + l * WS_WL;
    }
    run(PH_PRO, PH_PRO + 1);
    const int Wcs[3] = {128, 512, 2048};
    const size_t ocs[3] = {O_W128S, O_W512S, O_W2048S}, ocp[3] = {O_W128P, O_W512P, O_W2048P};
    for (int l = 0; l < 2; ++l) {
        unsigned char* wl = ws + WS_W + l * WS_WL;
        run(PH_LAYER0 + l * PH_PER_LAYER + P_G1, PH_LAYER0 + l * PH_PER_LAYER + P_G1 + 1);
        for (int g = 0; g < 3; ++g) {
            const int Wc = Wcs[g];
            k_cache<<<2048, 256, 0, stream>>>(Z, in[5 + g] + (size_t)l * 32 * Wc * 512, out + ocs[g] + (size_t)l * 32 * Wc * 512, out + ocp[g] + (size_t)l * Wc * 512, Wc, g, 0);
        }
        run(PH_LAYER0 + l * PH_PER_LAYER + P_MIX1, PH_LAYER0 + l * PH_PER_LAYER + P_MIX1 + 1);
        run(PH_LAYER0 + l * PH_PER_LAYER + P_MIX2, PH_LAYER0 + l * PH_PER_LAYER + P_MIX2 + 1);
        run(PH_LAYER0 + l * PH_PER_LAYER + P_MIX3, PH_LAYER0 + l * PH_PER_LAYER + P_MIX3 + 1);
        k_hgrn_seq<<<33 * 512 / 4, 256, 0, stream>>>(Z, in[4] + (size_t)l * 32 * 4 * 128 * 128, in[21], HRAW, out, l);
        k_hgrn_post<<<MT, 256, 0, stream>>>(HRAW, Z, in[22] + (size_t)l * 128, Y);
        k_attn<<<MT, 256, 0, stream>>>(Z, in[5] + (size_t)l * 32 * 128 * 512, in[6] + (size_t)l * 32 * 512 * 512, in[7] + (size_t)l * 32 * 2048 * 512, Y);
        run(PH_LAYER0 + l * PH_PER_LAYER + P_G2, PH_LAYER0 + l * PH_PER_LAYER + P_G2 + 1);
        run(PH_LAYER0 + l * PH_PER_LAYER + P_G3, PH_LAYER0 + l * PH_PER_LAYER + P_G3 + 1);
        const float* xp = l == 0 ? in[0] : X2; const float* xs = l == 0 ? in[1] : X2 + (size_t)MP * DM;
        run(PH_LAYER0 + l * PH_PER_LAYER + P_E1, PH_LAYER0 + l * PH_PER_LAYER + P_E1 + 1);
        run(PH_LAYER0 + l * PH_PER_LAYER + P_G4, PH_LAYER0 + l * PH_PER_LAYER + P_G4 + 1);
        run(PH_LAYER0 + l * PH_PER_LAYER + P_G5, PH_LAYER0 + l * PH_PER_LAYER + P_G5 + 1);
        float* xo = l == 0 ? X2 : out;
        run(PH_LAYER0 + l * PH_PER_LAYER + P_E2, PH_LAYER0 + l * PH_PER_LAYER + P_E2 + 1);
    }
}
```

```cpp
#include <hip/hip_runtime.h>
#include <stdint.h>

typedef unsigned short bf16_t;
#define DEV __device__ __forceinline__

DEV float bf2f(bf16_t b) { return __uint_as_float(((unsigned)b) << 16); }
DEV bf16_t f2bf(float f) { unsigned u = __float_as_uint(f); u += 0x7fffu + ((u >> 16) & 1u); return (bf16_t)(u >> 16); }
DEV float sigmoidf_(float x) { return 1.f / (1.f + expf(-x)); }
DEV float wave_sum(float v) {
#pragma unroll
    for (int o = 1; o < 64; o <<= 1) v += __shfl_xor(v, o);
    return v;
}
DEV float wave_max(float v) {
#pragma unroll
    for (int o = 1; o < 64; o <<= 1) v = fmaxf(v, __shfl_xor(v, o));
    return v;
}

constexpr int MP = 16384, MS = 256, MT = MP + MS;
constexpr int DM = 1024, NIN = 7936, DFF = 4096, YK = 1280;
constexpr int ZC_UA = 0, ZC_QB = 512, ZC_FB = 1024, ZC_IB = 1536, ZC_GB = 2048, ZC_QC = 2560, ZC_KC = 3328, ZC_VC = 4096, ZC_GATE = 4864;
constexpr int NB = 32, NT = 8;
constexpr size_t O_Y = 0, O_CONVP = 17039360, O_CONVS = 17042432, O_LRUP = 17140736, O_LRUS = 17141760, O_HGP = 17174528, O_HGS = 17305600,
                 O_W128P = 21499904, O_W128S = 21630976, O_W512P = 25825280, O_W512S = 26349568, O_W2048P = 43126784, O_W2048S = 45223936;
constexpr size_t MiB = 1u << 20;
constexpr size_t WS_W = 1 * MiB, WS_WL = 40 * MiB;
constexpr size_t W_IN = 0, W_BR = 16 * MiB, W_OUT = 19 * MiB, W_UP = 21 * MiB, W_DN = 29 * MiB;
constexpr size_t WS_XN = 82 * MiB, WS_Z = 116 * MiB, WS_Y = 368 * MiB, WS_MIX = 409 * MiB, WS_OB = 442 * MiB, WS_X1 = 475 * MiB, WS_X2 = 540 * MiB,
                 WS_HID = 605 * MiB, WS_XC = 735 * MiB, WS_LA = 768 * MiB, WS_LB = 801 * MiB, WS_HRAW = 834 * MiB;

#include <hip/hip_cooperative_groups.h>
namespace pg8 {
#define PG8_LAS __attribute__((address_space(3)))
typedef unsigned short bf16_t;
typedef short bf16x8 __attribute__((ext_vector_type(8)));
typedef float f32x4 __attribute__((ext_vector_type(4)));
typedef unsigned u32x4 __attribute__((ext_vector_type(4)));
constexpr int BM = 256, BK = 64, HALF = 128, HTB = HALF * BK * 2  , STAGE_BYTES = 8 * HTB, NXCD = 8, WGM = 8;

__host__ __device__ __forceinline__ int lds_byte(int r, int c) { const int st = (r >> 4) * 2 + (c >> 5), rr = r & 15, cc = c & 31, ob = rr * 64 + cc * 2; return st * 1024 + (ob ^ (((ob >> 9) & 1) << 5)); }
__host__ __device__ __forceinline__ void stage_rc(int b, int& R, int& C) { const int st = b / 1024, sb = b % 1024, swz = sb ^ (((sb >> 9) & 1) << 5); R = (st >> 1) * 16 + swz / 64; C = (st & 1) * 32 + (swz % 64) / 2; }
__host__ __device__ __forceinline__ int perm32(int rho) { const int n = rho >> 4, i = rho & 15; return 8 * (i >> 2) + 4 * n + (i & 3); }

struct Unit { int pm, pn; };
struct Gemm { const bf16_t* A; const bf16_t* Bt; int M, N, K; };

struct StaticOrder {
    int nM, nN, nwg, G, c;
    __host__ __device__ void init(int M, int N, int G_, int c_) { nM = M / BM; nN = N / BM; nwg = nM * nN; G = G_; c = c_; }
    __host__ __device__ bool next(int i, Unit& u) const {
        const long L = (long)i * G + c; if (L >= nwg) return false;
        int wgid = (int)L; { const int q = nwg / NXCD, r = nwg % NXCD, xcd = wgid % NXCD, off = wgid / NXCD; wgid = (xcd < r ? xcd * (q + 1) : r * (q + 1) + (xcd - r) * q) + off; }
        const int nig = WGM * nN, gid = wgid / nig, fm = gid * WGM, gsz = (nM - fm) < WGM ? (nM - fm) : WGM;
        u.pm = fm + ((wgid % nig) % gsz); u.pn = (wgid % nig) / gsz; return true;
    }
    __device__ __forceinline__ void a_ready(const Unit&) const {}
    __device__ __forceinline__ void done(const Unit&) const {}
};
__device__ __forceinline__ unsigned cvt_pk_bf16(float lo, float hi) { unsigned r; asm volatile("v_cvt_pk_bf16_f32 %0, %1, %2" : "=v"(r) : "v"(lo), "v"(hi)); return r; }
__device__ __forceinline__ float fsig(float x) { return __builtin_amdgcn_rcpf(1.f + __expf(-x)); }
__device__ __forceinline__ float bflo(unsigned w) { return __uint_as_float(w << 16); }
__device__ __forceinline__ float bfhi(unsigned w) { return __uint_as_float(w & 0xffff0000u); }
constexpr int ZP = 7936;
struct EpiZ {
    static constexpr bool PERM = true, AFTER_DRAIN = false, HOOK = false;
    bf16_t* Z; const float* bgate;
    __device__ __forceinline__ void operator()(const f32x4 (&acc)[2][2][4][2], const Unit& u, int wr, int wc, int fr, int fq) const {
        const int colt = u.pn * BM;
        const int mode = colt >= 4864 ? 3 : (((colt >= 512 && colt < 1024) || (colt >= 2048 && colt < 2560)) ? 1 : ((colt >= 2560 && colt < 3328) ? 2 : 0));
        const int row0 = u.pm * BM + wr * 64 + fr, col0 = colt + wc * 32 + 8 * fq;
        f32x4 bv[2][2];
#pragma unroll
        for (int bj = 0; bj < 2; ++bj)
#pragma unroll
            for (int n = 0; n < 2; ++n) bv[bj][n] = mode == 3 ? *(const f32x4*)(bgate + (col0 - 4864) + bj * HALF + 4 * n) : (f32x4){0.f, 0.f, 0.f, 0.f};
#pragma unroll
        for (int ai = 0; ai < 2; ++ai)
#pragma unroll
            for (int m = 0; m < 4; ++m) { bf16_t* rowp = Z + (size_t)(row0 + ai * HALF + m * 16) * ZP + col0;
#pragma unroll
                for (int bj = 0; bj < 2; ++bj) { f32x4 v0 = acc[ai][bj][m][0] + bv[bj][0], v1 = acc[ai][bj][m][1] + bv[bj][1];
                    if (mode == 3) {
#pragma unroll
                        for (int j = 0; j < 4; ++j) { v0[j] = fsig(v0[j]); v1[j] = fsig(v1[j]); } }
                    else if (mode == 1) {
#pragma unroll
                        for (int j = 0; j < 4; ++j) { v0[j] = v0[j] * fsig(v0[j]); v1[j] = v1[j] * fsig(v1[j]); } }
                    else if (mode == 2) { v0 = v0 * 0.125f; v1 = v1 * 0.125f; }
                    u32x4 w; w.x = cvt_pk_bf16(v0[0], v0[1]); w.y = cvt_pk_bf16(v0[2], v0[3]); w.z = cvt_pk_bf16(v1[0], v1[1]); w.w = cvt_pk_bf16(v1[2], v1[3]);
                    *(u32x4*)(rowp + bj * HALF) = w; } }
    }
};
template <int ACT  > struct EpiBf {
    static constexpr bool PERM = true, AFTER_DRAIN = false, HOOK = false;
    bf16_t* O; int ldc;
    __device__ __forceinline__ void operator()(const f32x4 (&acc)[2][2][4][2], const Unit& u, int wr, int wc, int fr, int fq) const {
        const int row0 = u.pm * BM + wr * 64 + fr, col0 = u.pn * BM + wc * 32 + 8 * fq;
#pragma unroll
        for (int ai = 0; ai < 2; ++ai)
#pragma unroll
            for (int m = 0; m < 4; ++m) { bf16_t* rowp = O + (size_t)(row0 + ai * HALF + m * 16) * ldc + col0;
#pragma unroll
                for (int bj = 0; bj < 2; ++bj) { f32x4 v0 = acc[ai][bj][m][0], v1 = acc[ai][bj][m][1];
                    if (ACT == 1) {
#pragma unroll
                        for (int j = 0; j < 4; ++j) { const float a = fmaxf(v0[j], 0.f), b = fmaxf(v1[j], 0.f); v0[j] = a * a; v1[j] = b * b; } }
                    u32x4 w; w.x = cvt_pk_bf16(v0[0], v0[1]); w.y = cvt_pk_bf16(v0[2], v0[3]); w.z = cvt_pk_bf16(v1[0], v1[1]); w.w = cvt_pk_bf16(v1[2], v1[3]);
                    *(u32x4*)(rowp + bj * HALF) = w; } }
    }
};
struct EpiMix {
    static constexpr bool PERM = true, AFTER_DRAIN = false, HOOK = true;
    const bf16_t* Z; bf16_t* O;
    __device__ __forceinline__ void hook(f32x4 (&acc)[2][2][4][2], const Unit& u, int wr, int wc, int fr, int fq, int t) const {
        const int seg = t == 8 ? 0 : 1;
        int row0 = u.pm * BM + wr * 64 + fr; const int col0 = u.pn * BM + wc * 32 + 8 * fq;
        asm volatile("" : "+v"(row0));
#pragma unroll
        for (int ai = 0; ai < 2; ++ai)
#pragma unroll
            for (int m = 0; m < 4; ++m) { const bf16_t* gp = (const bf16_t*)((const char*)Z + (unsigned)(((row0 + ai * HALF + m * 16) * ZP + 4864 + seg * 1024 + col0) * 2));
#pragma unroll
                for (int bj = 0; bj < 2; ++bj) { const u32x4 ga = *(const u32x4*)(gp + bj * HALF), gb = *(const u32x4*)(gp + 1024 + bj * HALF);
                    f32x4 r0, r1;
                    r0[0] = fmaxf(bflo(ga.x), 1e-30f) * __builtin_amdgcn_rcpf(fmaxf(bflo(gb.x), 1e-30f)); r0[1] = fmaxf(bfhi(ga.x), 1e-30f) * __builtin_amdgcn_rcpf(fmaxf(bfhi(gb.x), 1e-30f));
                    r0[2] = fmaxf(bflo(ga.y), 1e-30f) * __builtin_amdgcn_rcpf(fmaxf(bflo(gb.y), 1e-30f)); r0[3] = fmaxf(bfhi(ga.y), 1e-30f) * __builtin_amdgcn_rcpf(fmaxf(bfhi(gb.y), 1e-30f));
                    r1[0] = fmaxf(bflo(ga.z), 1e-30f) * __builtin_amdgcn_rcpf(fmaxf(bflo(gb.z), 1e-30f)); r1[1] = fmaxf(bfhi(ga.z), 1e-30f) * __builtin_amdgcn_rcpf(fmaxf(bfhi(gb.z), 1e-30f));
                    r1[2] = fmaxf(bflo(ga.w), 1e-30f) * __builtin_amdgcn_rcpf(fmaxf(bflo(gb.w), 1e-30f)); r1[3] = fmaxf(bfhi(ga.w), 1e-30f) * __builtin_amdgcn_rcpf(fmaxf(bfhi(gb.w), 1e-30f));
                    acc[ai][bj][m][0] = acc[ai][bj][m][0] * r0; acc[ai][bj][m][1] = acc[ai][bj][m][1] * r1;
                    asm volatile("" ::: "memory"); } }
    }
    __device__ __forceinline__ void operator()(const f32x4 (&acc)[2][2][4][2], const Unit& u, int wr, int wc, int fr, int fq) const {
        int row0 = u.pm * BM + wr * 64 + fr; const int col0 = u.pn * BM + wc * 32 + 8 * fq;
        asm volatile("" : "+v"(row0));
#pragma unroll
        for (int ai = 0; ai < 2; ++ai)
#pragma unroll
            for (int m = 0; m < 4; ++m) { const int row = row0 + ai * HALF + m * 16; const bf16_t* gp = (const bf16_t*)((const char*)Z + (unsigned)((row * ZP + 4864 + 2048 + col0) * 2)); bf16_t* rowp = (bf16_t*)((char*)O + (unsigned)((row * 1024 + col0) * 2));
#pragma unroll
                for (int bj = 0; bj < 2; ++bj) { const u32x4 g = *(const u32x4*)(gp + bj * HALF);
                    f32x4 v0 = acc[ai][bj][m][0], v1 = acc[ai][bj][m][1];
                    v0[0] *= fmaxf(bflo(g.x), 1e-30f); v0[1] *= fmaxf(bfhi(g.x), 1e-30f); v0[2] *= fmaxf(bflo(g.y), 1e-30f); v0[3] *= fmaxf(bfhi(g.y), 1e-30f);
                    v1[0] *= fmaxf(bflo(g.z), 1e-30f); v1[1] *= fmaxf(bfhi(g.z), 1e-30f); v1[2] *= fmaxf(bflo(g.w), 1e-30f); v1[3] *= fmaxf(bfhi(g.w), 1e-30f);
                    u32x4 w; w.x = cvt_pk_bf16(v0[0], v0[1]); w.y = cvt_pk_bf16(v0[2], v0[3]); w.z = cvt_pk_bf16(v1[0], v1[1]); w.w = cvt_pk_bf16(v1[2], v1[3]);
                    *(u32x4*)(rowp + bj * HALF) = w; }
                asm volatile("" ::: "memory"); }
    }
};
template <class Epi, class Sched, bool ALIGN_EPI = false, bool SP2 = false>
__device__ __forceinline__ void gemm_phase(PG8_LAS unsigned char* lds, const Gemm g, const Sched& S, const Epi& E) {
    int tid_ = threadIdx.x; asm volatile("" : "+v"(tid_));
    const int tid = tid_, wid = __builtin_amdgcn_readfirstlane(tid >> 6), lane = tid & 63, wr = wid >> 2, wc = wid & 3, fr = lane & 15, fq = lane >> 4;
    const int K = g.K, nt = K / BK;
    unsigned voffA[2], voffB[2];
#pragma unroll
    for (int i = 0; i < 2; ++i) { int R, C; stage_rc(tid * 16 + i * 8192, R, C); const int Rb = Epi::PERM ? ((R & ~31) + perm32(R & 31)) : R;
        voffA[i] = (unsigned)(R * K + C) * 2u; voffB[i] = (unsigned)(Rb * K + C) * 2u; }
    const size_t kstep = (size_t)(BK * 2);
    const size_t hstep = (size_t)HALF * K * 2;
    const size_t tstep = 2 * hstep;
    const unsigned ldsw = (unsigned)wid * 1024u;
    const int aoff = lds_byte(wr * 64 + fr, fq * 8), boff = lds_byte(wc * 32 + fr, fq * 8);
#define PG8_SA(b, h) (((b) * 2 + (h)) * HTB)
#define PG8_SB(b, h) ((4 + (b) * 2 + (h)) * HTB)
#define PG8_STAGE(bufoff, gbase, voff) do { _Pragma("unroll") for (int _i = 0; _i < 2; ++_i) \
        __builtin_amdgcn_global_load_lds((const unsigned*)((const char*)(gbase) + (voff)[_i]), (PG8_LAS unsigned*)(lds + (bufoff) + ldsw + _i * 8192), 16, 0, 0); } while (0)
#define PG8_LDA(dst, b, h) do { _Pragma("unroll") for (int m = 0; m < 4; ++m) _Pragma("unroll") for (int k = 0; k < 2; ++k) dst[m][k] = *(const PG8_LAS bf16x8*)(lds + PG8_SA(b, h) + aoff + m * 2048 + k * 1024); } while (0)
#define PG8_LDB(dst, b, h) do { _Pragma("unroll") for (int n = 0; n < 2; ++n) _Pragma("unroll") for (int k = 0; k < 2; ++k) dst[n][k] = *(const PG8_LAS bf16x8*)(lds + PG8_SB(b, h) + boff + n * 2048 + k * 1024); } while (0)
#define PG8_MMA(ai, bj, At, Bt) do { __builtin_amdgcn_s_setprio(1); _Pragma("unroll") for (int m = 0; m < 4; ++m) _Pragma("unroll") for (int n = 0; n < 2; ++n) _Pragma("unroll") for (int k = 0; k < 2; ++k) \
        acc[ai][bj][m][n] = __builtin_amdgcn_mfma_f32_16x16x32_bf16(Bt[n][k], At[m][k], acc[ai][bj][m][n], 0, 0, 0); __builtin_amdgcn_s_setprio(0); } while (0)
#define PG8_WAIT_V(n) asm volatile("s_waitcnt vmcnt(" #n ")" ::: "memory")
#define PG8_WAIT_L(n) asm volatile("s_waitcnt lgkmcnt(" #n ")" ::: "memory")
#define PG8_BAR __builtin_amdgcn_s_barrier()
#define PG8_SCHED __builtin_amdgcn_sched_barrier(0)
    Unit cur, nxt; int ui = 0;
    if (!S.next(0, cur)) return;
    f32x4 acc[2][2][4][2];
#pragma unroll
    for (int a = 0; a < 2; ++a)
#pragma unroll
        for (int b = 0; b < 2; ++b)
#pragma unroll
            for (int m = 0; m < 4; ++m)
#pragma unroll
                for (int n = 0; n < 2; ++n) acc[a][b][m][n] = (f32x4){0.f, 0.f, 0.f, 0.f};
    bf16x8 At[4][2], B0[2][2], B1[2][2];
    const char* cA = (const char*)g.A + (size_t)cur.pm * tstep; const char* cB = (const char*)g.Bt + (size_t)cur.pn * tstep;
    S.a_ready(cur);
    if constexpr (SP2) {
        PG8_STAGE(PG8_SB(0, 0), cB, voffB); PG8_STAGE(PG8_SB(0, 1), cB + hstep, voffB); PG8_STAGE(PG8_SA(0, 0), cA, voffA); PG8_STAGE(PG8_SA(0, 1), cA + hstep, voffA);
        if (wr == 1) PG8_BAR;
        PG8_WAIT_V(2); PG8_BAR;
        PG8_STAGE(PG8_SB(1, 0), cB + kstep, voffB); PG8_STAGE(PG8_SA(1, 0), cA + kstep, voffA); PG8_STAGE(PG8_SB(1, 1), cB + hstep + kstep, voffB);
        PG8_WAIT_V(6); PG8_BAR;
    } else {
        PG8_STAGE(PG8_SB(0, 0), cB, voffB); PG8_STAGE(PG8_SA(0, 0), cA, voffA); PG8_STAGE(PG8_SB(0, 1), cB + hstep, voffB); PG8_STAGE(PG8_SA(0, 1), cA + hstep, voffA);
        if (wr == 1) PG8_BAR;
        PG8_WAIT_V(4); PG8_BAR;
        PG8_STAGE(PG8_SB(1, 0), cB + kstep, voffB); PG8_STAGE(PG8_SA(1, 0), cA + kstep, voffA); PG8_STAGE(PG8_SB(1, 1), cB + hstep + kstep, voffB);
        PG8_WAIT_V(6); PG8_BAR;
    }
    for (;;) {
        const bool has_next = S.next(ui + 1, nxt);
        const char* nA = has_next ? (const char*)g.A + (size_t)nxt.pm * tstep : cA; const char* nB = has_next ? (const char*)g.Bt + (size_t)nxt.pn * tstep : cB;
        for (int t = 0; t < nt; t += 2) {
            if constexpr (Epi::HOOK) { if (t == 8 || t == 16) { PG8_SCHED; E.hook(acc, cur, wr, wc, fr, fq, t); PG8_SCHED; } }
            const bool last = (t == nt - 2);
            const char* a1 = cA + (size_t)(t + 1) * kstep;
            const char* a2 = last ? nA : cA + (size_t)(t + 2) * kstep; const char* b2 = last ? nB : cB + (size_t)(t + 2) * kstep;
            const char* a3 = a2 + kstep; const char* b3 = b2 + kstep;
            if (last && has_next) S.a_ready(nxt);
            if constexpr (SP2) {
            PG8_LDB(B0, 0, 0); PG8_LDB(B1, 0, 1); PG8_SCHED; PG8_LDA(At, 0, 0); PG8_STAGE(PG8_SA(1, 1), a1 + hstep, voffA);
            PG8_WAIT_V(8); PG8_WAIT_L(0); PG8_BAR; PG8_MMA(0, 0, At, B0); PG8_MMA(0, 1, At, B1); PG8_BAR; PG8_SCHED;
            PG8_LDA(At, 0, 1); PG8_STAGE(PG8_SB(0, 0), b2, voffB); PG8_STAGE(PG8_SB(0, 1), b2 + hstep, voffB); PG8_STAGE(PG8_SA(0, 0), a2, voffA);
            PG8_WAIT_V(8); PG8_WAIT_L(0); PG8_BAR; PG8_MMA(1, 0, At, B0); PG8_MMA(1, 1, At, B1); PG8_BAR; PG8_SCHED;
            PG8_LDB(B0, 1, 0); PG8_LDB(B1, 1, 1); PG8_SCHED; PG8_LDA(At, 1, 0); PG8_STAGE(PG8_SA(0, 1), a2 + hstep, voffA);
            PG8_WAIT_V(8); PG8_WAIT_L(0); PG8_BAR; PG8_MMA(0, 0, At, B0); PG8_MMA(0, 1, At, B1); PG8_BAR; PG8_SCHED;
            PG8_LDA(At, 1, 1); PG8_STAGE(PG8_SB(1, 0), b3, voffB); PG8_STAGE(PG8_SB(1, 1), b3 + hstep, voffB); PG8_STAGE(PG8_SA(1, 0), a3, voffA);
            PG8_WAIT_V(8); PG8_WAIT_L(0); PG8_BAR; PG8_MMA(1, 0, At, B0); PG8_MMA(1, 1, At, B1); PG8_BAR; PG8_SCHED;
            } else {
            PG8_LDB(B0, 0, 0); PG8_SCHED; PG8_LDA(At, 0, 0); PG8_STAGE(PG8_SA(1, 1), a1 + hstep, voffA);
            PG8_WAIT_L(8); PG8_BAR; PG8_WAIT_L(0); PG8_MMA(0, 0, At, B0); PG8_BAR; PG8_SCHED;
            PG8_LDB(B1, 0, 1); PG8_STAGE(PG8_SB(0, 0), b2, voffB);
            PG8_BAR; PG8_WAIT_L(0); PG8_MMA(0, 1, At, B1); PG8_BAR;
            PG8_LDA(At, 0, 1); PG8_STAGE(PG8_SA(0, 0), a2, voffA);
            PG8_BAR; PG8_WAIT_L(0); PG8_MMA(1, 0, At, B0); PG8_BAR; PG8_SCHED;
            PG8_STAGE(PG8_SB(0, 1), b2 + hstep, voffB);
            PG8_WAIT_V(6); PG8_BAR; PG8_MMA(1, 1, At, B1); PG8_BAR;
            PG8_LDB(B0, 1, 0); PG8_SCHED; PG8_LDA(At, 1, 0); PG8_STAGE(PG8_SA(0, 1), a2 + hstep, voffA);
            PG8_WAIT_L(8); PG8_BAR; PG8_WAIT_L(0); PG8_MMA(0, 0, At, B0); PG8_BAR; PG8_SCHED;
            PG8_LDB(B1, 1, 1); PG8_STAGE(PG8_SB(1, 0), b3, voffB);
            PG8_BAR; PG8_WAIT_L(0); PG8_MMA(0, 1, At, B1); PG8_BAR;
            PG8_LDA(At, 1, 1); PG8_STAGE(PG8_SA(1, 0), a3, voffA);
            PG8_BAR; PG8_WAIT_L(0); PG8_MMA(1, 0, At, B0); PG8_BAR; PG8_SCHED;
            PG8_STAGE(PG8_SB(1, 1), b3 + hstep, voffB);
            PG8_WAIT_V(6); PG8_BAR; PG8_MMA(1, 1, At, B1); PG8_BAR;
            }
        }
        if constexpr (ALIGN_EPI) { if (wr == 0) PG8_BAR; }
        if constexpr (!Epi::AFTER_DRAIN) { E(acc, cur, wr, wc, fr, fq); S.done(cur); }
        if (!has_next) break;
#pragma unroll
        for (int a = 0; a < 2; ++a)
#pragma unroll
            for (int b = 0; b < 2; ++b)
#pragma unroll
                for (int m = 0; m < 4; ++m)
#pragma unroll
                    for (int n = 0; n < 2; ++n) acc[a][b][m][n] = (f32x4){0.f, 0.f, 0.f, 0.f};
        cur = nxt; cA = nA; cB = nB; ++ui;
        if constexpr (ALIGN_EPI) { if (wr == 1) PG8_BAR; }
    }
    PG8_WAIT_V(0);
    if constexpr (!ALIGN_EPI) { if (wr == 0) PG8_BAR; }
    PG8_BAR;
    if constexpr (Epi::AFTER_DRAIN) { E.fused(acc, cur, wr, wc, fr, fq, lds, wid, lane); S.done(cur); }
#undef PG8_SA
#undef PG8_SB
#undef PG8_STAGE
#undef PG8_LDA
#undef PG8_LDB
#undef PG8_MMA
#undef PG8_WAIT_V
#undef PG8_WAIT_L
#undef PG8_BAR
#undef PG8_SCHED
}
}
#define LAS __attribute__((address_space(3)))
constexpr int NWAVES = 8;
constexpr size_t WS_LAGG = 870 * MiB;
constexpr size_t WS_LHIN = 871 * MiB;
constexpr size_t WS_LRUW = 872 * MiB;
typedef float f32x4v __attribute__((ext_vector_type(4)));
typedef unsigned u32x4v __attribute__((ext_vector_type(4)));
typedef unsigned u32x2v __attribute__((ext_vector_type(2)));
DEV unsigned pk2(float lo, float hi) { return (unsigned)f2bf(lo) | ((unsigned)f2bf(hi) << 16); }
DEV int tid_opaque() { int t = threadIdx.x; asm volatile("" : "+v"(t)); return t; }
DEV void lds_wait() { asm volatile("s_waitcnt lgkmcnt(0)" ::: "memory"); }

DEV void wt_item(const float* __restrict__ W, int N, bf16_t* __restrict__ WT, int P, int koff, const float* __restrict__ scale, LAS float* scr, int item, int lane) {
    const int nblk = N / 32, kb = item / nblk, nb = item % nblk, k0 = 64 * kb, n0 = 32 * nb;
#pragma unroll 8
    for (int i = 0; i < 32; ++i) { const int kk = 2 * i + (lane >> 5); scr[kk * 33 + (lane & 31)] = W[(size_t)(k0 + kk) * N + n0 + (lane & 31)] * (scale ? scale[k0 + kk] : 1.f); }
    lds_wait();
    const int c = lane & 7;
#pragma unroll
    for (int j = 0; j < 4; ++j) { const int n = (lane >> 3) + 8 * j; const LAS float* s = scr + (8 * c) * 33 + n;
        u32x4v o; o.x = pk2(s[0 * 33], s[1 * 33]); o.y = pk2(s[2 * 33], s[3 * 33]); o.z = pk2(s[4 * 33], s[5 * 33]); o.w = pk2(s[6 * 33], s[7 * 33]);
        *(u32x4v*)(WT + (size_t)(n0 + n) * P + koff + k0 + 8 * c) = o; }
    lds_wait();
}
DEV void xn_row(const float* __restrict__ x, bf16_t* __restrict__ o, int lane) {
    const f32x4v* xr = (const f32x4v*)x + lane; f32x4v v[4]; float s = 0.f;
#pragma unroll
    for (int j = 0; j < 4; ++j) { v[j] = xr[64 * j]; s += (v[j].x * v[j].x + v[j].y * v[j].y) + (v[j].z * v[j].z + v[j].w * v[j].w); }
    const float rinv = rsqrtf(wave_sum(s) * (1.f / DM) + 1e-6f);
    u32x2v* o8 = (u32x2v*)o + lane;
#pragma unroll
    for (int j = 0; j < 4; ++j) { u32x2v w; w.x = pk2(v[j].x * rinv, v[j].y * rinv); w.y = pk2(v[j].z * rinv, v[j].w * rinv); o8[64 * j] = w; }
}
DEV void elt_row(const float* __restrict__ x, const bf16_t* __restrict__ O, const float* __restrict__ g, float* __restrict__ xout, bf16_t* __restrict__ xn, int lane) {
    const u32x2v* orow = (const u32x2v*)O + lane; f32x4v o[4]; float s = 0.f;
#pragma unroll
    for (int j = 0; j < 4; ++j) { const u32x2v w = orow[64 * j]; o[j].x = __uint_as_float(w.x << 16); o[j].y = __uint_as_float(w.x & 0xffff0000u); o[j].z = __uint_as_float(w.y << 16); o[j].w = __uint_as_float(w.y & 0xffff0000u);
        s += (o[j].x * o[j].x + o[j].y * o[j].y) + (o[j].z * o[j].z + o[j].w * o[j].w); }
    const float rinv = rsqrtf(wave_sum(s) * (1.f / DM) + 1e-6f);
    const f32x4v* xr = (const f32x4v*)x + lane; const f32x4v* gr = (const f32x4v*)g + lane; f32x4v v[4]; float s2 = 0.f;
#pragma unroll
    for (int j = 0; j < 4; ++j) { v[j] = xr[64 * j] + o[j] * rinv * gr[64 * j]; s2 += (v[j].x * v[j].x + v[j].y * v[j].y) + (v[j].z * v[j].z + v[j].w * v[j].w); }
    const float rinv2 = rsqrtf(wave_sum(s2) * (1.f / DM) + 1e-6f);
    f32x4v* xo = (f32x4v*)xout + lane; u32x2v* o8 = (u32x2v*)xn + lane;
#pragma unroll
    for (int j = 0; j < 4; ++j) { xo[64 * j] = v[j]; u32x2v w; w.x = pk2(v[j].x * rinv2, v[j].y * rinv2); w.y = pk2(v[j].z * rinv2, v[j].w * rinv2); o8[64 * j] = w; }
}
DEV void phase_prologue(const float* const* in, float* out, unsigned char* ws, LAS unsigned char* lds, int G, int c) {
    const int tid = tid_opaque(), lane = tid & 63, wave = tid >> 6, gw = c * NWAVES + wave, NGW = G * NWAVES;
    LAS float* scr = (LAS float*)(lds + wave * 16384);
    constexpr int I_IN = 16 * 248, I_BA = 8 * 32, I_BC = 4 * 32, I_OUT = 16 * 32, I_UP = 16 * 128, I_DN = 64 * 32, I_L = I_IN + 2 * I_BA + I_BC + I_OUT + I_UP + I_DN;
    for (int it = gw; it < 2 * I_L; it += NGW) {
        const int l = it / I_L; int r = it % I_L; unsigned char* wl = ws + WS_W + (size_t)l * WS_WL;
        if (r < I_IN) { wt_item(in[12] + (size_t)l * DM * NIN, NIN, (bf16_t*)(wl + W_IN), DM, 0, in[8] + l * DM, scr, r, lane); continue; } r -= I_IN;
        if (r < I_BA) { wt_item(in[23] + (size_t)l * 512 * DM, DM, (bf16_t*)(wl + W_BR), YK, 0, nullptr, scr, r, lane); continue; } r -= I_BA;
        if (r < I_BA) { wt_item(in[24] + (size_t)l * 512 * DM, DM, (bf16_t*)(wl + W_BR), YK, 512, nullptr, scr, r, lane); continue; } r -= I_BA;
        if (r < I_BC) { wt_item(in[25] + (size_t)l * 256 * DM, DM, (bf16_t*)(wl + W_BR), YK, 1024, nullptr, scr, r, lane); continue; } r -= I_BC;
        if (r < I_OUT) { wt_item(in[26] + (size_t)l * DM * DM, DM, (bf16_t*)(wl + W_OUT), DM, 0, nullptr, scr, r, lane); continue; } r -= I_OUT;
        if (r < I_UP) { wt_item(in[27] + (size_t)l * DM * DFF, DFF, (bf16_t*)(wl + W_UP), DM, 0, in[10] + l * DM, scr, r, lane); continue; } r -= I_UP;
        wt_item(in[28] + (size_t)l * DFF * DM, DM, (bf16_t*)(wl + W_DN), DFF, 0, nullptr, scr, r, lane);
    }
    bf16_t* XN = (bf16_t*)(ws + WS_XN);
    for (int m = gw; m < MT; m += NGW) xn_row(m < MP ? in[0] + (size_t)m * DM : in[1] + (size_t)(m - MP) * DM, XN + (size_t)m * DM, lane);
    { float* lw = (float*)(ws + WS_LRUW);
      for (int i = c * (NWAVES * 64) + tid; i < 2 * 2 * 8 * 4096; i += G * NWAVES * 64) { const int d = i & 63, e = (i >> 6) & 63, n = (i >> 12) & 7, k = (i >> 15) & 1, l = i >> 16;
          lw[i] = in[k ? 18 : 16][((size_t)(l * 8 + n) * 64 + d) * 64 + e]; } }
    const size_t gt = (size_t)c * (NWAVES * 64) + tid, NT_ = (size_t)G * NWAVES * 64;
#pragma unroll
    for (int g = 0; g < 3; ++g) {
        const int Wc = g == 0 ? 128 : (g == 1 ? 512 : 2048);
        const size_t o_s = g == 0 ? O_W128S : (g == 1 ? O_W512S : O_W2048S);
        const f32x4v* src = (const f32x4v*)in[5 + g] + 1024; f32x4v* dst = (f32x4v*)(out + o_s);
        const size_t n4 = (size_t)2 * 32 * Wc * 128; const unsigned blk4 = (unsigned)Wc * 128, lim4 = (unsigned)(Wc - 8) * 128;
        for (size_t i = gt; i < n4; i += 4 * NT_) {
            f32x4v v[4];
#pragma unroll
            for (int k = 0; k < 4; ++k) { const size_t j = i + (size_t)k * NT_; if (j < n4 && (unsigned)(j % blk4) < lim4) v[k] = __builtin_nontemporal_load(src + j); }
#pragma unroll
            for (int k = 0; k < 4; ++k) { const size_t j = i + (size_t)k * NT_; if (j < n4 && (unsigned)(j % blk4) < lim4) __builtin_nontemporal_store(v[k], dst + j); }
        }
    }
}
DEV void phase_elt(const float* xp, const float* xs, const bf16_t* O, const float* g, float* xout, bf16_t* XN, int G, int c) {
    const int tid = tid_opaque(), lane = tid & 63, wave = tid >> 6, gw = c * NWAVES + wave, NGW = G * NWAVES;
    for (int m = gw; m < MT; m += NGW) elt_row(m < MP ? xp + (size_t)m * DM : xs + (size_t)(m - MP) * DM, O + (size_t)m * DM, g, xout + (size_t)m * DM, XN + (size_t)m * DM, lane);
}

template <bool FINAL>
DEV void lru_item(const float* const* in, float* out, unsigned char* ws, LAS unsigned char* lds, int l, bool sample, int idx) {
    const int c = tid_opaque(), n = c >> 6, e = c & 63;
    const bf16_t* Z = (const bf16_t*)(ws + WS_Z); bf16_t* Y = (bf16_t*)(ws + WS_Y);
    LAS float* xc = (LAS float*)lds;
    const int T = sample ? 8 : 64, row0 = sample ? MP + idx * 8 : idx * 64;
    const float* cw = in[14] + (size_t)l * 4 * 512; const float cb = in[15][l * 512 + c];
    const float w0 = cw[c], w1 = cw[512 + c], w2 = cw[1024 + c], w3 = cw[1536 + c];
    float u0, u1, u2;
    if (sample) { const float* st = in[2] + ((size_t)l * 32 + idx) * 3 * 512; u0 = st[c]; u1 = st[512 + c]; u2 = st[1024 + c]; }
    else if (idx == 0) { u0 = 0.f; u1 = 0.f; u2 = 0.f; }
    else { u0 = bf2f(Z[(size_t)(row0 - 3) * NIN + c]); u1 = bf2f(Z[(size_t)(row0 - 2) * NIN + c]); u2 = bf2f(Z[(size_t)(row0 - 1) * NIN + c]); }
#pragma unroll 8
    for (int t = 0; t < T; ++t) { const float u3 = bf2f(Z[(size_t)(row0 + t) * NIN + c]);
        xc[t * 512 + c] = cb + w0 * u0 + w1 * u1 + w2 * u2 + w3 * u3; u0 = u1; u1 = u2; u2 = u3; }
    if (FINAL) {
        if (sample) { float* o = out + O_CONVS + ((size_t)l * 32 + idx) * 3 * 512; o[c] = u0; o[512 + c] = u1; o[1024 + c] = u2; }
        else if (idx == 255) { float* o = out + O_CONVP + (size_t)l * 3 * 512; o[c] = u0; o[512 + c] = u1; o[1024 + c] = u2; }
    }
    float wr[64], wi[64];
    { const f32x4v* pr = (const f32x4v*)((const float*)(ws + WS_LRUW) + ((size_t)(l * 2 + 0) * 8 + n) * 4096 + e * 64); const f32x4v* pi = pr + 8 * 4096 / 4;
#pragma unroll
      for (int d4 = 0; d4 < 16; ++d4) { const f32x4v a = pr[d4], b = pi[d4];
          wr[4 * d4] = a.x; wr[4 * d4 + 1] = a.y; wr[4 * d4 + 2] = a.z; wr[4 * d4 + 3] = a.w; wi[4 * d4] = b.x; wi[4 * d4 + 1] = b.y; wi[4 * d4 + 2] = b.z; wi[4 * d4 + 3] = b.w; } }
    const float br = in[17][l * 512 + c], bi = in[19][l * 512 + c];
    const float sp = -8.f * log1pf(expf(-in[20][l * 512 + c]));
    float h = 0.f, ap = 1.f;
    if (FINAL) h = sample ? in[3][((size_t)l * 32 + idx) * 512 + c] : ((const float*)(ws + WS_LHIN))[(size_t)idx * 512 + c];
    __syncthreads();
#pragma unroll 1
    for (int t = 0; t < T; ++t) {
        const LAS f32x4v* xv = (const LAS f32x4v*)(xc + t * 512 + n * 64);
        float rp = br, ip = bi;
#pragma unroll
        for (int d4 = 0; d4 < 16; ++d4) { const f32x4v x = xv[d4];
            rp += x.x * wr[4 * d4] + x.y * wr[4 * d4 + 1] + x.z * wr[4 * d4 + 2] + x.w * wr[4 * d4 + 3];
            ip += x.x * wi[4 * d4] + x.y * wi[4 * d4 + 1] + x.z * wi[4 * d4 + 2] + x.w * wi[4 * d4 + 3];
            if ((d4 & 3) == 3) asm volatile("" ::: "memory"); }
        const float r = __builtin_amdgcn_rcpf(1.f + __expf(-rp)), ig = __builtin_amdgcn_rcpf(1.f + __expf(-ip));
        const float log_a = sp * r, a = __expf(log_a);
        const float x2 = 2.f * log_a;
        const float em = x2 > -0.25f ? -x2 * (1.f + x2 * (0.5f + x2 * (0.16666667f + x2 * (0.041666668f + x2 * (0.0083333333f + x2 * 0.0013888889f))))) : 1.f - a * a;
        const float mult = (!sample && idx == 0 && t == 0) ? 1.f : __builtin_sqrtf(em);
        h = a * h + mult * ig * xc[t * 512 + c]; ap *= a;
        if (FINAL) Y[(size_t)(row0 + t) * YK + c] = f2bf(h);
    }
    if (FINAL) { if (sample) out[O_LRUS + ((size_t)l * 32 + idx) * 512 + c] = h; }
    else { float* ag = (float*)(ws + WS_LAGG) + (size_t)idx * 1024; ag[c] = ap; ag[512 + c] = h; }
    __syncthreads();
}
DEV void lru_scan(float* out, unsigned char* ws, int l) {
    const int c = tid_opaque(); const float* ag = (const float*)(ws + WS_LAGG); float* hin = (float*)(ws + WS_LHIN);
    float h = 0.f;
#pragma unroll 8
    for (int j = 0; j < 256; ++j) { const float a = ag[(size_t)j * 1024 + c], b = ag[(size_t)j * 1024 + 512 + c]; hin[(size_t)j * 512 + c] = h; h = a * h + b; }
    out[O_LRUP + (size_t)l * 512 + c] = h;
}
typedef short bf16x8v __attribute__((ext_vector_type(8)));
typedef short s16x4v __attribute__((ext_vector_type(4)));
constexpr size_t WS_OG = 873 * MiB;
constexpr size_t WS_LSE = 898 * MiB;
constexpr int AK_PITCH = 144, AV_PITCH = 528, AV_OFF = 256 * AK_PITCH;

DEV void attn_prompt_item(unsigned char* ws, LAS unsigned char* lds, int it) {
    const int tid = tid_opaque(), lane = tid & 63, w = tid >> 6, fr = lane & 15, fq = lane >> 4;
    const bf16_t* Z = (const bf16_t*)(ws + WS_Z);
    const int g = it >> 9, rem = it & 511, tile = rem >> 2, hh = rem & 3, hd = g * 4 + hh;
    const int dil = g == 0 ? 1 : (g == 1 ? 4 : 16), nb = 128 / dil, r = tile / nb, n = tile % nb;
    { const int key = tid >> 1, part = tid & 1; int m = 128 * (n - 1) + key; m = m < 0 ? 0 : m;
      const bf16_t* kp = Z + (size_t)(m * dil + r) * NIN + ZC_KC + hd * 64 + part * 32;
      u32x4v kk[4], vv[4];
#pragma unroll
      for (int j = 0; j < 4; ++j) { kk[j] = *(const u32x4v*)(kp + 8 * j); vv[j] = *(const u32x4v*)(kp + (ZC_VC - ZC_KC) + 8 * j); }
#pragma unroll
      for (int j = 0; j < 4; ++j) *(LAS u32x4v*)(lds + key * AK_PITCH + part * 64 + 16 * j) = kk[j];
#pragma unroll
      for (int j = 0; j < 4; ++j) { const unsigned wv[4] = {vv[j].x, vv[j].y, vv[j].z, vv[j].w};
#pragma unroll
          for (int i = 0; i < 4; ++i) { const int d = part * 32 + 8 * j + 2 * i;
              *(LAS unsigned short*)(lds + AV_OFF + d * AV_PITCH + key * 2) = (unsigned short)(wv[i] & 0xffffu);
              *(LAS unsigned short*)(lds + AV_OFF + (d + 1) * AV_PITCH + key * 2) = (unsigned short)(wv[i] >> 16); } } }
    const int tq = (128 * n + 16 * w + fr) * dil + r;
    bf16x8v bq[2];
    { const bf16_t* qp = Z + (size_t)tq * NIN + ZC_QC + hd * 64 + fq * 8; bq[0] = *(const bf16x8v*)qp; bq[1] = *(const bf16x8v*)(qp + 32); }
    __syncthreads();
    f32x4v s[9];
#pragma unroll
    for (int kbi = 0; kbi < 9; ++kbi) { const int kb = w + kbi; f32x4v a = {0.f, 0.f, 0.f, 0.f};
#pragma unroll
        for (int ks = 0; ks < 2; ++ks) { const bf16x8v ka = *(const LAS bf16x8v*)(lds + (kb * 16 + fr) * AK_PITCH + ks * 64 + fq * 16);
            a = __builtin_amdgcn_mfma_f32_16x16x32_bf16(ka, bq[ks], a, 0, 0, 0); }
        s[kbi] = a; }
    float mx = -1e30f;
#pragma unroll
    for (int kbi = 0; kbi < 9; ++kbi)
#pragma unroll
        for (int j = 0; j < 4; ++j) { bool ok = !(n == 0 && w + kbi < 8);
            if (kbi == 0) ok = ok && (fr <= fq * 4 + j);
            if (kbi == 8) ok = ok && (fr >= fq * 4 + j);
            s[kbi][j] = ok ? s[kbi][j] : -1e30f; mx = fmaxf(mx, s[kbi][j]); }
    mx = fmaxf(mx, __shfl_xor(mx, 16)); mx = fmaxf(mx, __shfl_xor(mx, 32));
    float lsum = 0.f;
#pragma unroll
    for (int kbi = 0; kbi < 9; ++kbi)
#pragma unroll
        for (int j = 0; j < 4; ++j) { const float p = s[kbi][j] > -1e29f ? __expf(s[kbi][j] - mx) : 0.f; s[kbi][j] = p; lsum += p; }
    lsum += __shfl_xor(lsum, 16); lsum += __shfl_xor(lsum, 32);
    f32x4v o[4];
#pragma unroll
    for (int mb = 0; mb < 4; ++mb) o[mb] = (f32x4v){0.f, 0.f, 0.f, 0.f};
#pragma unroll
    for (int st = 0; st < 5; ++st) { const int kb0 = w + 2 * st, kb1 = st < 4 ? kb0 + 1 : kb0;
        bf16x8v bp; u32x4v bpw; bpw.x = pk2(s[2 * st][0], s[2 * st][1]); bpw.y = pk2(s[2 * st][2], s[2 * st][3]);
        if (st < 4) { bpw.z = pk2(s[2 * st + 1][0], s[2 * st + 1][1]); bpw.w = pk2(s[2 * st + 1][2], s[2 * st + 1][3]); } else { bpw.z = 0u; bpw.w = 0u; }
        bp = __builtin_bit_cast(bf16x8v, bpw);
#pragma unroll
        for (int mb = 0; mb < 4; ++mb) { const LAS unsigned char* vr = lds + AV_OFF + (mb * 16 + fr) * AV_PITCH + fq * 8;
            const u32x2v v0 = *(const LAS u32x2v*)(vr + kb0 * 32), v1 = *(const LAS u32x2v*)(vr + kb1 * 32);
            u32x4v av; av.x = v0.x; av.y = v0.y; av.z = v1.x; av.w = v1.y;
            o[mb] = __builtin_amdgcn_mfma_f32_16x16x32_bf16(__builtin_bit_cast(bf16x8v, av), bp, o[mb], 0, 0, 0); } }
    const float rl = 1.f / lsum;
    bf16_t* og = (bf16_t*)(ws + WS_OG) + ((size_t)g * MT + tq) * 256 + hh * 64 + fq * 4;
#pragma unroll
    for (int mb = 0; mb < 4; ++mb) { u32x2v wv; wv.x = pk2(o[mb][0] * rl, o[mb][1] * rl); wv.y = pk2(o[mb][2] * rl, o[mb][3] * rl); *(u32x2v*)(og + mb * 16) = wv; }
    if (fq == 0) ((float*)(ws + WS_LSE))[((size_t)g * MT + tq) * 4 + hh] = mx + __logf(lsum);
    __syncthreads();
}

DEV f32x4v arow4(const float* __restrict__ cache, const bf16_t* __restrict__ Z, int idx, int Wc, int b, int coff_c, int coff_z) {
    if (idx < Wc) return *(const f32x4v*)(cache + (size_t)idx * 512 + coff_c);
    const u32x2v w = *(const u32x2v*)(Z + (size_t)(MP + b * 8 + idx - Wc) * NIN + coff_z);
    return (f32x4v){__uint_as_float(w.x << 16), __uint_as_float(w.x & 0xffff0000u), __uint_as_float(w.y << 16), __uint_as_float(w.y & 0xffff0000u)};
}
DEV void attn_sample_item(const float* const* in, unsigned char* ws, int l, int it, int lane) {
    const bf16_t* Z = (const bf16_t*)(ws + WS_Z);
    const int g = it % 3, rh = it / 3, hh = rh & 3, rs = rh >> 2, b = rs >> 3, t = rs & 7, row = MP + rs;
    const int dil = g == 0 ? 1 : (g == 1 ? 4 : 16), Wc = 128 * dil, hd = g * 4 + hh;
    const float* cache = in[5 + g] + (size_t)l * 32 * Wc * 512 + (size_t)b * Wc * 512;
    const int ksub = lane >> 4, dq = lane & 15;
    f32x4v q4;
    { const u32x2v w = *(const u32x2v*)(Z + (size_t)row * NIN + ZC_QC + hd * 64 + dq * 4);
      q4 = (f32x4v){__uint_as_float(w.x << 16), __uint_as_float(w.x & 0xffff0000u), __uint_as_float(w.y << 16), __uint_as_float(w.y & 0xffff0000u)}; }
    float s[33]; float mx = -1e30f;
#pragma unroll
    for (int i = 0; i < 33; ++i) { const int j = 4 * i + ksub; const bool ok = j <= 128; const int idx = dil * (128 - (ok ? j : 128)) + t;
        const f32x4v k4 = arow4(cache, Z, idx, Wc, b, hh * 64 + dq * 4, ZC_KC + hd * 64 + dq * 4);
        float d = q4.x * k4.x + q4.y * k4.y + q4.z * k4.z + q4.w * k4.w;
        d += __shfl_xor(d, 1); d += __shfl_xor(d, 2); d += __shfl_xor(d, 4); d += __shfl_xor(d, 8);
        s[i] = ok ? d : -1e30f; mx = fmaxf(mx, s[i]); }
    mx = fmaxf(mx, __shfl_xor(mx, 16)); mx = fmaxf(mx, __shfl_xor(mx, 32));
    float lsum = 0.f;
#pragma unroll
    for (int i = 0; i < 33; ++i) { s[i] = s[i] > -1e29f ? __expf(s[i] - mx) : 0.f; lsum += s[i]; }
    lsum += __shfl_xor(lsum, 16); lsum += __shfl_xor(lsum, 32);
    f32x4v acc = {0.f, 0.f, 0.f, 0.f};
#pragma unroll
    for (int i = 0; i < 33; ++i) { const int j = 4 * i + ksub; const int idx = dil * (128 - (j <= 128 ? j : 128)) + t;
        const f32x4v v4 = arow4(cache, Z, idx, Wc, b, 256 + hh * 64 + dq * 4, ZC_VC + hd * 64 + dq * 4);
        acc += v4 * s[i]; }
#pragma unroll
    for (int k = 0; k < 4; ++k) { acc[k] += __shfl_xor(acc[k], 16); acc[k] += __shfl_xor(acc[k], 32); }
    const float rl = 1.f / lsum;
    if (ksub == 0) { u32x2v wv; wv.x = pk2(acc.x * rl, acc.y * rl); wv.y = pk2(acc.z * rl, acc.w * rl);
        *(u32x2v*)((bf16_t*)(ws + WS_OG) + ((size_t)g * MT + row) * 256 + hh * 64 + dq * 4) = wv; }
    if (lane == 0) ((float*)(ws + WS_LSE))[((size_t)g * MT + row) * 4 + hh] = mx + __logf(lsum);
}
DEV void attn_merge(unsigned char* ws, int G, int c) {
    const int tid = tid_opaque(), lane = tid & 63, wave = tid >> 6, gw = c * NWAVES + wave, NGW = G * NWAVES;
    const bf16_t* og = (const bf16_t*)(ws + WS_OG); const float* lse = (const float*)(ws + WS_LSE); bf16_t* Y = (bf16_t*)(ws + WS_Y);
    for (int wi = gw; wi < MT * 4 / 8; wi += NGW) { const int pr = wi * 8 + (lane >> 3), row = pr >> 2, hh = pr & 3, d8 = lane & 7;
        const float l0 = lse[(size_t)row * 4 + hh], l1 = lse[((size_t)MT + row) * 4 + hh], l2 = lse[((size_t)2 * MT + row) * 4 + hh];
        const float mx = fmaxf(l0, fmaxf(l1, l2)); float w0 = __expf(l0 - mx), w1 = __expf(l1 - mx), w2 = __expf(l2 - mx);
        const float rs = 1.f / (w0 + w1 + w2); w0 *= rs; w1 *= rs; w2 *= rs;
        const size_t off = (size_t)row * 256 + hh * 64 + d8 * 8;
        const u32x4v a = *(const u32x4v*)(og + off), b = *(const u32x4v*)(og + (size_t)MT * 256 + off), cc = *(const u32x4v*)(og + (size_t)2 * MT * 256 + off);
        const unsigned aw[4] = {a.x, a.y, a.z, a.w}, bw[4] = {b.x, b.y, b.z, b.w}, cw[4] = {cc.x, cc.y, cc.z, cc.w}; u32x4v o; unsigned ow[4];
#pragma unroll
        for (int i = 0; i < 4; ++i) ow[i] = pk2(w0 * __uint_as_float(aw[i] << 16) + w1 * __uint_as_float(bw[i] << 16) + w2 * __uint_as_float(cw[i] << 16),
                                             w0 * __uint_as_float(aw[i] & 0xffff0000u) + w1 * __uint_as_float(bw[i] & 0xffff0000u) + w2 * __uint_as_float(cw[i] & 0xffff0000u));
        o.x = ow[0]; o.y = ow[1]; o.z = ow[2]; o.w = ow[3];
        *(u32x4v*)(Y + (size_t)row * YK + 1024 + hh * 64 + d8 * 8) = o; }
}
DEV void cache_new_rows(float* out, unsigned char* ws, int l, int G, int c) {
    const int tid = tid_opaque(); const bf16_t* Z = (const bf16_t*)(ws + WS_Z);
    const int gt = c * (NWAVES * 64) + tid, NT_ = G * NWAVES * 64;
#pragma unroll
    for (int g = 0; g < 3; ++g) { const int Wc = g == 0 ? 128 : (g == 1 ? 512 : 2048);
        const size_t o_s = g == 0 ? O_W128S : (g == 1 ? O_W512S : O_W2048S), o_p = g == 0 ? O_W128P : (g == 1 ? O_W512P : O_W2048P);
        const int n_s = 32 * 8 * 128, n_p = Wc * 128;
        for (int i = gt; i < n_s + n_p; i += NT_) { int zrow; float* dst;
            const int e4 = i & 127, e = e4 * 4, kv = e >> 8, hh = (e >> 6) & 3, d = e & 63;
            if (i < n_s) { const int rr = i >> 7, b = rr >> 3, tt = rr & 7; zrow = MP + b * 8 + tt; dst = out + o_s + (((size_t)l * 32 + b) * Wc + (Wc - 8 + tt)) * 512 + e; }
            else { const int ri = (i - n_s) >> 7; zrow = MP - Wc + ri; dst = out + o_p + ((size_t)l * Wc + ri) * 512 + e; }
            const u32x2v z = *(const u32x2v*)(Z + (size_t)zrow * NIN + (kv ? ZC_VC : ZC_KC) + (g * 4 + hh) * 64 + d);
            *(f32x4v*)dst = (f32x4v){__uint_as_float(z.x << 16), __uint_as_float(z.x & 0xffff0000u), __uint_as_float(z.y << 16), __uint_as_float(z.y & 0xffff0000u)}; } }
}
constexpr size_t WS_HU = 900 * MiB;
constexpr size_t WS_HS = 916 * MiB;
constexpr size_t WS_HD = 932 * MiB;
constexpr int HQ_P = 272, HK_P = 80;
constexpr int H_QT = 0, H_KT = 8704, H_KH = 17408, H_VT = 27648, H_AT = 37888, H_DV = 40448, H_CS = 40960, H_RS = 43008;
template <int MODE  >
DEV void hgrn_item(const float* const* in, float* out, unsigned char* ws, LAS unsigned char* lds, int l, int idx) {
    const int tid = tid_opaque(), lane = tid & 63, w = tid >> 6, fr = lane & 15, fq = lane >> 4;
    const int ch = tid & 127, part = tid >> 7;
    const bf16_t* Z = (const bf16_t*)(ws + WS_Z); bf16_t* Y = (bf16_t*)(ws + WS_Y);
    const int h = idx & 3, blk = idx >> 2;
    const int row_base = MODE == 2 ? MP + blk * 8 : blk * 256;
    constexpr int NCH = MODE == 2 ? 1 : 8;
    float lb = 0.f;
    if (l == 1) { const float r0 = in[21][h * 128 + ch], r1 = in[21][512 + h * 128 + ch]; lb = 1.f / (1.f + __expf(r0 - r1)); }
    const float omlb = 1.f - lb;
    f32x4v S[8];
    if (MODE == 0) {
#pragma unroll
        for (int i = 0; i < 8; ++i) S[i] = (f32x4v){0.f, 0.f, 0.f, 0.f};
    } else if (MODE == 1) { const f32x4v* sp = (const f32x4v*)(ws + WS_HS) + (size_t)idx * 4096;
#pragma unroll
        for (int i = 0; i < 8; ++i) S[i] = sp[(i * 8 + w) * 64 + lane];
    } else { const float* sp = in[4] + (((size_t)l * 32 + blk) * 4 + h) * 16384;
#pragma unroll
        for (int i = 0; i < 8; ++i)
#pragma unroll
            for (int j = 0; j < 4; ++j) S[i][j] = sp[(16 * i + 4 * fq + j) * 128 + 16 * w + fr];
    }
    float dsum = 0.f;
    float rq[8], rz[8], rv[8];
    auto load_raw = [&](int cidx) {
#pragma unroll
        for (int k = 0; k < 8; ++k) { const int tok = part * 8 + k;
            if (MODE == 2 && tok >= 8) { rq[k] = 0.f; rz[k] = 0.f; rv[k] = 0.f; }
            else { const bf16_t* z = Z + (size_t)(row_base + cidx * 32 + tok) * NIN + h * 128 + ch;
                rq[k] = bf2f(z[ZC_QB]); rz[k] = bf2f(z[ZC_FB]); rv[k] = bf2f(z[ZC_IB]); } }
    };
    load_raw(0);
#pragma unroll 1
    for (int cidx = 0; cidx < NCH; ++cidx) {
        float lf[8], kk[8];
        float run = 0.f;
#pragma unroll
        for (int k = 0; k < 8; ++k) { const bool pad = MODE == 2 && part * 8 + k >= 8;
            const float sg = __builtin_amdgcn_rcpf(1.f + __expf(-rz[k]));
            const float f = lb + omlb * sg; run += pad ? 0.f : __logf(f); lf[k] = run; kk[k] = pad ? 0.f : omlb * (1.f - sg); }
        ((LAS float*)(lds + H_CS))[part * 128 + ch] = run;
        __syncthreads();
        float pre = 0.f, tot = 0.f;
#pragma unroll
        for (int p = 0; p < 4; ++p) { const float v = ((const LAS float*)(lds + H_CS))[p * 128 + ch]; tot += v; pre += p < part ? v : 0.f; }
        { u32x4v kh, vt; unsigned khw[4], vtw[4];
#pragma unroll
          for (int k2 = 0; k2 < 4; ++k2) {
              float qa, ka, ha, qb, kb2, hb;
              { const float b = pre + lf[2 * k2]; qa = rq[2 * k2] * __expf(b); ka = kk[2 * k2] * __expf(fminf(-b, 80.f)); ha = kk[2 * k2] * __expf(tot - b); }
              { const float b = pre + lf[2 * k2 + 1]; qb = rq[2 * k2 + 1] * __expf(b); kb2 = kk[2 * k2 + 1] * __expf(fminf(-b, 80.f)); hb = kk[2 * k2 + 1] * __expf(tot - b); }
              const int t0 = part * 8 + 2 * k2;
              *(LAS unsigned short*)(lds + H_QT + t0 * HQ_P + ch * 2) = f2bf(qa); *(LAS unsigned short*)(lds + H_QT + (t0 + 1) * HQ_P + ch * 2) = f2bf(qb);
              *(LAS unsigned short*)(lds + H_KT + t0 * HQ_P + ch * 2) = f2bf(ka); *(LAS unsigned short*)(lds + H_KT + (t0 + 1) * HQ_P + ch * 2) = f2bf(kb2);
              khw[k2] = pk2(ha, hb); vtw[k2] = pk2(rv[2 * k2], rv[2 * k2 + 1]); }
          kh.x = khw[0]; kh.y = khw[1]; kh.z = khw[2]; kh.w = khw[3]; vt.x = vtw[0]; vt.y = vtw[1]; vt.z = vtw[2]; vt.w = vtw[3];
          *(LAS u32x4v*)(lds + H_KH + ch * HK_P + part * 16) = kh; *(LAS u32x4v*)(lds + H_VT + ch * HK_P + part * 16) = vt; }
        if (part == 0) { ((LAS float*)(lds + H_DV))[ch] = __expf(tot); dsum += tot; }
        if (cidx + 1 < NCH) load_raw(cidx + 1);
        __syncthreads();
        if (MODE != 0 && w < 4) {
            const int mb = w == 0 ? 0 : (w == 3 ? 0 : 1), nbk = w == 2 ? 1 : (w == 3 ? 1 : 0);
            f32x4v a = {0.f, 0.f, 0.f, 0.f};
            if (w < 3) {
#pragma unroll
                for (int ks = 0; ks < 4; ++ks) { const bf16x8v qa = *(const LAS bf16x8v*)(lds + H_QT + (mb * 16 + fr) * HQ_P + ks * 64 + fq * 16);
                    const bf16x8v kb = *(const LAS bf16x8v*)(lds + H_KT + (nbk * 16 + fr) * HQ_P + ks * 64 + fq * 16);
                    a = __builtin_amdgcn_mfma_f32_16x16x32_bf16(qa, kb, a, 0, 0, 0); }
            }
#pragma unroll
            for (int j = 0; j < 4; ++j) { const bool keep = w == 1 || (w != 3 && fr <= fq * 4 + j);
                *(LAS unsigned short*)(lds + H_AT + (mb * 16 + fq * 4 + j) * HK_P + (nbk * 16 + fr) * 2) = f2bf(keep ? a[j] : 0.f); }
        }
        __syncthreads();
        const bf16x8v vfrag = *(const LAS bf16x8v*)(lds + H_VT + (16 * w + fr) * HK_P + fq * 16);
        f32x4v o[2];
        if (MODE != 0) {
            bf16x8v sb[4];
#pragma unroll
            for (int pb = 0; pb < 4; ++pb) { u32x4v t; t.x = pk2(S[2 * pb][0], S[2 * pb][1]); t.y = pk2(S[2 * pb][2], S[2 * pb][3]); t.z = pk2(S[2 * pb + 1][0], S[2 * pb + 1][1]); t.w = pk2(S[2 * pb + 1][2], S[2 * pb + 1][3]);
                sb[pb] = __builtin_bit_cast(bf16x8v, t); }
#pragma unroll
            for (int mb = 0; mb < 2; ++mb) {
                const bf16x8v af = *(const LAS bf16x8v*)(lds + H_AT + (mb * 16 + fr) * HK_P + fq * 16);
                f32x4v a = __builtin_amdgcn_mfma_f32_16x16x32_bf16(af, vfrag, (f32x4v){0.f, 0.f, 0.f, 0.f}, 0, 0, 0);
#pragma unroll
                for (int pb = 0; pb < 4; ++pb) { const LAS unsigned char* qr = lds + H_QT + (mb * 16 + fr) * HQ_P + fq * 8;
                    const u32x2v q0 = *(const LAS u32x2v*)(qr + (2 * pb) * 32), q1 = *(const LAS u32x2v*)(qr + (2 * pb + 1) * 32);
                    u32x4v qa; qa.x = q0.x; qa.y = q0.y; qa.z = q1.x; qa.w = q1.y;
                    a = __builtin_amdgcn_mfma_f32_16x16x32_bf16(__builtin_bit_cast(bf16x8v, qa), sb[pb], a, 0, 0, 0); }
                o[mb] = a; }
        }
#pragma unroll
        for (int i = 0; i < 8; ++i) { const f32x4v dv = *(const LAS f32x4v*)(lds + H_DV + (16 * i + 4 * fq) * 4);
            const bf16x8v kf = *(const LAS bf16x8v*)(lds + H_KH + (16 * i + fr) * HK_P + fq * 16);
            S[i] = __builtin_amdgcn_mfma_f32_16x16x32_bf16(kf, vfrag, S[i] * dv, 0, 0, 0); }
        if (MODE != 0) {
#pragma unroll
            for (int mb = 0; mb < 2; ++mb)
#pragma unroll
                for (int j = 0; j < 4; ++j) { float q = o[mb][j] * o[mb][j];
                    q += __shfl_xor(q, 1); q += __shfl_xor(q, 2); q += __shfl_xor(q, 4); q += __shfl_xor(q, 8);
                    if (fr == 0) ((LAS float*)(lds + H_RS))[w * 32 + mb * 16 + fq * 4 + j] = q; }
            __syncthreads();
            const float ng = in[22][l * 128 + 16 * w + fr];
#pragma unroll
            for (int mb = 0; mb < 2; ++mb)
#pragma unroll
                for (int j = 0; j < 4; ++j) { const int t = mb * 16 + fq * 4 + j; float q = 0.f;
#pragma unroll
                    for (int ww = 0; ww < 8; ++ww) q += ((const LAS float*)(lds + H_RS))[ww * 32 + t];
                    const float rinv = rsqrtf(q * (1.f / 128.f) + 1e-6f);
                    if (MODE == 2 && t >= 8) continue;
                    const size_t row = (size_t)(row_base + cidx * 32 + t);
                    const float gate = bf2f(Z[row * NIN + ZC_GB + h * 128 + 16 * w + fr]);
                    Y[row * YK + 512 + h * 128 + 16 * w + fr] = f2bf(o[mb][j] * rinv * ng * gate); }
        }
        __syncthreads();
    }
    if (MODE == 0) { f32x4v* up = (f32x4v*)(ws + WS_HU) + (size_t)idx * 4096;
#pragma unroll
        for (int i = 0; i < 8; ++i) up[(i * 8 + w) * 64 + lane] = S[i];
        if (part == 0) ((float*)(ws + WS_HD))[(size_t)idx * 128 + ch] = __expf(dsum);
    } else if (MODE == 2) { float* sp = out + O_HGS + (((size_t)l * 32 + blk) * 4 + h) * 16384;
#pragma unroll
        for (int i = 0; i < 8; ++i)
#pragma unroll
            for (int j = 0; j < 4; ++j) sp[(16 * i + 4 * fq + j) * 128 + 16 * w + fr] = S[i][j];
    }
}
DEV void hgrn_scan(float* out, unsigned char* ws, int l, int item) {
    const int tid = tid_opaque(); const int p = item * 512 + tid;
    const int h = p >> 12, q = p & 4095, i = q >> 9, w = (q >> 6) & 7, lane = q & 63, fr = lane & 15, fq = lane >> 4;
    const f32x4v* U = (const f32x4v*)(ws + WS_HU); f32x4v* Sst = (f32x4v*)(ws + WS_HS); const float* D = (const float*)(ws + WS_HD);
    f32x4v s = {0.f, 0.f, 0.f, 0.f};
#pragma unroll 8
    for (int sc = 0; sc < 64; ++sc) { const size_t o4 = ((size_t)sc * 4 + h) * 4096 + q;
        const f32x4v u = U[o4]; const f32x4v d = *(const f32x4v*)(D + ((size_t)sc * 4 + h) * 128 + 16 * i + 4 * fq);
        Sst[o4] = s; s = s * d + u; }
    float* sp = out + O_HGP + ((size_t)l * 4 + h) * 16384;
#pragma unroll
    for (int j = 0; j < 4; ++j) sp[(16 * i + 4 * fq + j) * 128 + 16 * w + fr] = s[j];
}
namespace cg = cooperative_groups;
constexpr int LDS_BYTES = 147456, RING_OFF = 0;
constexpr int PH_PRO = 0, PH_LAYER0 = 1, PH_PER_LAYER = 10, PH_END = PH_LAYER0 + 2 * PH_PER_LAYER;
constexpr int P_G1 = 0, P_MIX1 = 1, P_MIX2 = 2, P_MIX3 = 3, P_G2 = 4, P_G3 = 5, P_E1 = 6, P_G4 = 7, P_G5 = 8, P_E2 = 9;
struct Args { const float* in[29]; float* out; unsigned char* ws; int ph_lo, ph_hi; };
static_assert(sizeof(Args) == 31 * 8 + 8, "Args has no padding");
#ifndef PHMASK
#define PHMASK 0xffffffff
#endif
#define PHM(k) ((PHMASK >> (k)) & 1)

__global__ void __launch_bounds__(NWAVES * 64, 2) mega(Args args) {
    extern __shared__ __attribute__((aligned(16))) unsigned char lds_raw[];
    LAS unsigned char* lds = (LAS unsigned char*)lds_raw;
    cg::grid_group grid = cg::this_grid();
    const int G = gridDim.x, c = blockIdx.x;
    const int lo = args.ph_lo, hi = args.ph_hi;
#pragma unroll 1
    for (int ph = lo; ph < hi; ++ph) {
        unsigned char* ws = args.ws; asm volatile("" : "+s"(ws));
        const int l = ph >= PH_LAYER0 + PH_PER_LAYER ? 1 : 0, k = ph == PH_PRO ? -1 : ph - PH_LAYER0 - l * PH_PER_LAYER;
        bf16_t* XN = (bf16_t*)(ws + WS_XN); bf16_t* Z = (bf16_t*)(ws + WS_Z); bf16_t* Y = (bf16_t*)(ws + WS_Y); bf16_t* MIX = (bf16_t*)(ws + WS_MIX);
        bf16_t* OB = (bf16_t*)(ws + WS_OB); bf16_t* HID = (bf16_t*)(ws + WS_HID); float* X1 = (float*)(ws + WS_X1); float* X2 = (float*)(ws + WS_X2);
        unsigned char* wl = ws + WS_W + (size_t)l * WS_WL;
        if (ph == PH_PRO) phase_prologue(args.in, args.out, ws, lds, G, c);
        else if (PHM(P_G1) && k == P_G1) {
            pg8::Gemm g{XN, (const bf16_t*)(wl + W_IN), MT, NIN, DM}; pg8::StaticOrder S; S.init(MT, NIN, G, c);
            pg8::EpiZ E{Z, args.in[13] + (size_t)l * 3072};
            pg8::gemm_phase<pg8::EpiZ, pg8::StaticOrder, true, true>(lds + RING_OFF, g, S, E);
        } else if (PHM(P_MIX1) && k == P_MIX1) {
            for (int it = c; it < 288; it += G) { if (it < 256) lru_item<false>(args.in, args.out, ws, lds, l, false, it); else lru_item<true>(args.in, args.out, ws, lds, l, true, it - 256); }
            for (int it = c; it < 384; it += G) { if (it < 256) hgrn_item<0>(args.in, args.out, ws, lds, l, it); else hgrn_item<2>(args.in, args.out, ws, lds, l, it - 256); }
            for (int it = c; it < 1536; it += G) attn_prompt_item(ws, lds, it);
            { const int tid = tid_opaque(), lane = tid & 63, gw = c * NWAVES + (tid >> 6); for (int it = gw; it < 3072; it += G * NWAVES) attn_sample_item(args.in, ws, l, it, lane); }
            cache_new_rows(args.out, ws, l, G, c);
        } else if (PHM(P_MIX2) && k == P_MIX2) {
            if (c < 32) hgrn_scan(args.out, ws, l, c); else if (c == 32) lru_scan(args.out, ws, l);
        } else if (PHM(P_MIX3) && k == P_MIX3) {
            for (int it = c; it < 256; it += G) lru_item<true>(args.in, args.out, ws, lds, l, false, it);
            for (int it = c; it < 256; it += G) hgrn_item<1>(args.in, args.out, ws, lds, l, it);
            attn_merge(ws, G, c);
        } else if (PHM(P_G2) && k == P_G2) {
            pg8::Gemm g{Y, (const bf16_t*)(wl + W_BR), MT, DM, YK}; pg8::StaticOrder S; S.init(MT, DM, G, c);
            pg8::EpiMix E{Z, MIX};
            pg8::gemm_phase<pg8::EpiMix, pg8::StaticOrder, true, true>(lds + RING_OFF, g, S, E);
        } else if (PHM(P_G3) && k == P_G3) {
            pg8::Gemm g{MIX, (const bf16_t*)(wl + W_OUT), MT, DM, DM}; pg8::StaticOrder S; S.init(MT, DM, G, c);
            pg8::EpiBf<0> E{OB, DM};
            pg8::gemm_phase<pg8::EpiBf<0>, pg8::StaticOrder, true, true>(lds + RING_OFF, g, S, E);
        } else if (PHM(P_E1) && k == P_E1) {
            phase_elt(l == 0 ? args.in[0] : X2, l == 0 ? args.in[1] : X2 + (size_t)MP * DM, OB, args.in[9] + (size_t)l * DM, X1, XN, G, c);
        } else if (PHM(P_G4) && k == P_G4) {
            pg8::Gemm g{XN, (const bf16_t*)(wl + W_UP), MT, DFF, DM}; pg8::StaticOrder S; S.init(MT, DFF, G, c);
            pg8::EpiBf<1> E{HID, DFF};
            pg8::gemm_phase<pg8::EpiBf<1>, pg8::StaticOrder, true, true>(lds + RING_OFF, g, S, E);
        } else if (PHM(P_G5) && k == P_G5) {
            pg8::Gemm g{HID, (const bf16_t*)(wl + W_DN), MT, DM, DFF}; pg8::StaticOrder S; S.init(MT, DM, G, c);
            pg8::EpiBf<0> E{OB, DM};
            pg8::gemm_phase<pg8::EpiBf<0>, pg8::StaticOrder, true, true>(lds + RING_OFF, g, S, E);
        } else if (PHM(P_E2) && k == P_E2) {
            phase_elt(X1, X1 + (size_t)MP * DM, OB, args.in[11] + (size_t)l * DM, l == 0 ? X2 : args.out, XN, G, c);
        }
        if (ph + 1 < hi) grid.sync();
    }
}
__global__ void __launch_bounds__(256) k_wt(const float* __restrict__ src, int K, int N, bf16_t* __restrict__ dst, int P, int koff, const float* __restrict__ scale) {
    __shared__ float t[32][33];
    const int n0 = blockIdx.x * 32, k0 = blockIdx.y * 32, tx = threadIdx.x & 31, ty = threadIdx.x >> 5;
    for (int i = ty; i < 32; i += 8) t[i][tx] = src[(size_t)(k0 + i) * N + n0 + tx] * (scale ? scale[k0 + i] : 1.f);
    __syncthreads();
    for (int i = ty; i < 32; i += 8) dst[(size_t)(n0 + i) * P + koff + k0 + tx] = f2bf(t[tx][i]);
}

__global__ void __launch_bounds__(256) k_xn(const float* __restrict__ xp, const float* __restrict__ xs, bf16_t* __restrict__ XN) {
    const int row = blockIdx.x * 4 + (threadIdx.x >> 6), lane = threadIdx.x & 63;
    if (row >= MT) return;
    const float* x = row < MP ? xp + (size_t)row * DM : xs + (size_t)(row - MP) * DM;
    float v[16]; float s = 0.f;
#pragma unroll
    for (int j = 0; j < 16; ++j) { v[j] = x[lane + 64 * j]; s += v[j] * v[j]; }
    s = wave_sum(s);
    const float rinv = rsqrtf(s * (1.f / DM) + 1e-6f);
#pragma unroll
    for (int j = 0; j < 16; ++j) XN[(size_t)row * DM + lane + 64 * j] = f2bf(v[j] * rinv);
}

__global__ void __launch_bounds__(256) k_elt(const float* __restrict__ xp, const float* __restrict__ xs, const bf16_t* __restrict__ O, const float* __restrict__ g,
                                             float* __restrict__ xout, bf16_t* __restrict__ XN) {
    const int row = blockIdx.x * 4 + (threadIdx.x >> 6), lane = threadIdx.x & 63;
    if (row >= MT) return;
    const float* x = row < MP ? xp + (size_t)row * DM : xs + (size_t)(row - MP) * DM;
    float o[16], v[16]; float s = 0.f;
#pragma unroll
    for (int j = 0; j < 16; ++j) { o[j] = bf2f(O[(size_t)row * DM + lane + 64 * j]); s += o[j] * o[j]; }
    s = wave_sum(s);
    const float rinv = rsqrtf(s * (1.f / DM) + 1e-6f);
    float s2 = 0.f;
#pragma unroll
    for (int j = 0; j < 16; ++j) { v[j] = x[lane + 64 * j] + o[j] * rinv * g[lane + 64 * j]; s2 += v[j] * v[j]; }
    s2 = wave_sum(s2);
    const float rinv2 = rsqrtf(s2 * (1.f / DM) + 1e-6f);
#pragma unroll
    for (int j = 0; j < 16; ++j) { xout[(size_t)row * DM + lane + 64 * j] = v[j]; XN[(size_t)row * DM + lane + 64 * j] = f2bf(v[j] * rinv2); }
}

struct NEpiZ {
    bf16_t* Z; const float* bgate;
    DEV void operator()(int m, int n, float v) const {
        float r = v;
        if (n >= ZC_GATE) r = sigmoidf_(v + bgate[n - ZC_GATE]);
        else if ((n >= ZC_QB && n < ZC_FB) || (n >= ZC_GB && n < ZC_QC)) r = v * sigmoidf_(v);
        else if (n >= ZC_QC && n < ZC_KC) r = v * 0.125f;
        Z[(size_t)m * NIN + n] = f2bf(r);
    }
};
struct NEpiBf {
    bf16_t* O; int N;
    DEV void operator()(int m, int n, float v) const { O[(size_t)m * N + n] = f2bf(v); }
};
struct NEpiRelu2 {
    bf16_t* O; int N;
    DEV void operator()(int m, int n, float v) const { float r = fmaxf(v, 0.f); O[(size_t)m * N + n] = f2bf(r * r); }
};
template <class Epi, bool GATED>
__global__ void __launch_bounds__(256) k_gemm(const bf16_t* __restrict__ A, const bf16_t* __restrict__ Bt, int M, int N, int K, Epi E, const bf16_t* __restrict__ Zg) {
    __shared__ float sA[32][65], sB[32][65];
    const int tx = threadIdx.x & 15, ty = threadIdx.x >> 4, m0 = blockIdx.y * 64, n0 = blockIdx.x * 64;
    float acc[4][4], tot[4][4];
#pragma unroll
    for (int i = 0; i < 4; ++i)
#pragma unroll
        for (int j = 0; j < 4; ++j) { acc[i][j] = 0.f; tot[i][j] = 0.f; }
    for (int k0 = 0; k0 < K; k0 += 32) {
        if (GATED && (k0 == 512 || k0 == 1024)) {
            const int seg = k0 == 512 ? 0 : 1;
#pragma unroll
            for (int i = 0; i < 4; ++i)
#pragma unroll
                for (int j = 0; j < 4; ++j) { tot[i][j] += acc[i][j] * bf2f(Zg[(size_t)(m0 + ty * 4 + i) * NIN + ZC_GATE + seg * 1024 + n0 + tx * 4 + j]); acc[i][j] = 0.f; }
        }
        for (int i = threadIdx.x; i < 2048; i += 256) { const int r = i >> 5, c = i & 31;
            sA[c][r] = bf2f(A[(size_t)(m0 + r) * K + k0 + c]); sB[c][r] = bf2f(Bt[(size_t)(n0 + r) * K + k0 + c]); }
        __syncthreads();
#pragma unroll 8
        for (int kk = 0; kk < 32; ++kk) {
            float a[4], b[4];
#pragma unroll
            for (int i = 0; i < 4; ++i) { a[i] = sA[kk][ty * 4 + i]; b[i] = sB[kk][tx * 4 + i]; }
#pragma unroll
            for (int i = 0; i < 4; ++i)
#pragma unroll
                for (int j = 0; j < 4; ++j) acc[i][j] += a[i] * b[j];
        }
        __syncthreads();
    }
#pragma unroll
    for (int i = 0; i < 4; ++i)
#pragma unroll
        for (int j = 0; j < 4; ++j) {
            const int m = m0 + ty * 4 + i, n = n0 + tx * 4 + j;
            float v = acc[i][j];
            if (GATED) v = tot[i][j] + v * bf2f(Zg[(size_t)m * NIN + ZC_GATE + 2 * 1024 + n]);
            E(m, n, v);
        }
}

__global__ void __launch_bounds__(256) k_conv(const bf16_t* __restrict__ Z, const float* __restrict__ st_conv  , const float* __restrict__ cw  ,
                                              const float* __restrict__ cb, float* __restrict__ XC) {
    const size_t idx = (size_t)blockIdx.x * 256 + threadIdx.x;
    if (idx >= (size_t)MT * 512) return;
    const int row = (int)(idx >> 9), c = (int)(idx & 511);
    float acc = cb[c];
    if (row < MP) {
#pragma unroll
        for (int j = 0; j < 4; ++j) { const int i = row - 3 + j; if (i >= 0) acc += cw[j * 512 + c] * bf2f(Z[(size_t)i * NIN + ZC_UA + c]); }
    } else {
        const int b = (row - MP) >> 3, t = (row - MP) & 7;
#pragma unroll
        for (int j = 0; j < 4; ++j) { const int i = t - 3 + j;
            const float u = i >= 0 ? bf2f(Z[(size_t)(MP + b * 8 + i) * NIN + ZC_UA + c]) : st_conv[((size_t)b * 3 + (3 + i)) * 512 + c];
            acc += cw[j * 512 + c] * u; }
    }
    XC[idx] = acc;
}
__global__ void __launch_bounds__(256) k_gates(const float* __restrict__ XC, const float* __restrict__ wr, const float* __restrict__ br, const float* __restrict__ wi,
                                               const float* __restrict__ bi, const float* __restrict__ lam, float* __restrict__ LA, float* __restrict__ LB) {
    const size_t idx = (size_t)blockIdx.x * 256 + threadIdx.x;
    if (idx >= (size_t)MT * 512) return;
    const int row = (int)(idx >> 9), c = (int)(idx & 511), n = c >> 6, e = c & 63;
    float rp = br[c], ip = bi[c];
    const float* x = XC + (size_t)row * 512 + n * 64;
    for (int d = 0; d < 64; ++d) { const float xv = x[d]; rp += xv * wr[((size_t)n * 64 + d) * 64 + e]; ip += xv * wi[((size_t)n * 64 + d) * 64 + e]; }
    const float r = sigmoidf_(rp), ig = sigmoidf_(ip);
    const float log_a = -8.f * r * log1pf(expf(-lam[c]));
    const float a = expf(log_a);
    const float mult = (row == 0) ? 1.f : sqrtf(-expm1f(2.f * log_a));
    LA[idx] = a; LB[idx] = mult * ig * XC[idx];
}
__global__ void __launch_bounds__(256) k_lru_scan(const float* __restrict__ LA, const float* __restrict__ LB, const float* __restrict__ st_lru  ,
                                                  const bf16_t* __restrict__ Z, bf16_t* __restrict__ Y, float* __restrict__ out, int layer) {
    const int idx = blockIdx.x * 256 + threadIdx.x;
    if (idx >= 33 * 512) return;
    const int seq = idx >> 9, c = idx & 511;
    float h; int row0, T;
    if (seq == 0) { h = 0.f; row0 = 0; T = MP; } else { h = st_lru[(size_t)(seq - 1) * 512 + c]; row0 = MP + (seq - 1) * 8; T = 8; }
    for (int t = 0; t < T; ++t) { const size_t i = (size_t)(row0 + t) * 512 + c; h = LA[i] * h + LB[i]; Y[(size_t)(row0 + t) * YK + c] = f2bf(h); }
    if (seq == 0) {
        out[O_LRUP + (size_t)layer * 512 + c] = h;
        for (int j = 0; j < 3; ++j) out[O_CONVP + ((size_t)layer * 3 + j) * 512 + c] = bf2f(Z[(size_t)(MP - 3 + j) * NIN + ZC_UA + c]);
    } else {
        const int b = seq - 1;
        out[O_LRUS + ((size_t)layer * 32 + b) * 512 + c] = h;
        for (int j = 0; j < 3; ++j) out[O_CONVS + (((size_t)layer * 32 + b) * 3 + j) * 512 + c] = bf2f(Z[(size_t)(MP + b * 8 + 5 + j) * NIN + ZC_UA + c]);
    }
}

__global__ void __launch_bounds__(256) k_hgrn_seq(const bf16_t* __restrict__ Z, const float* __restrict__ st_hg  , const float* __restrict__ lbraw  ,
                                                  float* __restrict__ HRAW, float* __restrict__ out, int layer) {
    const int w = blockIdx.x * 4 + (threadIdx.x >> 6), lane = threadIdx.x & 63;
    if (w >= 33 * 512) return;
    const int seq = w >> 9, h = (w >> 7) & 3, dv = w & 127;
    float lb0 = 0.f, lb1 = 0.f;
    if (layer == 1) { lb0 = sigmoidf_(lbraw[512 + h * 128 + lane] - lbraw[h * 128 + lane]); lb1 = sigmoidf_(lbraw[512 + h * 128 + lane + 64] - lbraw[h * 128 + lane + 64]); }
    float S0 = 0.f, S1 = 0.f; int row0 = 0, T = MP;
    if (seq > 0) { const int b = seq - 1; row0 = MP + b * 8; T = 8;
        S0 = st_hg[(((size_t)b * 4 + h) * 128 + lane) * 128 + dv]; S1 = st_hg[(((size_t)b * 4 + h) * 128 + lane + 64) * 128 + dv]; }
    for (int t = 0; t < T; ++t) {
        const bf16_t* z = Z + (size_t)(row0 + t) * NIN;
        const float q0 = bf2f(z[ZC_QB + h * 128 + lane]), q1 = bf2f(z[ZC_QB + h * 128 + lane + 64]);
        const float s0 = sigmoidf_(bf2f(z[ZC_FB + h * 128 + lane])), s1 = sigmoidf_(bf2f(z[ZC_FB + h * 128 + lane + 64]));
        const float v = bf2f(z[ZC_IB + h * 128 + dv]);
        const float f0 = lb0 + (1.f - lb0) * s0, f1 = lb1 + (1.f - lb1) * s1;
        const float k0 = (1.f - lb0) * (1.f - s0), k1 = (1.f - lb1) * (1.f - s1);
        S0 = f0 * S0 + k0 * v; S1 = f1 * S1 + k1 * v;
        const float o = wave_sum(S0 * q0 + S1 * q1);
        if (lane == 0) HRAW[(size_t)(row0 + t) * 512 + h * 128 + dv] = o;
    }
    if (seq == 0) { out[O_HGP + (((size_t)layer * 4 + h) * 128 + lane) * 128 + dv] = S0; out[O_HGP + (((size_t)layer * 4 + h) * 128 + lane + 64) * 128 + dv] = S1; }
    else { const int b = seq - 1;
        out[O_HGS + ((((size_t)layer * 32 + b) * 4 + h) * 128 + lane) * 128 + dv] = S0; out[O_HGS + ((((size_t)layer * 32 + b) * 4 + h) * 128 + lane + 64) * 128 + dv] = S1; }
}
__global__ void __launch_bounds__(256) k_hgrn_post(const float* __restrict__ HRAW, const bf16_t* __restrict__ Z, const float* __restrict__ ng  , bf16_t* __restrict__ Y) {
    const int w = blockIdx.x * 4 + (threadIdx.x >> 6), lane = threadIdx.x & 63;
    if (w >= MT * 4) return;
    const int row = w >> 2, h = w & 3;
    const float o0 = HRAW[(size_t)row * 512 + h * 128 + lane], o1 = HRAW[(size_t)row * 512 + h * 128 + lane + 64];
    const float s = wave_sum(o0 * o0 + o1 * o1);
    const float rinv = rsqrtf(s * (1.f / 128.f) + 1e-6f);
    Y[(size_t)row * YK + 512 + h * 128 + lane] = f2bf(o0 * rinv * ng[lane] * bf2f(Z[(size_t)row * NIN + ZC_GB + h * 128 + lane]));
    Y[(size_t)row * YK + 512 + h * 128 + lane + 64] = f2bf(o1 * rinv * ng[lane + 64] * bf2f(Z[(size_t)row * NIN + ZC_GB + h * 128 + lane + 64]));
}

DEV float dot_row_bf(const float (&q)[64], const bf16_t* __restrict__ p) {
    float s = 0.f;
#pragma unroll
    for (int d8 = 0; d8 < 8; ++d8) { const uint4 u = *(const uint4*)(p + d8 * 8); const unsigned w[4] = {u.x, u.y, u.z, u.w};
#pragma unroll
        for (int i = 0; i < 4; ++i) { s += q[d8 * 8 + 2 * i] * __uint_as_float(w[i] << 16); s += q[d8 * 8 + 2 * i + 1] * __uint_as_float(w[i] & 0xffff0000u); } }
    return s;
}
DEV float dot_row_f(const float (&q)[64], const float* __restrict__ p) {
    float s = 0.f;
#pragma unroll
    for (int d4 = 0; d4 < 16; ++d4) { const float4 u = *(const float4*)(p + d4 * 4); s += q[d4 * 4] * u.x + q[d4 * 4 + 1] * u.y + q[d4 * 4 + 2] * u.z + q[d4 * 4 + 3] * u.w; }
    return s;
}
__global__ void __launch_bounds__(256) k_attn(const bf16_t* __restrict__ Z, const float* __restrict__ c128, const float* __restrict__ c512, const float* __restrict__ c2048  ,
                                              bf16_t* __restrict__ Y) {
    const int w = blockIdx.x * 4 + (threadIdx.x >> 6), lane = threadIdx.x & 63;
    if (w >= MT * 4) return;
    const int row = w >> 2, hh = w & 3;
    const bool prompt = row < MP;
    const int b = prompt ? 0 : (row - MP) >> 3, t = prompt ? row : (row - MP) & 7;
    float og[3], lse[3];
#pragma unroll
    for (int g = 0; g < 3; ++g) {
        const int dil = g == 0 ? 1 : (g == 1 ? 4 : 16), Wc = 128 * dil, hd = g * 4 + hh;
        const float* cache = g == 0 ? c128 : (g == 1 ? c512 : c2048);
        float q[64];
        { const bf16_t* qp = Z + (size_t)row * NIN + ZC_QC + hd * 64;
#pragma unroll
          for (int d8 = 0; d8 < 8; ++d8) { const uint4 u = *(const uint4*)(qp + d8 * 8); const unsigned ww[4] = {u.x, u.y, u.z, u.w};
#pragma unroll
              for (int i = 0; i < 4; ++i) { q[d8 * 8 + 2 * i] = __uint_as_float(ww[i] << 16); q[d8 * 8 + 2 * i + 1] = __uint_as_float(ww[i] & 0xffff0000u); } } }
        float s[3]; bool val[3];
#pragma unroll
        for (int sl = 0; sl < 3; ++sl) {
            const int j = lane + 64 * sl;
            s[sl] = -1e30f; val[sl] = false;
            if (j <= 128) {
                if (prompt) { const int tk = t - dil * j; if (tk >= 0) { val[sl] = true; s[sl] = dot_row_bf(q, Z + (size_t)tk * NIN + ZC_KC + hd * 64); } }
                else { const int idx = dil * (128 - j) + t; val[sl] = true;
                    if (idx < Wc) s[sl] = dot_row_f(q, cache + ((size_t)b * Wc + idx) * 512 + hh * 64);
                    else s[sl] = dot_row_bf(q, Z + (size_t)(MP + b * 8 + idx - Wc) * NIN + ZC_KC + hd * 64); }
            }
        }
        const float m = wave_max(fmaxf(s[0], fmaxf(s[1], s[2])));
        float p[3];
#pragma unroll
        for (int sl = 0; sl < 3; ++sl) p[sl] = val[sl] ? expf(s[sl] - m) : 0.f;
        const float l = wave_sum(p[0] + p[1] + p[2]);
        float acc = 0.f;
        for (int j = 0; j <= 128; ++j) {
            const float pj = __shfl(j < 64 ? p[0] : (j < 128 ? p[1] : p[2]), j & 63);
            float v = 0.f;
            if (prompt) { const int tk = t - dil * j; if (tk >= 0) v = bf2f(Z[(size_t)tk * NIN + ZC_VC + hd * 64 + lane]); }
            else { const int idx = dil * (128 - j) + t;
                if (idx < Wc) v = cache[((size_t)b * Wc + idx) * 512 + 256 + hh * 64 + lane];
                else v = bf2f(Z[(size_t)(MP + b * 8 + idx - Wc) * NIN + ZC_VC + hd * 64 + lane]); }
            acc += pj * v;
        }
        og[g] = acc / l; lse[g] = m + logf(l);
    }
    const float mx = fmaxf(lse[0], fmaxf(lse[1], lse[2]));
    const float w0 = expf(lse[0] - mx), w1 = expf(lse[1] - mx), w2 = expf(lse[2] - mx);
    Y[(size_t)row * YK + 1024 + hh * 64 + lane] = f2bf((w0 * og[0] + w1 * og[1] + w2 * og[2]) / (w0 + w1 + w2));
}

__global__ void __launch_bounds__(256) k_cache(const bf16_t* __restrict__ Z, const float* __restrict__ cin  , float* __restrict__ outs  ,
                                               float* __restrict__ outp  , int Wc, int g, int bulk) {
    const size_t n4s = (size_t)32 * Wc * 128, n4p = (size_t)Wc * 128;
    for (size_t i = (size_t)blockIdx.x * 256 + threadIdx.x; i < n4s + n4p; i += (size_t)gridDim.x * 256) {
        if (i < n4s) {
            const int e4 = (int)(i & 127); const size_t r = i >> 7; const int b = (int)(r / Wc), ri = (int)(r % Wc);
            float4 v;
            if (ri + 8 < Wc) { if (!bulk) continue; v = *(const float4*)(cin + ((size_t)b * Wc + ri + 8) * 512 + e4 * 4); }
            else { const int tt = ri + 8 - Wc, e = e4 * 4, kv = e >> 8, hh = (e >> 6) & 3, d = e & 63;
                const bf16_t* z = Z + (size_t)(MP + b * 8 + tt) * NIN + (kv ? ZC_VC : ZC_KC) + (g * 4 + hh) * 64 + d;
                v = make_float4(bf2f(z[0]), bf2f(z[1]), bf2f(z[2]), bf2f(z[3])); }
            *(float4*)(outs + r * 512 + e4 * 4) = v;
        } else {
            const size_t ip = i - n4s; const int e4 = (int)(ip & 127), ri = (int)(ip >> 7), e = e4 * 4, kv = e >> 8, hh = (e >> 6) & 3, d = e & 63;
            const bf16_t* z = Z + (size_t)(MP - Wc + ri) * NIN + (kv ? ZC_VC : ZC_KC) + (g * 4 + hh) * 64 + d;
            *(float4*)(outp + (size_t)ri * 512 + e4 * 4) = make_float4(bf2f(z[0]), bf2f(z[1]), bf2f(z[2]), bf2f(z[3]));
        }
    }
}

extern "C" void kernel_launch(void* const* d_in, const int* in_sizes, int n_in, void* d_out, int out_size, void* d_ws, size_t ws_size, hipStream_t stream) {
    const float* const* in = (const float* const*)d_in;
    float* out = (float*)d_out; unsigned char* ws = (unsigned char*)d_ws;
    bf16_t* XN = (bf16_t*)(ws + WS_XN); bf16_t* Z = (bf16_t*)(ws + WS_Z); bf16_t* Y = (bf16_t*)(ws + WS_Y); bf16_t* MIX = (bf16_t*)(ws + WS_MIX);
    bf16_t* OB = (bf16_t*)(ws + WS_OB); float* X1 = (float*)(ws + WS_X1); float* X2 = (float*)(ws + WS_X2); bf16_t* HID = (bf16_t*)(ws + WS_HID);
    float* XC = (float*)(ws + WS_XC); float* LA = (float*)(ws + WS_LA); float* LBb = (float*)(ws + WS_LB); float* HRAW = (float*)(ws + WS_HRAW);
    static int grid = 0;
    if (grid == 0) {
        int dev = 0, cus = 0, per_cu = 0;
        hipGetDevice(&dev); hipDeviceGetAttribute(&cus, hipDeviceAttributeMultiprocessorCount, dev);
        hipFuncSetAttribute((const void*)mega, hipFuncAttributeMaxDynamicSharedMemorySize, LDS_BYTES);
        hipOccupancyMaxActiveBlocksPerMultiprocessor(&per_cu, (const void*)mega, NWAVES * 64, LDS_BYTES);
        if (per_cu < 1) per_cu = 1;
        grid = cus * 1;
        (void)hipGetLastError();
    }
    Args a{};
    for (int i = 0; i < 29; ++i) a.in[i] = (const float*)d_in[i];
    a.out = out; a.ws = ws;
    auto run = [&](int lo, int hi) { a.ph_lo = lo; a.ph_hi = hi; hipLaunchKernelGGL(mega, dim3(grid), dim3(NWAVES * 64), LDS_BYTES, stream, a); };
    for (int l = 0; l < 2; ++l) {
        unsigned char* wl = ws + WS_W + l * WS_WL;
    }
    run(PH_PRO, PH_PRO + 1);
    const int Wcs[3] = {128, 512, 2048};
    const size_t ocs[3] = {O_W128S, O_W512S, O_W2048S}, ocp[3] = {O_W128P, O_W512P, O_W2048P};
    for (int l = 0; l < 2; ++l) {
        unsigned char* wl = ws + WS_W + l * WS_WL;
        run(PH_LAYER0 + l * PH_PER_LAYER + P_G1, PH_LAYER0 + l * PH_PER_LAYER + P_G1 + 1);
        for (int g = 0; g < 3; ++g) {
            const int Wc = Wcs[g];
        }
        run(PH_LAYER0 + l * PH_PER_LAYER + P_MIX1, PH_LAYER0 + l * PH_PER_LAYER + P_MIX1 + 1);
        run(PH_LAYER0 + l * PH_PER_LAYER + P_MIX2, PH_LAYER0 + l * PH_PER_LAYER + P_MIX2 + 1);
        run(PH_LAYER0 + l * PH_PER_LAYER + P_MIX3, PH_LAYER0 + l * PH_PER_LAYER + P_MIX3 + 1);
        run(PH_LAYER0 + l * PH_PER_LAYER + P_G2, PH_LAYER0 + l * PH_PER_LAYER + P_G2 + 1);
        run(PH_LAYER0 + l * PH_PER_LAYER + P_G3, PH_LAYER0 + l * PH_PER_LAYER + P_G3 + 1);
        const float* xp = l == 0 ? in[0] : X2; const float* xs = l == 0 ? in[1] : X2 + (size_t)MP * DM;
        run(PH_LAYER0 + l * PH_PER_LAYER + P_E1, PH_LAYER0 + l * PH_PER_LAYER + P_E1 + 1);
        run(PH_LAYER0 + l * PH_PER_LAYER + P_G4, PH_LAYER0 + l * PH_PER_LAYER + P_G4 + 1);
        run(PH_LAYER0 + l * PH_PER_LAYER + P_G5, PH_LAYER0 + l * PH_PER_LAYER + P_G5 + 1);
        float* xo = l == 0 ? X2 : out;
        run(PH_LAYER0 + l * PH_PER_LAYER + P_E2, PH_LAYER0 + l * PH_PER_LAYER + P_E2 + 1);
    }
}
```

```cpp
#include <hip/hip_runtime.h>
#include <stdint.h>

typedef unsigned short bf16_t;
#define DEV __device__ __forceinline__

DEV float bf2f(bf16_t b) { return __uint_as_float(((unsigned)b) << 16); }
typedef float f32x2c __attribute__((ext_vector_type(2)));
typedef __bf16 bf16x2c __attribute__((ext_vector_type(2)));
DEV unsigned cvt_pk_bf16_hw(float lo, float hi) { const f32x2c v = {lo, hi}; return __builtin_bit_cast(unsigned, __builtin_convertvector(v, bf16x2c)); }
DEV bf16_t f2bf(float f) { return (bf16_t)(cvt_pk_bf16_hw(f, 0.f) & 0xffffu); }
DEV float sigmoidf_(float x) { return 1.f / (1.f + expf(-x)); }
DEV float dpp_f(float v, const int ctrl_sel) {
    int r;
    if (ctrl_sel == 0) r = __builtin_amdgcn_update_dpp(0, __float_as_int(v), 0xB1, 0xf, 0xf, true);
    else if (ctrl_sel == 1) r = __builtin_amdgcn_update_dpp(0, __float_as_int(v), 0x4E, 0xf, 0xf, true);
    else if (ctrl_sel == 2) r = __builtin_amdgcn_update_dpp(0, __float_as_int(v), 0x141, 0xf, 0xf, true);
    else r = __builtin_amdgcn_update_dpp(0, __float_as_int(v), 0x140, 0xf, 0xf, true);
    return __int_as_float(r);
}
DEV float row16_sum(float v) { v += dpp_f(v, 0); v += dpp_f(v, 1); v += dpp_f(v, 2); v += dpp_f(v, 3); return v; }
DEV float row16_max(float v) { v = fmaxf(v, dpp_f(v, 0)); v = fmaxf(v, dpp_f(v, 1)); v = fmaxf(v, dpp_f(v, 2)); v = fmaxf(v, dpp_f(v, 3)); return v; }
DEV float wave_sum(float v) { v = row16_sum(v); v += __shfl_xor(v, 16); v += __shfl_xor(v, 32); return v; }
DEV float wave_max(float v) { v = row16_max(v); v = fmaxf(v, __shfl_xor(v, 16)); v = fmaxf(v, __shfl_xor(v, 32)); return v; }

constexpr int MP = 16384, MS = 256, MT = MP + MS;
constexpr int DM = 1024, NIN = 7936, DFF = 4096, YK = 1280;
constexpr int ZC_UA = 0, ZC_QB = 512, ZC_FB = 1024, ZC_IB = 1536, ZC_GB = 2048, ZC_QC = 2560, ZC_KC = 3328, ZC_VC = 4096, ZC_GATE = 4864;
constexpr int NB = 32, NT = 8;
constexpr size_t O_Y = 0, O_CONVP = 17039360, O_CONVS = 17042432, O_LRUP = 17140736, O_LRUS = 17141760, O_HGP = 17174528, O_HGS = 17305600,
                 O_W128P = 21499904, O_W128S = 21630976, O_W512P = 25825280, O_W512S = 26349568, O_W2048P = 43126784, O_W2048S = 45223936;
constexpr size_t MiB = 1u << 20;
constexpr size_t WS_W = 1 * MiB, WS_WL = 40 * MiB;
constexpr size_t W_IN = 0, W_BR = 16 * MiB, W_OUT = 19 * MiB, W_UP = 21 * MiB, W_DN = 29 * MiB;
constexpr size_t WS_XN = 82 * MiB, WS_Z = 116 * MiB, WS_Y = 368 * MiB, WS_MIX = 409 * MiB, WS_OB = 442 * MiB, WS_X1 = 475 * MiB, WS_X2 = 540 * MiB,
                 WS_HID = 605 * MiB, WS_XC = 735 * MiB, WS_LA = 768 * MiB, WS_LB = 801 * MiB, WS_HRAW = 834 * MiB;

#include <hip/hip_cooperative_groups.h>
namespace pg8 {
#define PG8_LAS __attribute__((address_space(3)))
typedef unsigned short bf16_t;
typedef short bf16x8 __attribute__((ext_vector_type(8)));
typedef float f32x4 __attribute__((ext_vector_type(4)));
typedef unsigned u32x4 __attribute__((ext_vector_type(4)));
constexpr int BM = 256, BK = 64, HALF = 128, HTB = HALF * BK * 2  , STAGE_BYTES = 8 * HTB, NXCD = 8, WGM = 4;

__host__ __device__ __forceinline__ int lds_byte(int r, int c) { const int st = (r >> 4) * 2 + (c >> 5), rr = r & 15, cc = c & 31, ob = rr * 64 + cc * 2; return st * 1024 + (ob ^ (((ob >> 9) & 1) << 5)); }
__host__ __device__ __forceinline__ void stage_rc(int b, int& R, int& C) { const int st = b / 1024, sb = b % 1024, swz = sb ^ (((sb >> 9) & 1) << 5); R = (st >> 1) * 16 + swz / 64; C = (st & 1) * 32 + (swz % 64) / 2; }
__host__ __device__ __forceinline__ int perm32(int rho) { const int n = rho >> 4, i = rho & 15; return 8 * (i >> 2) + 4 * n + (i & 3); }

__device__ __forceinline__ unsigned cvt_pk_bf16(float lo, float hi) { return ::cvt_pk_bf16_hw(lo, hi); }
struct Unit { int pm, pn, k0, nt, split; };
struct Gemm { const bf16_t* A; const bf16_t* Bt; int M, N, K; };

struct StaticOrder {
    int nM, nN, nwg, G, c, ntK;
    __host__ __device__ void init(int M, int N, int G_, int c_, int K_ = 0) { nM = M / BM; nN = N / BM; nwg = nM * nN; G = G_; c = c_; ntK = K_ / BK; }
    __host__ __device__ bool next(int i, Unit& u) const {
        const long L = (long)i * G + c; if (L >= nwg) return false;
        int wgid = (int)L; { const int q = nwg / NXCD, r = nwg % NXCD, xcd = wgid % NXCD, off = wgid / NXCD; wgid = (xcd < r ? xcd * (q + 1) : r * (q + 1) + (xcd - r) * q) + off; }
        const int nig = WGM * nN, gid = wgid / nig, fm = gid * WGM, gsz = (nM - fm) < WGM ? (nM - fm) : WGM;
        u.pm = fm + ((wgid % nig) % gsz); u.pn = (wgid % nig) / gsz; u.k0 = 0; u.nt = ntK; u.split = 0; return true;
    }
    __device__ __forceinline__ void a_ready(const Unit&) const {}
    __device__ __forceinline__ void done(const Unit&) const {}
};
struct Finisher { const float* part; int nks; bf16_t* dst; int ld; int act; };
struct SplitOrder {
    StaticOrder P; int npieces, npn, c; Finisher fin;
    __host__ __device__ void init(int Mp, int N, int G_, int c_, int K_, int npn_, int nsplit_) { P.init(Mp, N, G_, c_, K_); c = c_; npn = npn_; npieces = npn_ * nsplit_; fin.part = nullptr; }
    __host__ __device__ bool next(int i, Unit& u) const {
        if (c < npieces) { if (i == 0) { u.pm = P.nM; u.pn = c % npn; u.k0 = (c / npn) * 4; u.nt = 4; u.split = 1; return true; } return P.next(i - 1, u); }
        return P.next(i, u);
    }
    __device__ __forceinline__ void a_ready(const Unit& u) const {
        if (fin.part == nullptr || !u.split) return;
        int tid = threadIdx.x; asm volatile("" : "+v"(tid));
        const int colb = u.k0 * BK;
#pragma unroll 4
        for (int i = 0; i < 32; ++i) { const int idx4 = i * 512 + tid, row = idx4 >> 6, c4 = idx4 & 63;
            const float* p = fin.part + (size_t)row * fin.ld + colb + c4 * 4; f32x4 s = *(const f32x4*)p;
            for (int ks = 1; ks < fin.nks; ++ks) s = s + *(const f32x4*)(p + (size_t)ks * 256 * fin.ld);
            if (fin.act == 1) {
#pragma unroll
                for (int j = 0; j < 4; ++j) { const float a = fmaxf(s[j], 0.f); s[j] = a * a; } }
            unsigned w0 = cvt_pk_bf16(s[0], s[1]), w1 = cvt_pk_bf16(s[2], s[3]);
            unsigned long long w = (unsigned long long)w0 | ((unsigned long long)w1 << 32);
            *(unsigned long long*)(fin.dst + (size_t)row * fin.ld + colb + c4 * 4) = w; }
        asm volatile("s_waitcnt vmcnt(0)" ::: "memory");
        __syncthreads();
        __builtin_amdgcn_fence(__ATOMIC_ACQUIRE, "agent");
        asm volatile("s_waitcnt vmcnt(0)" ::: "memory");
        __syncthreads();
    }
    __device__ __forceinline__ void done(const Unit&) const {}
};
__device__ __forceinline__ float fsig(float x) { return __builtin_amdgcn_rcpf(1.f + __expf(-x)); }
__device__ __forceinline__ float bflo(unsigned w) { return __uint_as_float(w << 16); }
__device__ __forceinline__ float bfhi(unsigned w) { return __uint_as_float(w & 0xffff0000u); }
typedef unsigned u32x2 __attribute__((ext_vector_type(2)));
__device__ __forceinline__ unsigned pk_u8x4(float a, float b, float c, float d) { unsigned r = 0u; r = __builtin_amdgcn_cvt_pk_u8_f32(a * 255.f, 0, r); r = __builtin_amdgcn_cvt_pk_u8_f32(b * 255.f, 1, r); r = __builtin_amdgcn_cvt_pk_u8_f32(c * 255.f, 2, r); r = __builtin_amdgcn_cvt_pk_u8_f32(d * 255.f, 3, r); return r; }
__device__ __forceinline__ float gq(unsigned w, const int k) { return fmaxf((float)((w >> (8 * k)) & 0xffu), 0.5f); }
constexpr int ZP = 7936;
struct EpiZ {
    static constexpr bool PERM = true, AFTER_DRAIN = false, HOOK = false;
    bf16_t* Z; const float* bgate; bf16_t* GF;
    __device__ __forceinline__ void operator()(const f32x4 (&acc)[2][2][4][2], const Unit& u, int wr, int wc, int fr, int fq) const {
        const int colt = u.pn * BM;
        const int mode = colt >= 4864 ? 3 : (((colt >= 512 && colt < 1024) || (colt >= 2048 && colt < 2560)) ? 1 : ((colt >= 2560 && colt < 3328) ? 2 : 0));
        const int row0 = u.pm * BM + wr * 64 + fr, col0 = colt + wc * 32 + 8 * fq;
        f32x4 bv[2][2];
#pragma unroll
        for (int bj = 0; bj < 2; ++bj)
#pragma unroll
            for (int n = 0; n < 2; ++n) bv[bj][n] = mode == 3 ? *(const f32x4*)(bgate + (col0 - 4864) + bj * HALF + 4 * n) : (f32x4){0.f, 0.f, 0.f, 0.f};
        int row0l = row0; asm volatile("" : "+v"(row0l));
        int tidl = (wr * 4 + wc) * 64 + fq * 16 + fr; asm volatile("" : "+v"(tidl));
#pragma unroll
        for (int ai = 0; ai < 2; ++ai)
#pragma unroll
            for (int m = 0; m < 4; ++m) { bf16_t* rowp = (bf16_t*)((char*)Z + (unsigned)(((row0l + ai * HALF + m * 16) * ZP + col0) * 2));
#pragma unroll
                for (int bj = 0; bj < 2; ++bj) { f32x4 v0 = acc[ai][bj][m][0] + bv[bj][0], v1 = acc[ai][bj][m][1] + bv[bj][1];
                    if (mode == 3) {
#pragma unroll
                        for (int j = 0; j < 4; ++j) { v0[j] = fsig(v0[j]); v1[j] = fsig(v1[j]); } }
                    else if (mode == 1) {
#pragma unroll
                        for (int j = 0; j < 4; ++j) { v0[j] = v0[j] * fsig(v0[j]); v1[j] = v1[j] * fsig(v1[j]); } }
                    else if (mode == 2) { v0 = v0 * 0.125f; v1 = v1 * 0.125f; }
                    u32x4 w; w.x = cvt_pk_bf16(v0[0], v0[1]); w.y = cvt_pk_bf16(v0[2], v0[3]); w.z = cvt_pk_bf16(v1[0], v1[1]); w.w = cvt_pk_bf16(v1[2], v1[3]);
                    if (mode == 3) { u32x2 g8; g8.x = pk_u8x4(v0[0], v0[1], v0[2], v0[3]); g8.y = pk_u8x4(v1[0], v1[1], v1[2], v1[3]);
                        *(u32x2*)((char*)GF + ((size_t)(((u.pn - 19) * 65 + u.pm) * 16 + ai * 8 + m * 2 + bj) * 512 + tidl) * 8) = g8; }
                    else *(u32x4*)(rowp + bj * HALF) = w; } }
    }
};
template <int ACT  > struct EpiBf {
    static constexpr bool PERM = true, AFTER_DRAIN = false, HOOK = false;
    bf16_t* O; int ldc; float* OS;
    __device__ __forceinline__ void operator()(const f32x4 (&acc)[2][2][4][2], const Unit& u, int wr, int wc, int fr, int fq) const {
        const int row0 = u.pm * BM + wr * 64 + fr, col0 = u.pn * BM + wc * 32 + 8 * fq;
        if (u.split) {
            int r0 = wr * 64 + fr; asm volatile("" : "+v"(r0));
            float* ps = OS + (size_t)(u.k0 >> 2) * 256 * ldc;
#pragma unroll
            for (int ai = 0; ai < 2; ++ai)
#pragma unroll
                for (int m = 0; m < 4; ++m) { float* rowp = (float*)((char*)ps + (unsigned)(((r0 + ai * HALF + m * 16) * ldc + col0) * 4));
#pragma unroll
                    for (int bj = 0; bj < 2; ++bj) { *(f32x4*)(rowp + bj * HALF) = acc[ai][bj][m][0]; *(f32x4*)(rowp + bj * HALF + 4) = acc[ai][bj][m][1]; } }
            return;
        }
        int row0l = row0; asm volatile("" : "+v"(row0l));
#pragma unroll
        for (int ai = 0; ai < 2; ++ai)
#pragma unroll
            for (int m = 0; m < 4; ++m) { bf16_t* rowp = (bf16_t*)((char*)O + (unsigned)(((row0l + ai * HALF + m * 16) * ldc + col0) * 2));
#pragma unroll
                for (int bj = 0; bj < 2; ++bj) { f32x4 v0 = acc[ai][bj][m][0], v1 = acc[ai][bj][m][1];
                    if (ACT == 1) {
#pragma unroll
                        for (int j = 0; j < 4; ++j) { const float a = fmaxf(v0[j], 0.f), b = fmaxf(v1[j], 0.f); v0[j] = a * a; v1[j] = b * b; } }
                    u32x4 w; w.x = cvt_pk_bf16(v0[0], v0[1]); w.y = cvt_pk_bf16(v0[2], v0[3]); w.z = cvt_pk_bf16(v1[0], v1[1]); w.w = cvt_pk_bf16(v1[2], v1[3]);
                    *(u32x4*)(rowp + bj * HALF) = w; } }
    }
};
struct EpiMix {
    static constexpr bool PERM = true, AFTER_DRAIN = false, HOOK = true;
    const bf16_t* GF; bf16_t* O; float* PS;
    __device__ __forceinline__ void hook(f32x4 (&acc)[2][2][4][2], const Unit& u, int wr, int wc, int fr, int fq, int t) const {
        const int seg = t == 8 ? 0 : 1;
        int tidl = (wr * 4 + wc) * 64 + fq * 16 + fr; asm volatile("" : "+v"(tidl));
        const char* ga_p = (const char*)GF + ((size_t)(((seg * 4 + u.pn) * 65 + u.pm) * 16) * 512 + tidl) * 8; const char* gb_p = ga_p + (size_t)4 * 65 * 16 * 512 * 8;
#pragma unroll
        for (int ai = 0; ai < 2; ++ai)
#pragma unroll
            for (int m = 0; m < 4; ++m) {
#pragma unroll
                for (int bj = 0; bj < 2; ++bj) { const u32x2 ga = *(const u32x2*)(ga_p + (ai * 8 + m * 2 + bj) * 4096), gb = *(const u32x2*)(gb_p + (ai * 8 + m * 2 + bj) * 4096);
                    f32x4 r0, r1;
#pragma unroll
                    for (int k = 0; k < 4; ++k) { r0[k] = gq(ga.x, k) * __builtin_amdgcn_rcpf(gq(gb.x, k)); r1[k] = gq(ga.y, k) * __builtin_amdgcn_rcpf(gq(gb.y, k)); }
                    acc[ai][bj][m][0] = acc[ai][bj][m][0] * r0; acc[ai][bj][m][1] = acc[ai][bj][m][1] * r1; }
                if (m == 3) asm volatile("" ::: "memory"); }
    }
    __device__ __forceinline__ void operator()(const f32x4 (&acc)[2][2][4][2], const Unit& u, int wr, int wc, int fr, int fq) const {
        int row0 = u.pm * BM + wr * 64 + fr; const int col0 = u.pn * BM + wc * 32 + 8 * fq;
        asm volatile("" : "+v"(row0));
        int tidl = (wr * 4 + wc) * 64 + fq * 16 + fr; asm volatile("" : "+v"(tidl));
        if (u.split) {
            const int br = u.k0 >= 16 ? 2 : (u.k0 >= 8 ? 1 : 0);
            float* ps = PS + (size_t)(u.k0 >> 2) * (256 * 1024);
#pragma unroll
            for (int ai = 0; ai < 2; ++ai)
#pragma unroll
                for (int m = 0; m < 4; ++m) { const int row = row0 + ai * HALF + m * 16;
                    float* rowp = (float*)((char*)ps + (unsigned)(((row - u.pm * BM) * 1024 + col0) * 4));
#pragma unroll
                    for (int bj = 0; bj < 2; ++bj) { const u32x2 g = *(const u32x2*)((const char*)GF + ((size_t)(((br * 4 + u.pn) * 65 + u.pm) * 16 + ai * 8 + m * 2 + bj) * 512 + tidl) * 8);
                        f32x4 v0 = acc[ai][bj][m][0], v1 = acc[ai][bj][m][1];
#pragma unroll
                        for (int k = 0; k < 4; ++k) { v0[k] *= gq(g.x, k) * (1.f / 255.f); v1[k] *= gq(g.y, k) * (1.f / 255.f); }
                        *(f32x4*)(rowp + bj * HALF) = v0; *(f32x4*)(rowp + bj * HALF + 4) = v1; }
                    asm volatile("" ::: "memory"); }
            return;
        }
#pragma unroll
        for (int ai = 0; ai < 2; ++ai)
#pragma unroll
            for (int m = 0; m < 4; ++m) { const int row = row0 + ai * HALF + m * 16; bf16_t* rowp = (bf16_t*)((char*)O + (unsigned)((row * 1024 + col0) * 2));
#pragma unroll
                for (int bj = 0; bj < 2; ++bj) { const u32x2 g = *(const u32x2*)((const char*)GF + ((size_t)(((8 + u.pn) * 65 + u.pm) * 16 + ai * 8 + m * 2 + bj) * 512 + tidl) * 8);
                    f32x4 v0 = acc[ai][bj][m][0], v1 = acc[ai][bj][m][1];
#pragma unroll
                    for (int k = 0; k < 4; ++k) { v0[k] *= gq(g.x, k) * (1.f / 255.f); v1[k] *= gq(g.y, k) * (1.f / 255.f); }
                    u32x4 w; w.x = cvt_pk_bf16(v0[0], v0[1]); w.y = cvt_pk_bf16(v0[2], v0[3]); w.z = cvt_pk_bf16(v1[0], v1[1]); w.w = cvt_pk_bf16(v1[2], v1[3]);
                    *(u32x4*)(rowp + bj * HALF) = w; }
                asm volatile("" ::: "memory"); }
    }
};
template <class Epi, class Sched, bool ALIGN_EPI = false, bool SP2 = false>
__device__ __forceinline__ void gemm_phase(PG8_LAS unsigned char* lds, const Gemm g, const Sched& S, const Epi& E) {
    int tid_ = threadIdx.x; asm volatile("" : "+v"(tid_));
    const int tid = tid_, wid = __builtin_amdgcn_readfirstlane(tid >> 6), lane = tid & 63, wr = wid >> 2, wc = wid & 3, fr = lane & 15, fq = lane >> 4;
    const int K = g.K;
    unsigned voffA[2], voffB[2];
#pragma unroll
    for (int i = 0; i < 2; ++i) { int R, C; stage_rc(tid * 16 + i * 8192, R, C); const int Rb = Epi::PERM ? ((R & ~31) + perm32(R & 31)) : R;
        voffA[i] = (unsigned)(R * K + C) * 2u; voffB[i] = (unsigned)(Rb * K + C) * 2u; }
    const size_t kstep = (size_t)(BK * 2);
    const size_t hstep = (size_t)HALF * K * 2;
    const size_t tstep = 2 * hstep;
    const unsigned ldsw = (unsigned)wid * 1024u;
    const int aoff = lds_byte(wr * 64 + fr, fq * 8), boff = lds_byte(wc * 32 + fr, fq * 8);
#define PG8_SA(b, h) (((b) * 2 + (h)) * HTB)
#define PG8_SB(b, h) ((4 + (b) * 2 + (h)) * HTB)
#define PG8_STAGE(bufoff, gbase, voff) do { _Pragma("unroll") for (int _i = 0; _i < 2; ++_i) \
        __builtin_amdgcn_global_load_lds((const unsigned*)((const char*)(gbase) + (voff)[_i]), (PG8_LAS unsigned*)(lds + (bufoff) + ldsw + _i * 8192), 16, 0, 0); } while (0)
#define PG8_LDA(dst, b, h) do { _Pragma("unroll") for (int m = 0; m < 4; ++m) _Pragma("unroll") for (int k = 0; k < 2; ++k) dst[m][k] = *(const PG8_LAS bf16x8*)(lds + PG8_SA(b, h) + aoff + m * 2048 + k * 1024); } while (0)
#define PG8_LDB(dst, b, h) do { _Pragma("unroll") for (int n = 0; n < 2; ++n) _Pragma("unroll") for (int k = 0; k < 2; ++k) dst[n][k] = *(const PG8_LAS bf16x8*)(lds + PG8_SB(b, h) + boff + n * 2048 + k * 1024); } while (0)
#define PG8_MMA(ai, bj, At, Bt) do { __builtin_amdgcn_s_setprio(1); _Pragma("unroll") for (int m = 0; m < 4; ++m) _Pragma("unroll") for (int n = 0; n < 2; ++n) _Pragma("unroll") for (int k = 0; k < 2; ++k) \
        acc[ai][bj][m][n] = __builtin_amdgcn_mfma_f32_16x16x32_bf16(Bt[n][k], At[m][k], acc[ai][bj][m][n], 0, 0, 0); __builtin_amdgcn_s_setprio(0); } while (0)
#define PG8_WAIT_V(n) asm volatile("s_waitcnt vmcnt(" #n ")" ::: "memory")
#define PG8_WAIT_L(n) asm volatile("s_waitcnt lgkmcnt(" #n ")" ::: "memory")
#define PG8_BAR __builtin_amdgcn_s_barrier()
#define PG8_SCHED __builtin_amdgcn_sched_barrier(0)
    Unit cur, nxt; int ui = 0;
    if (!S.next(0, cur)) return;
    f32x4 acc[2][2][4][2];
#pragma unroll
    for (int a = 0; a < 2; ++a)
#pragma unroll
        for (int b = 0; b < 2; ++b)
#pragma unroll
            for (int m = 0; m < 4; ++m)
#pragma unroll
                for (int n = 0; n < 2; ++n) acc[a][b][m][n] = (f32x4){0.f, 0.f, 0.f, 0.f};
    bf16x8 At[4][2], B0[2][2], B1[2][2];
    const char* cA = (const char*)g.A + (size_t)cur.pm * tstep + (size_t)cur.k0 * kstep; const char* cB = (const char*)g.Bt + (size_t)cur.pn * tstep + (size_t)cur.k0 * kstep;
    S.a_ready(cur);
    if constexpr (SP2) {
        PG8_STAGE(PG8_SB(0, 0), cB, voffB); PG8_STAGE(PG8_SB(0, 1), cB + hstep, voffB); PG8_STAGE(PG8_SA(0, 0), cA, voffA); PG8_STAGE(PG8_SA(0, 1), cA + hstep, voffA);
        if (wr == 1) PG8_BAR;
        PG8_WAIT_V(2); PG8_BAR;
        PG8_STAGE(PG8_SB(1, 0), cB + kstep, voffB); PG8_STAGE(PG8_SA(1, 0), cA + kstep, voffA); PG8_STAGE(PG8_SB(1, 1), cB + hstep + kstep, voffB);
        PG8_WAIT_V(6); PG8_BAR;
    } else {
        PG8_STAGE(PG8_SB(0, 0), cB, voffB); PG8_STAGE(PG8_SA(0, 0), cA, voffA); PG8_STAGE(PG8_SB(0, 1), cB + hstep, voffB); PG8_STAGE(PG8_SA(0, 1), cA + hstep, voffA);
        if (wr == 1) PG8_BAR;
        PG8_WAIT_V(4); PG8_BAR;
        PG8_STAGE(PG8_SB(1, 0), cB + kstep, voffB); PG8_STAGE(PG8_SA(1, 0), cA + kstep, voffA); PG8_STAGE(PG8_SB(1, 1), cB + hstep + kstep, voffB);
        PG8_WAIT_V(6); PG8_BAR;
    }
    for (;;) {
        const bool has_next = S.next(ui + 1, nxt);
        const char* nA = has_next ? (const char*)g.A + (size_t)nxt.pm * tstep + (size_t)nxt.k0 * kstep : cA; const char* nB = has_next ? (const char*)g.Bt + (size_t)nxt.pn * tstep + (size_t)nxt.k0 * kstep : cB;
        const int nt = cur.nt;
        for (int t = 0; t < nt; t += 2) {
            if constexpr (Epi::HOOK) { if (t == 8 || t == 16) { PG8_SCHED; E.hook(acc, cur, wr, wc, fr, fq, t); PG8_SCHED; } }
            const bool last = (t == nt - 2);
            const char* a1 = cA + (size_t)(t + 1) * kstep;
            const char* a2 = last ? nA : cA + (size_t)(t + 2) * kstep; const char* b2 = last ? nB : cB + (size_t)(t + 2) * kstep;
            const char* a3 = a2 + kstep; const char* b3 = b2 + kstep;
            if (last && has_next) S.a_ready(nxt);
            if constexpr (SP2) {
            PG8_LDB(B0, 0, 0); PG8_LDB(B1, 0, 1); PG8_SCHED; PG8_LDA(At, 0, 0); PG8_STAGE(PG8_SA(1, 1), a1 + hstep, voffA);
            PG8_WAIT_V(8); PG8_WAIT_L(0); PG8_BAR; PG8_MMA(0, 0, At, B0); PG8_MMA(0, 1, At, B1); PG8_BAR; PG8_SCHED;
            PG8_LDA(At, 0, 1); PG8_STAGE(PG8_SB(0, 0), b2, voffB); PG8_STAGE(PG8_SB(0, 1), b2 + hstep, voffB); PG8_STAGE(PG8_SA(0, 0), a2, voffA);
            PG8_WAIT_V(8); PG8_WAIT_L(0); PG8_BAR; PG8_MMA(1, 0, At, B0); PG8_MMA(1, 1, At, B1); PG8_BAR; PG8_SCHED;
            PG8_LDB(B0, 1, 0); PG8_LDB(B1, 1, 1); PG8_SCHED; PG8_LDA(At, 1, 0); PG8_STAGE(PG8_SA(0, 1), a2 + hstep, voffA);
            PG8_WAIT_V(8); PG8_WAIT_L(0); PG8_BAR; PG8_MMA(0, 0, At, B0); PG8_MMA(0, 1, At, B1); PG8_BAR; PG8_SCHED;
            PG8_LDA(At, 1, 1); PG8_STAGE(PG8_SB(1, 0), b3, voffB); PG8_STAGE(PG8_SB(1, 1), b3 + hstep, voffB); PG8_STAGE(PG8_SA(1, 0), a3, voffA);
            PG8_WAIT_V(8); PG8_WAIT_L(0); PG8_BAR; PG8_MMA(1, 0, At, B0); PG8_MMA(1, 1, At, B1); PG8_BAR; PG8_SCHED;
            } else {
            PG8_LDB(B0, 0, 0); PG8_SCHED; PG8_LDA(At, 0, 0); PG8_STAGE(PG8_SA(1, 1), a1 + hstep, voffA);
            PG8_WAIT_L(8); PG8_BAR; PG8_WAIT_L(0); PG8_MMA(0, 0, At, B0); PG8_BAR; PG8_SCHED;
            PG8_LDB(B1, 0, 1); PG8_STAGE(PG8_SB(0, 0), b2, voffB);
            PG8_BAR; PG8_WAIT_L(0); PG8_MMA(0, 1, At, B1); PG8_BAR;
            PG8_LDA(At, 0, 1); PG8_STAGE(PG8_SA(0, 0), a2, voffA);
            PG8_BAR; PG8_WAIT_L(0); PG8_MMA(1, 0, At, B0); PG8_BAR; PG8_SCHED;
            PG8_STAGE(PG8_SB(0, 1), b2 + hstep, voffB);
            PG8_WAIT_V(6); PG8_BAR; PG8_MMA(1, 1, At, B1); PG8_BAR;
            PG8_LDB(B0, 1, 0); PG8_SCHED; PG8_LDA(At, 1, 0); PG8_STAGE(PG8_SA(0, 1), a2 + hstep, voffA);
            PG8_WAIT_L(8); PG8_BAR; PG8_WAIT_L(0); PG8_MMA(0, 0, At, B0); PG8_BAR; PG8_SCHED;
            PG8_LDB(B1, 1, 1); PG8_STAGE(PG8_SB(1, 0), b3, voffB);
            PG8_BAR; PG8_WAIT_L(0); PG8_MMA(0, 1, At, B1); PG8_BAR;
            PG8_LDA(At, 1, 1); PG8_STAGE(PG8_SA(1, 0), a3, voffA);
            PG8_BAR; PG8_WAIT_L(0); PG8_MMA(1, 0, At, B0); PG8_BAR; PG8_SCHED;
            PG8_STAGE(PG8_SB(1, 1), b3 + hstep, voffB);
            PG8_WAIT_V(6); PG8_BAR; PG8_MMA(1, 1, At, B1); PG8_BAR;
            }
        }
        if constexpr (ALIGN_EPI) { if (wr == 0) PG8_BAR; }
        if constexpr (!Epi::AFTER_DRAIN) { E(acc, cur, wr, wc, fr, fq); S.done(cur); }
        if (!has_next) break;
#pragma unroll
        for (int a = 0; a < 2; ++a)
#pragma unroll
            for (int b = 0; b < 2; ++b)
#pragma unroll
                for (int m = 0; m < 4; ++m)
#pragma unroll
                    for (int n = 0; n < 2; ++n) acc[a][b][m][n] = (f32x4){0.f, 0.f, 0.f, 0.f};
        cur = nxt; cA = nA; cB = nB; ++ui;
        if constexpr (ALIGN_EPI) { if (wr == 1) PG8_BAR; }
    }
    PG8_WAIT_V(0);
    if constexpr (!ALIGN_EPI) { if (wr == 0) PG8_BAR; }
    PG8_BAR;
    if constexpr (Epi::AFTER_DRAIN) { E.fused(acc, cur, wr, wc, fr, fq, lds, wid, lane); S.done(cur); }
#undef PG8_SA
#undef PG8_SB
#undef PG8_STAGE
#undef PG8_LDA
#undef PG8_LDB
#undef PG8_MMA
#undef PG8_WAIT_V
#undef PG8_WAIT_L
#undef PG8_BAR
#undef PG8_SCHED
}
}
#define LAS __attribute__((address_space(3)))
constexpr int NWAVES = 8;
constexpr size_t WS_LAGG = 870 * MiB;
constexpr size_t WS_LHIN = 871 * MiB;
constexpr size_t WS_LRUW = 872 * MiB;
typedef float f32x4v __attribute__((ext_vector_type(4)));
typedef unsigned u32x4v __attribute__((ext_vector_type(4)));
typedef unsigned u32x2v __attribute__((ext_vector_type(2)));
DEV unsigned pk2(float lo, float hi) { return cvt_pk_bf16_hw(lo, hi); }
DEV int tid_opaque() { int t = threadIdx.x; asm volatile("" : "+v"(t)); return t; }
DEV void lds_wait() { asm volatile("s_waitcnt lgkmcnt(0)" ::: "memory"); }

DEV void wt_item(const float* __restrict__ W, int N, bf16_t* __restrict__ WT, int P, int koff, const float* __restrict__ scale, LAS float* scr, int item, int lane) {
    const int nblk = N / 64, kb = item / nblk, nb = item % nblk, k0 = 64 * kb, n0 = 64 * nb;
    { float v[64];
#pragma unroll
      for (int i = 0; i < 64; ++i) v[i] = __builtin_nontemporal_load(W + (size_t)(k0 + i) * N + n0 + lane);
      const float sc0 = scale ? scale[k0 + lane] : 1.f;
#pragma unroll
      for (int i = 0; i < 64; ++i) scr[i * 65 + lane] = v[i] * __shfl(sc0, i); }
    lds_wait();
    const int c = lane & 7;
#pragma unroll
    for (int j = 0; j < 8; ++j) { const int n = (lane >> 3) + 8 * j; const LAS float* s = scr + (8 * c) * 65 + n;
        u32x4v o; o.x = pk2(s[0 * 65], s[1 * 65]); o.y = pk2(s[2 * 65], s[3 * 65]); o.z = pk2(s[4 * 65], s[5 * 65]); o.w = pk2(s[6 * 65], s[7 * 65]);
        *(u32x4v*)(WT + (size_t)(n0 + n) * P + koff + k0 + 8 * c) = o; }
    lds_wait();
}
DEV void xn_finish(const f32x4v (&v)[4], bf16_t* __restrict__ o, int lane) {
    float s = 0.f;
#pragma unroll
    for (int j = 0; j < 4; ++j) s += (v[j].x * v[j].x + v[j].y * v[j].y) + (v[j].z * v[j].z + v[j].w * v[j].w);
    const float rinv = rsqrtf(wave_sum(s) * (1.f / DM) + 1e-6f);
    u32x2v* o8 = (u32x2v*)o + lane;
#pragma unroll
    for (int j = 0; j < 4; ++j) { u32x2v w; w.x = pk2(v[j].x * rinv, v[j].y * rinv); w.y = pk2(v[j].z * rinv, v[j].w * rinv); o8[64 * j] = w; }
}
DEV void xn_row(const float* __restrict__ x, bf16_t* __restrict__ o, int lane) {
    const f32x4v* xr = (const f32x4v*)x + lane; f32x4v v[4]; float s = 0.f;
#pragma unroll
    for (int j = 0; j < 4; ++j) { v[j] = xr[64 * j]; s += (v[j].x * v[j].x + v[j].y * v[j].y) + (v[j].z * v[j].z + v[j].w * v[j].w); }
    const float rinv = rsqrtf(wave_sum(s) * (1.f / DM) + 1e-6f);
    u32x2v* o8 = (u32x2v*)o + lane;
#pragma unroll
    for (int j = 0; j < 4; ++j) { u32x2v w; w.x = pk2(v[j].x * rinv, v[j].y * rinv); w.y = pk2(v[j].z * rinv, v[j].w * rinv); o8[64 * j] = w; }
}
struct EltRow { u32x2v o[4]; f32x4v x[4]; };
DEV void elt_load(EltRow& r, const float* __restrict__ x, const bf16_t* __restrict__ O, int lane) {
    const u32x2v* orow = (const u32x2v*)O + lane; const f32x4v* xr = (const f32x4v*)x + lane;
#pragma unroll
    for (int j = 0; j < 4; ++j) { r.o[j] = __builtin_nontemporal_load(orow + 64 * j); r.x[j] = __builtin_nontemporal_load(xr + 64 * j); }
}
DEV void elt_load_f32(EltRow& r, f32x4v (&of)[4], const float* __restrict__ x, const float* __restrict__ O, int nks, int lane) {
    const f32x4v* orow = (const f32x4v*)O + lane; const f32x4v* xr = (const f32x4v*)x + lane;
#pragma unroll
    for (int j = 0; j < 4; ++j) { of[j] = orow[64 * j]; r.x[j] = xr[64 * j]; }
    for (int ks = 1; ks < nks; ++ks) { orow += 65536;
#pragma unroll
        for (int j = 0; j < 4; ++j) of[j] += orow[64 * j]; }
}
DEV void elt_finish(const f32x4v (&o)[4], const f32x4v (&x)[4], const f32x4v (&gv)[4], float* __restrict__ xout, bf16_t* __restrict__ xn, int lane) {
    float s = 0.f;
#pragma unroll
    for (int j = 0; j < 4; ++j) s += (o[j].x * o[j].x + o[j].y * o[j].y) + (o[j].z * o[j].z + o[j].w * o[j].w);
    const float rinv = rsqrtf(wave_sum(s) * (1.f / DM) + 1e-6f);
    f32x4v v[4]; float s2 = 0.f;
#pragma unroll
    for (int j = 0; j < 4; ++j) { v[j] = x[j] + o[j] * rinv * gv[j]; s2 += (v[j].x * v[j].x + v[j].y * v[j].y) + (v[j].z * v[j].z + v[j].w * v[j].w); }
    f32x4v* xo = (f32x4v*)xout + lane;
    if (xn == nullptr) {
#pragma unroll
        for (int j = 0; j < 4; ++j) __builtin_nontemporal_store(v[j], xo + 64 * j);
        return;
    }
    const float rinv2 = rsqrtf(wave_sum(s2) * (1.f / DM) + 1e-6f);
    u32x2v* o8 = (u32x2v*)xn + lane;
#pragma unroll
    for (int j = 0; j < 4; ++j) { __builtin_nontemporal_store(v[j], xo + 64 * j); u32x2v w; w.x = pk2(v[j].x * rinv2, v[j].y * rinv2); w.y = pk2(v[j].z * rinv2, v[j].w * rinv2); o8[64 * j] = w; }
}
constexpr size_t WS_OS3 = 933 * MiB, WS_OS5 = 937 * MiB;
constexpr size_t WS_PSM = 966 * MiB, WS_PSH = 972 * MiB;
constexpr size_t WS_GF = 735 * MiB;
constexpr size_t WS_CTL = 0;
DEV void phase_prologue(const float* const* in, float* out, unsigned char* ws, LAS unsigned char* lds, int G, int c) {
    const int tid = tid_opaque(), lane = tid & 63, wave = tid >> 6;
    if (wave < 4) {
        const int gw = c * 4 + wave, NGW = G * 4;
        LAS float* scr = (LAS float*)(lds + wave * 16896);
        constexpr int I_IN = 16 * 124, I_BA = 8 * 16, I_BC = 4 * 16, I_OUT = 16 * 16, I_UP = 16 * 64, I_DN = 64 * 16, I_L = I_IN + 2 * I_BA + I_BC + I_OUT + I_UP + I_DN;
        for (int it = gw; it < 2 * I_L; it += NGW) {
            const int l = it / I_L; int r = it % I_L; unsigned char* wl = ws + WS_W + (size_t)l * WS_WL;
            if (r < I_IN) { wt_item(in[12] + (size_t)l * DM * NIN, NIN, (bf16_t*)(wl + W_IN), DM, 0, in[8] + l * DM, scr, r, lane); continue; } r -= I_IN;
            if (r < I_BA) { wt_item(in[23] + (size_t)l * 512 * DM, DM, (bf16_t*)(wl + W_BR), YK, 0, nullptr, scr, r, lane); continue; } r -= I_BA;
            if (r < I_BA) { wt_item(in[24] + (size_t)l * 512 * DM, DM, (bf16_t*)(wl + W_BR), YK, 512, nullptr, scr, r, lane); continue; } r -= I_BA;
            if (r < I_BC) { wt_item(in[25] + (size_t)l * 256 * DM, DM, (bf16_t*)(wl + W_BR), YK, 1024, nullptr, scr, r, lane); continue; } r -= I_BC;
            if (r < I_OUT) { wt_item(in[26] + (size_t)l * DM * DM, DM, (bf16_t*)(wl + W_OUT), DM, 0, nullptr, scr, r, lane); continue; } r -= I_OUT;
            if (r < I_UP) { wt_item(in[27] + (size_t)l * DM * DFF, DFF, (bf16_t*)(wl + W_UP), DM, 0, in[10] + l * DM, scr, r, lane); continue; } r -= I_UP;
            wt_item(in[28] + (size_t)l * DFF * DM, DM, (bf16_t*)(wl + W_DN), DFF, 0, nullptr, scr, r, lane);
        }
        bf16_t* XN = (bf16_t*)(ws + WS_XN);
        for (int m = gw; m < MT; m += 2 * NGW) {
            const int m1 = m + NGW; const float* x0 = m < MP ? in[0] + (size_t)m * DM : in[1] + (size_t)(m - MP) * DM;
            const float* x1 = m1 < MP ? in[0] + (size_t)m1 * DM : in[1] + (size_t)(m1 - MP) * DM;
            f32x4v a0[4], a1[4];
#pragma unroll
            for (int j = 0; j < 4; ++j) { a0[j] = ((const f32x4v*)x0)[lane + 64 * j]; if (m1 < MT) a1[j] = ((const f32x4v*)x1)[lane + 64 * j]; }
            xn_finish(a0, XN + (size_t)m * DM, lane);
            if (m1 < MT) xn_finish(a1, XN + (size_t)m1 * DM, lane);
        }
        { bf16_t* lw = (bf16_t*)(ws + WS_LRUW);
          for (int i = c * 256 + tid; i < 2 * 2 * 8 * 4096; i += G * 256) { const int d = i & 63, e = (i >> 6) & 63, n = (i >> 12) & 7, k = (i >> 15) & 1, l = i >> 16;
              lw[i] = f2bf(in[k ? 18 : 16][((size_t)(l * 8 + n) * 64 + d) * 64 + e]); } }
    }
    unsigned* qctr = (unsigned*)(ws + WS_CTL);
    for (;;) {
        unsigned q = 0; if (lane == 0) q = __hip_atomic_fetch_add(qctr, 1u, __ATOMIC_RELAXED, __HIP_MEMORY_SCOPE_AGENT);
        q = (unsigned)__builtin_amdgcn_readfirstlane((int)q);
        if (q >= 5376u) break;
        const int g = q < 256u ? 0 : (q < 1280u ? 1 : 2); const unsigned ql = q - (g == 0 ? 0u : (g == 1 ? 256u : 1280u));
        const unsigned blk4 = g == 0 ? 16384u : (g == 1 ? 65536u : 262144u), lim4 = blk4 - 1024u;
        const f32x4v* src = (const f32x4v*)in[5 + g] + 1024 + (size_t)ql * 4096; f32x4v* dst = (f32x4v*)(out + (g == 0 ? O_W128S : (g == 1 ? O_W512S : O_W2048S))) + (size_t)ql * 4096;
        const unsigned inblk = (ql * 4096u) & (blk4 - 1u);
#pragma unroll 1
        for (int it8 = 0; it8 < 8; ++it8) { f32x4v v[8];
#pragma unroll
            for (int k = 0; k < 8; ++k) { const unsigned j = (unsigned)(it8 * 8 + k) * 64u + lane; if (inblk + j < lim4) v[k] = __builtin_nontemporal_load(src + j); }
#pragma unroll
            for (int k = 0; k < 8; ++k) { const unsigned j = (unsigned)(it8 * 8 + k) * 64u + lane; if (inblk + j < lim4) __builtin_nontemporal_store(v[k], dst + j); } }
    }
}
DEV void phase_elt(const float* xp, const float* xs, const bf16_t* O, const float* OS, int nks, const float* g, float* xout, bf16_t* XN, int G, int c) {
    const int tid = tid_opaque(), lane = tid & 63, wave = tid >> 6, gw = c * NWAVES + wave, NGW = G * NWAVES;
    f32x4v gv[4];
#pragma unroll
    for (int j = 0; j < 4; ++j) gv[j] = ((const f32x4v*)g)[lane + 64 * j];
    EltRow r0, r1;
    int m = gw;
    if (m < MP) elt_load(r0, xp + (size_t)m * DM, O + (size_t)m * DM, lane);
#pragma unroll 1
    for (; m < MP; m += 2 * NGW) {
        const int m1 = m + NGW, m2 = m + 2 * NGW;
        if (m1 < MP) elt_load(r1, xp + (size_t)m1 * DM, O + (size_t)m1 * DM, lane);
        { f32x4v o[4];
#pragma unroll
          for (int j = 0; j < 4; ++j) { o[j].x = __uint_as_float(r0.o[j].x << 16); o[j].y = __uint_as_float(r0.o[j].x & 0xffff0000u); o[j].z = __uint_as_float(r0.o[j].y << 16); o[j].w = __uint_as_float(r0.o[j].y & 0xffff0000u); }
          elt_finish(o, r0.x, gv, xout + (size_t)m * DM, XN ? XN + (size_t)m * DM : nullptr, lane); }
        if (m2 < MP) elt_load(r0, xp + (size_t)m2 * DM, O + (size_t)m2 * DM, lane);
        if (m1 < MP) { f32x4v o[4];
#pragma unroll
          for (int j = 0; j < 4; ++j) { o[j].x = __uint_as_float(r1.o[j].x << 16); o[j].y = __uint_as_float(r1.o[j].x & 0xffff0000u); o[j].z = __uint_as_float(r1.o[j].y << 16); o[j].w = __uint_as_float(r1.o[j].y & 0xffff0000u); }
          elt_finish(o, r1.x, gv, xout + (size_t)m1 * DM, XN ? XN + (size_t)m1 * DM : nullptr, lane); }
    }
    for (int ms = gw; ms < MS; ms += NGW) { const int mm = MP + ms; f32x4v o[4];
        if (OS) { elt_load_f32(r0, o, xs + (size_t)ms * DM, OS + (size_t)ms * DM, nks, lane); }
        else { elt_load(r0, xs + (size_t)ms * DM, O + (size_t)mm * DM, lane);
#pragma unroll
          for (int j = 0; j < 4; ++j) { o[j].x = __uint_as_float(r0.o[j].x << 16); o[j].y = __uint_as_float(r0.o[j].x & 0xffff0000u); o[j].z = __uint_as_float(r0.o[j].y << 16); o[j].w = __uint_as_float(r0.o[j].y & 0xffff0000u); } }
        elt_finish(o, r0.x, gv, xout + (size_t)mm * DM, XN ? XN + (size_t)mm * DM : nullptr, lane); }
}

constexpr int XC_P = 516;
typedef short bf16x8l __attribute__((ext_vector_type(8)));
template <bool FINAL>
DEV void lru_item(const float* const* in, float* out, unsigned char* ws, LAS unsigned char* lds, int l, bool sample, int idx) {
    const int tid = tid_opaque(), c = tid, w = tid >> 6, lane = tid & 63, fr = lane & 15, fq = lane >> 4;
    const bf16_t* Z = (const bf16_t*)(ws + WS_Z); bf16_t* Y = (bf16_t*)(ws + WS_Y);
    LAS float* xc = (LAS float*)lds;
    const int T = sample ? 8 : 64, NMT = sample ? 1 : 4, row0 = sample ? MP + idx * 8 : idx * 64;
    { const float* cw = in[14] + (size_t)l * 4 * 512; const float cb = in[15][l * 512 + c];
      const float w0 = cw[c], w1 = cw[512 + c], w2 = cw[1024 + c], w3 = cw[1536 + c];
      float u0, u1, u2;
      if (sample) { const float* st = in[2] + ((size_t)l * 32 + idx) * 3 * 512; u0 = st[c]; u1 = st[512 + c]; u2 = st[1024 + c]; }
      else if (idx == 0) { u0 = 0.f; u1 = 0.f; u2 = 0.f; }
      else { u0 = bf2f(Z[(size_t)(row0 - 3) * NIN + c]); u1 = bf2f(Z[(size_t)(row0 - 2) * NIN + c]); u2 = bf2f(Z[(size_t)(row0 - 1) * NIN + c]); }
      if (!sample) { bf16_t ur[64];
#pragma unroll
          for (int t = 0; t < 64; ++t) ur[t] = Z[(size_t)(row0 + t) * NIN + c];
#pragma unroll
          for (int t = 0; t < 64; ++t) { const float u3 = bf2f(ur[t]); xc[t * XC_P + c] = cb + w0 * u0 + w1 * u1 + w2 * u2 + w3 * u3; u0 = u1; u1 = u2; u2 = u3; }
      } else {
#pragma unroll
          for (int t = 0; t < 8; ++t) { const float u3 = bf2f(Z[(size_t)(row0 + t) * NIN + c]); xc[t * XC_P + c] = cb + w0 * u0 + w1 * u1 + w2 * u2 + w3 * u3; u0 = u1; u1 = u2; u2 = u3; }
      }
      if (FINAL) {
          if (sample) { float* o = out + O_CONVS + ((size_t)l * 32 + idx) * 3 * 512; o[c] = u0; o[512 + c] = u1; o[1024 + c] = u2; }
          else if (idx == 255) { float* o = out + O_CONVP + (size_t)l * 3 * 512; o[c] = u0; o[512 + c] = u1; o[1024 + c] = u2; }
      } }
    bf16x8l bw[2][4][2];
    { const bf16_t* wb = (const bf16_t*)(ws + WS_LRUW) + ((size_t)(l * 2) * 8 + w) * 4096 + fr * 64 + fq * 8;
#pragma unroll
      for (int g = 0; g < 2; ++g)
#pragma unroll
          for (int nt = 0; nt < 4; ++nt)
#pragma unroll
              for (int ks = 0; ks < 2; ++ks) bw[g][nt][ks] = *(const bf16x8l*)(wb + (size_t)g * 8 * 4096 + nt * 16 * 64 + ks * 32); }
    float br[4], bi[4], sp[4], Hc[4], Ac[4];
#pragma unroll
    for (int nt = 0; nt < 4; ++nt) { const int cc = w * 64 + nt * 16 + fr;
        br[nt] = in[17][l * 512 + cc]; bi[nt] = in[19][l * 512 + cc]; { const float xl = __expf(-in[20][l * 512 + cc]);
          sp[nt] = -8.f * (xl < 0.1f ? xl * (1.f - xl * (0.5f - xl * (0.33333334f - xl * (0.25f - xl * (0.2f - xl * 0.16666667f))))) : __logf(1.f + xl)); } Ac[nt] = 1.f;
        Hc[nt] = FINAL ? (sample ? in[3][((size_t)l * 32 + idx) * 512 + cc] : ((const float*)(ws + WS_LHIN))[(size_t)idx * 512 + cc]) : 0.f; }
    __syncthreads();
#pragma unroll 1
    for (int mt = 0; mt < NMT; ++mt) {
        bf16x8l af[2];
#pragma unroll
        for (int ks = 0; ks < 2; ++ks) { const LAS f32x4v* xp = (const LAS f32x4v*)(xc + (mt * 16 + fr) * XC_P + w * 64 + ks * 32 + fq * 8);
            const f32x4v x0 = xp[0], x1 = xp[1]; u32x4v p; p.x = pk2(x0.x, x0.y); p.y = pk2(x0.z, x0.w); p.z = pk2(x1.x, x1.y); p.w = pk2(x1.z, x1.w);
            af[ks] = __builtin_bit_cast(bf16x8l, p); }
#pragma unroll
        for (int nt = 0; nt < 4; ++nt) {
            f32x4v rp = {0.f, 0.f, 0.f, 0.f}, ip = {0.f, 0.f, 0.f, 0.f};
#pragma unroll
            for (int ks = 0; ks < 2; ++ks) { rp = __builtin_amdgcn_mfma_f32_16x16x32_bf16(af[ks], bw[0][nt][ks], rp, 0, 0, 0); ip = __builtin_amdgcn_mfma_f32_16x16x32_bf16(af[ks], bw[1][nt][ks], ip, 0, 0, 0); }
            const int cc = w * 64 + nt * 16 + fr;
            float aj[4], bj[4];
#pragma unroll
            for (int j = 0; j < 4; ++j) { const int t = mt * 16 + fq * 4 + j;
                const float x = xc[t * XC_P + cc];
                const float r = __builtin_amdgcn_rcpf(1.f + __expf(-(rp[j] + br[nt]))), ig = __builtin_amdgcn_rcpf(1.f + __expf(-(ip[j] + bi[nt])));
                const float log_a = sp[nt] * r, a = __expf(log_a), x2 = 2.f * log_a;
                const float em = x2 > -0.25f ? -x2 * (1.f + x2 * (0.5f + x2 * (0.16666667f + x2 * (0.041666668f + x2 * (0.0083333333f + x2 * 0.0013888889f))))) : 1.f - a * a;
                const float mult = (!sample && idx == 0 && t == 0) ? 1.f : __builtin_sqrtf(em);
                const bool valid = t < T;
                aj[j] = valid ? a : 1.f; bj[j] = valid ? mult * ig * x : 0.f; }
            float A4 = aj[0] * aj[1] * aj[2] * aj[3], B4 = ((bj[0] * aj[1] + bj[1]) * aj[2] + bj[2]) * aj[3] + bj[3];
            { const float A1 = __shfl(A4, (lane - 16) & 63), B1 = __shfl(B4, (lane - 16) & 63); if (fq >= 1) { B4 = B1 * A4 + B4; A4 = A1 * A4; } }
            { const float A2 = __shfl(A4, (lane - 32) & 63), B2 = __shfl(B4, (lane - 32) & 63); if (fq >= 2) { B4 = B2 * A4 + B4; A4 = A2 * A4; } }
            const float At = __shfl(A4, 48 + fr), Bt = __shfl(B4, 48 + fr);
            if (FINAL) {
                const float Ae = __shfl(A4, (lane - 16) & 63), Be = __shfl(B4, (lane - 16) & 63);
                float h = fq == 0 ? Hc[nt] : Ae * Hc[nt] + Be;
#pragma unroll
                for (int j = 0; j < 4; ++j) { const int t = mt * 16 + fq * 4 + j; h = aj[j] * h + bj[j]; if (t < T) Y[(size_t)(row0 + t) * YK + cc] = f2bf(h); }
            }
            Hc[nt] = At * Hc[nt] + Bt; Ac[nt] *= At;
        }
    }
    if (FINAL) { if (sample && fq == 0) {
#pragma unroll
        for (int nt = 0; nt < 4; ++nt) out[O_LRUS + ((size_t)l * 32 + idx) * 512 + w * 64 + nt * 16 + fr] = Hc[nt]; } }
    else if (fq == 0) { float* ag = (float*)(ws + WS_LAGG) + (size_t)idx * 1024;
#pragma unroll
        for (int nt = 0; nt < 4; ++nt) { ag[w * 64 + nt * 16 + fr] = Ac[nt]; ag[512 + w * 64 + nt * 16 + fr] = Hc[nt]; } }
    __syncthreads();
}
DEV void lru_scan(float* out, unsigned char* ws, int l) {
    const int c = tid_opaque(); const float* ag = (const float*)(ws + WS_LAGG); float* hin = (float*)(ws + WS_LHIN);
    float h = 0.f;
#pragma unroll 1
    for (int j0 = 0; j0 < 256; j0 += 32) {
        float a[32], b[32];
#pragma unroll
        for (int k = 0; k < 32; ++k) { a[k] = ag[(size_t)(j0 + k) * 1024 + c]; b[k] = ag[(size_t)(j0 + k) * 1024 + 512 + c]; }
#pragma unroll
        for (int k = 0; k < 32; ++k) { hin[(size_t)(j0 + k) * 512 + c] = h; h = a[k] * h + b[k]; }
    }
    out[O_LRUP + (size_t)l * 512 + c] = h;
}
typedef short bf16x8v __attribute__((ext_vector_type(8)));
typedef short s16x4v __attribute__((ext_vector_type(4)));
constexpr size_t WS_OG = 873 * MiB;
constexpr size_t WS_LSE = 898 * MiB;
constexpr int AK_PITCH = 144, AV_PITCH = 528, AV_OFF = 256 * AK_PITCH;

constexpr int ABUF = 72704;
DEV void attn_prompt_item(unsigned char* ws, LAS unsigned char* lds0, int it) {
    const int tid = tid_opaque(), lane = tid & 63, w = tid >> 6, fr = lane & 15, fq = lane >> 4;
    const bf16_t* Z = (const bf16_t*)(ws + WS_Z);
    const int g = it >> 8, rem = it & 255, tile = rem >> 1, hp = rem & 1;
    const int dil = g == 0 ? 1 : (g == 1 ? 4 : 16), nb = 128 / dil, r = tile / nb, n = tile % nb;
    const int key = tid >> 1, part = tid & 1; int mk = 128 * (n - 1) + key; mk = mk < 0 ? 0 : mk;
    const int tq = (128 * n + 16 * w + fr) * dil + r;
    u32x4v kk[2][4], vv[2][4]; bf16x8v bq[2][2];
#pragma unroll
    for (int h2 = 0; h2 < 2; ++h2) { const int hd = g * 4 + 2 * hp + h2;
        const bf16_t* kp = Z + (size_t)(mk * dil + r) * NIN + ZC_KC + hd * 64 + part * 32;
#pragma unroll
        for (int j = 0; j < 4; ++j) { kk[h2][j] = *(const u32x4v*)(kp + 8 * j); vv[h2][j] = *(const u32x4v*)(kp + (ZC_VC - ZC_KC) + 8 * j); }
        const bf16_t* qp = Z + (size_t)tq * NIN + ZC_QC + hd * 64 + fq * 8; bq[h2][0] = *(const bf16x8v*)qp; bq[h2][1] = *(const bf16x8v*)(qp + 32); }
#pragma unroll
    for (int h2 = 0; h2 < 2; ++h2) {
        LAS unsigned char* lds = lds0 + h2 * ABUF; const int hh = 2 * hp + h2;
#pragma unroll
        for (int j = 0; j < 4; ++j) *(LAS u32x4v*)(lds + key * AK_PITCH + part * 64 + 16 * j) = kk[h2][j];
#pragma unroll
        for (int j = 0; j < 4; ++j) { const unsigned wv[4] = {vv[h2][j].x, vv[h2][j].y, vv[h2][j].z, vv[h2][j].w};
#pragma unroll
            for (int i = 0; i < 4; ++i) { const int d = part * 32 + 8 * j + 2 * i;
                *(LAS unsigned short*)(lds + AV_OFF + d * AV_PITCH + key * 2) = (unsigned short)(wv[i] & 0xffffu);
                *(LAS unsigned short*)(lds + AV_OFF + (d + 1) * AV_PITCH + key * 2) = (unsigned short)(wv[i] >> 16); } }
        __syncthreads();
        f32x4v s[9];
#pragma unroll
        for (int kbi = 0; kbi < 9; ++kbi) { const int kb = w + kbi; f32x4v a = {0.f, 0.f, 0.f, 0.f};
#pragma unroll
            for (int ks = 0; ks < 2; ++ks) { const bf16x8v ka = *(const LAS bf16x8v*)(lds + (kb * 16 + fr) * AK_PITCH + ks * 64 + fq * 16);
                a = __builtin_amdgcn_mfma_f32_16x16x32_bf16(ka, bq[h2][ks], a, 0, 0, 0); }
            s[kbi] = a; }
        float mx = -1e30f;
#pragma unroll
        for (int kbi = 0; kbi < 9; ++kbi)
#pragma unroll
            for (int j = 0; j < 4; ++j) { bool ok = !(n == 0 && w + kbi < 8);
                if (kbi == 0) ok = ok && (fr <= fq * 4 + j);
                if (kbi == 8) ok = ok && (fr >= fq * 4 + j);
                s[kbi][j] = ok ? s[kbi][j] : -1e30f; mx = fmaxf(mx, s[kbi][j]); }
        mx = fmaxf(mx, __shfl_xor(mx, 16)); mx = fmaxf(mx, __shfl_xor(mx, 32));
        float lsum = 0.f;
#pragma unroll
        for (int kbi = 0; kbi < 9; ++kbi)
#pragma unroll
            for (int j = 0; j < 4; ++j) { const float p = s[kbi][j] > -1e29f ? __expf(s[kbi][j] - mx) : 0.f; s[kbi][j] = p; lsum += p; }
        lsum += __shfl_xor(lsum, 16); lsum += __shfl_xor(lsum, 32);
        f32x4v o[4];
#pragma unroll
        for (int mb = 0; mb < 4; ++mb) o[mb] = (f32x4v){0.f, 0.f, 0.f, 0.f};
#pragma unroll
        for (int st = 0; st < 5; ++st) { const int kb0 = w + 2 * st, kb1 = st < 4 ? kb0 + 1 : kb0;
            bf16x8v bp; u32x4v bpw; bpw.x = pk2(s[2 * st][0], s[2 * st][1]); bpw.y = pk2(s[2 * st][2], s[2 * st][3]);
            if (st < 4) { bpw.z = pk2(s[2 * st + 1][0], s[2 * st + 1][1]); bpw.w = pk2(s[2 * st + 1][2], s[2 * st + 1][3]); } else { bpw.z = 0u; bpw.w = 0u; }
            bp = __builtin_bit_cast(bf16x8v, bpw);
#pragma unroll
            for (int mb = 0; mb < 4; ++mb) { const LAS unsigned char* vr = lds + AV_OFF + (mb * 16 + fr) * AV_PITCH + fq * 8;
                const u32x2v v0 = *(const LAS u32x2v*)(vr + kb0 * 32), v1 = *(const LAS u32x2v*)(vr + kb1 * 32);
                u32x4v av; av.x = v0.x; av.y = v0.y; av.z = v1.x; av.w = v1.y;
                o[mb] = __builtin_amdgcn_mfma_f32_16x16x32_bf16(__builtin_bit_cast(bf16x8v, av), bp, o[mb], 0, 0, 0); } }
        const float rl = 1.f / lsum;
        bf16_t* og = (bf16_t*)(ws + WS_OG) + ((size_t)g * MT + tq) * 256 + hh * 64 + fq * 4;
#pragma unroll
        for (int mb = 0; mb < 4; ++mb) { u32x2v wv; wv.x = pk2(o[mb][0] * rl, o[mb][1] * rl); wv.y = pk2(o[mb][2] * rl, o[mb][3] * rl); *(u32x2v*)(og + mb * 16) = wv; }
        if (fq == 0) ((float*)(ws + WS_LSE))[((size_t)g * MT + tq) * 4 + hh] = mx + __logf(lsum);
    }
    __syncthreads();
}

constexpr size_t WS_OGS = 989 * MiB, WS_LSES = 990 * MiB;
DEV void attn_sample_item(const float* const* in, unsigned char* ws, int l, int it, int lane) {
    const bf16_t* Z = (const bf16_t*)(ws + WS_Z);
    const int half = it & 1, i1 = it >> 1, g = i1 % 3, rs = i1 / 3, b = rs >> 3, t = rs & 7;
    const int dil = g == 0 ? 1 : (g == 1 ? 4 : 16), Wc = 128 * dil;
    const float* cache = in[5 + g] + ((size_t)l * 32 + b) * Wc * 512;
    const int hh = lane >> 4, dq = lane & 15, hd = g * 4 + hh;
    f32x4v q4;
    { const u32x2v w = *(const u32x2v*)(Z + (size_t)(MP + rs) * NIN + ZC_QC + hd * 64 + dq * 4);
      q4 = (f32x4v){__uint_as_float(w.x << 16), __uint_as_float(w.x & 0xffff0000u), __uint_as_float(w.y << 16), __uint_as_float(w.y & 0xffff0000u)}; }
    float m = -1e30f, lsum = 0.f; f32x4v acc = {0.f, 0.f, 0.f, 0.f};
    const int j0 = half ? 65 : 0, nj = half ? 64 : 65;
#pragma unroll 1
    for (int jb = 0; jb < nj; jb += 8) {
        f32x4v k4[8], v4[8];
#pragma unroll
        for (int u = 0; u < 8; ++u) { const int j = j0 + jb + u; const int jj = j < j0 + nj ? j : j0 + nj - 1; const int idx = dil * (128 - jj) + t;
            if (idx < Wc) { const float* rp = cache + (size_t)idx * 512 + hh * 64 + dq * 4; k4[u] = *(const f32x4v*)rp; v4[u] = *(const f32x4v*)(rp + 256); }
            else { const bf16_t* zp = Z + (size_t)(MP + b * 8 + idx - Wc) * NIN + hd * 64 + dq * 4; const u32x2v kw = *(const u32x2v*)(zp + ZC_KC), vw = *(const u32x2v*)(zp + ZC_VC);
                k4[u] = (f32x4v){__uint_as_float(kw.x << 16), __uint_as_float(kw.x & 0xffff0000u), __uint_as_float(kw.y << 16), __uint_as_float(kw.y & 0xffff0000u)};
                v4[u] = (f32x4v){__uint_as_float(vw.x << 16), __uint_as_float(vw.x & 0xffff0000u), __uint_as_float(vw.y << 16), __uint_as_float(vw.y & 0xffff0000u)}; } }
        float s[8]; float bm = m;
#pragma unroll
        for (int u = 0; u < 8; ++u) { float d = q4.x * k4[u].x + q4.y * k4[u].y + q4.z * k4[u].z + q4.w * k4[u].w; d = row16_sum(d);
            s[u] = (jb + u < nj) ? d : -1e30f; bm = fmaxf(bm, s[u]); }
        const float corr = __expf(m - bm); lsum *= corr; acc = acc * corr; m = bm;
#pragma unroll
        for (int u = 0; u < 8; ++u) { const float p = s[u] > -1e29f ? __expf(s[u] - bm) : 0.f; lsum += p; acc += v4[u] * p; }
    }
    const float rl = 1.f / lsum;
    { u32x2v wv; wv.x = pk2(acc.x * rl, acc.y * rl); wv.y = pk2(acc.z * rl, acc.w * rl);
      *(u32x2v*)((bf16_t*)(ws + WS_OGS) + (((size_t)half * 3 + g) * 256 + rs) * 256 + hh * 64 + dq * 4) = wv; }
    if (dq == 0) ((float*)(ws + WS_LSES))[(((size_t)half * 3 + g) * 256 + rs) * 4 + hh] = m + __logf(lsum);
}
DEV void attn_merge_sample(unsigned char* ws, int G, int c) {
    const int tid = tid_opaque(); const bf16_t* og = (const bf16_t*)(ws + WS_OGS); const float* lse = (const float*)(ws + WS_LSES); bf16_t* Y = (bf16_t*)(ws + WS_Y);
    for (int i = c * (NWAVES * 64) + tid; i < 256 * 4 * 8; i += G * NWAVES * 64) { const int d8 = i & 7, hh = (i >> 3) & 3, rs = i >> 5;
        float lv[6], mx = -1e30f;
#pragma unroll
        for (int p = 0; p < 6; ++p) { lv[p] = lse[((size_t)p * 256 + rs) * 4 + hh]; mx = fmaxf(mx, lv[p]); }
        float o[8], wsum = 0.f;
#pragma unroll
        for (int k = 0; k < 8; ++k) o[k] = 0.f;
#pragma unroll
        for (int p = 0; p < 6; ++p) { const float w = __expf(lv[p] - mx); wsum += w;
            const u32x4v a = *(const u32x4v*)(og + ((size_t)p * 256 + rs) * 256 + hh * 64 + d8 * 8); const unsigned aw[4] = {a.x, a.y, a.z, a.w};
#pragma unroll
            for (int k = 0; k < 4; ++k) { o[2 * k] += w * __uint_as_float(aw[k] << 16); o[2 * k + 1] += w * __uint_as_float(aw[k] & 0xffff0000u); } }
        const float rw = 1.f / wsum; u32x4v ov; ov.x = pk2(o[0] * rw, o[1] * rw); ov.y = pk2(o[2] * rw, o[3] * rw); ov.z = pk2(o[4] * rw, o[5] * rw); ov.w = pk2(o[6] * rw, o[7] * rw);
        *(u32x4v*)(Y + (size_t)(MP + rs) * YK + 1024 + hh * 64 + d8 * 8) = ov; }
}
DEV void attn_merge(unsigned char* ws, int G, int c, int wi_lo, int wi_hi) {
    const int tid = tid_opaque(), lane = tid & 63, wave = tid >> 6, gw = c * NWAVES + wave, NGW = G * NWAVES;
    const bf16_t* og = (const bf16_t*)(ws + WS_OG); const float* lse = (const float*)(ws + WS_LSE); bf16_t* Y = (bf16_t*)(ws + WS_Y);
    for (int wi0 = wi_lo + gw; wi0 < wi_hi; wi0 += 4 * NGW) {
        float l0[4], l1[4], l2[4]; u32x4v a[4], bb[4], cc[4];
#pragma unroll
        for (int k = 0; k < 4; ++k) { const int wi = wi0 + k * NGW; if (wi < wi_hi) { const int pr = wi * 8 + (lane >> 3), row = pr >> 2, hh = pr & 3, d8 = lane & 7;
            l0[k] = lse[(size_t)row * 4 + hh]; l1[k] = lse[((size_t)MT + row) * 4 + hh]; l2[k] = lse[((size_t)2 * MT + row) * 4 + hh];
            const size_t off = (size_t)row * 256 + hh * 64 + d8 * 8;
            a[k] = *(const u32x4v*)(og + off); bb[k] = *(const u32x4v*)(og + (size_t)MT * 256 + off); cc[k] = *(const u32x4v*)(og + (size_t)2 * MT * 256 + off); } }
#pragma unroll
        for (int k = 0; k < 4; ++k) { const int wi = wi0 + k * NGW; if (wi < wi_hi) { const int pr = wi * 8 + (lane >> 3), row = pr >> 2, hh = pr & 3, d8 = lane & 7;
            const float mx = fmaxf(l0[k], fmaxf(l1[k], l2[k])); float w0 = __expf(l0[k] - mx), w1 = __expf(l1[k] - mx), w2 = __expf(l2[k] - mx);
            const float rs = 1.f / (w0 + w1 + w2); w0 *= rs; w1 *= rs; w2 *= rs;
            const unsigned aw[4] = {a[k].x, a[k].y, a[k].z, a[k].w}, bw[4] = {bb[k].x, bb[k].y, bb[k].z, bb[k].w}, cw[4] = {cc[k].x, cc[k].y, cc[k].z, cc[k].w}; u32x4v o; unsigned ow[4];
#pragma unroll
            for (int i = 0; i < 4; ++i) ow[i] = pk2(w0 * __uint_as_float(aw[i] << 16) + w1 * __uint_as_float(bw[i] << 16) + w2 * __uint_as_float(cw[i] << 16),
                                                 w0 * __uint_as_float(aw[i] & 0xffff0000u) + w1 * __uint_as_float(bw[i] & 0xffff0000u) + w2 * __uint_as_float(cw[i] & 0xffff0000u));
            o.x = ow[0]; o.y = ow[1]; o.z = ow[2]; o.w = ow[3];
            *(u32x4v*)(Y + (size_t)row * YK + 1024 + hh * 64 + d8 * 8) = o; } }
    }
}
DEV void cache_new_rows(float* out, unsigned char* ws, int l, int G, int c) {
    const int tid = tid_opaque(); const bf16_t* Z = (const bf16_t*)(ws + WS_Z);
    const int gt = c * (NWAVES * 64) + tid, NT_ = G * NWAVES * 64;
#pragma unroll
    for (int g = 0; g < 3; ++g) { const int Wc = g == 0 ? 128 : (g == 1 ? 512 : 2048);
        const size_t o_s = g == 0 ? O_W128S : (g == 1 ? O_W512S : O_W2048S), o_p = g == 0 ? O_W128P : (g == 1 ? O_W512P : O_W2048P);
        const int n_s = 32 * 8 * 128, n_p = Wc * 128;
        for (int i = gt; i < n_s + n_p; i += NT_) { int zrow; float* dst;
            const int e4 = i & 127, e = e4 * 4, kv = e >> 8, hh = (e >> 6) & 3, d = e & 63;
            if (i < n_s) { const int rr = i >> 7, b = rr >> 3, tt = rr & 7; zrow = MP + b * 8 + tt; dst = out + o_s + (((size_t)l * 32 + b) * Wc + (Wc - 8 + tt)) * 512 + e; }
            else { const int ri = (i - n_s) >> 7; zrow = MP - Wc + ri; dst = out + o_p + ((size_t)l * Wc + ri) * 512 + e; }
            const u32x2v z = *(const u32x2v*)(Z + (size_t)zrow * NIN + (kv ? ZC_VC : ZC_KC) + (g * 4 + hh) * 64 + d);
            *(f32x4v*)dst = (f32x4v){__uint_as_float(z.x << 16), __uint_as_float(z.x & 0xffff0000u), __uint_as_float(z.y << 16), __uint_as_float(z.y & 0xffff0000u)}; } }
}
constexpr size_t WS_HU = 900 * MiB;
constexpr size_t WS_HS = 916 * MiB;
constexpr size_t WS_HD = 932 * MiB;
constexpr int HQ_P = 272, HK_P = 80;
constexpr int H_QT = 0, H_KT = 8704, H_KH = 17408, H_VT = 27648, H_DV = 37888, HB_SZ = 38400;
constexpr int H_AT = 2 * HB_SZ, H_CS = H_AT + 2560, H_RS = H_CS + 2048;
template <int MODE  >
DEV void hgrn_item(const float* const* in, float* out, unsigned char* ws, LAS unsigned char* lds, int l, int idx) {
    const int tid = tid_opaque(), lane = tid & 63, w = tid >> 6, fr = lane & 15, fq = lane >> 4;
    const int ch = tid & 127, part = tid >> 7;
    const bf16_t* Z = (const bf16_t*)(ws + WS_Z); bf16_t* Y = (bf16_t*)(ws + WS_Y);
    const int h = idx & 3, blk = idx >> 2;
    const int row_base = MODE == 2 ? MP + blk * 8 : blk * 256;
    constexpr int NCH = MODE == 2 ? 1 : 8;
    float lb = 0.f;
    if (l == 1) { const float r0 = in[21][h * 128 + ch], r1 = in[21][512 + h * 128 + ch]; lb = 1.f / (1.f + __expf(r0 - r1)); }
    const float omlb = 1.f - lb;
    f32x4v S[8];
    if (MODE == 0) {
#pragma unroll
        for (int i = 0; i < 8; ++i) S[i] = (f32x4v){0.f, 0.f, 0.f, 0.f};
    } else if (MODE == 1) { const f32x4v* sp = (const f32x4v*)(ws + WS_HS) + (size_t)idx * 4096;
#pragma unroll
        for (int i = 0; i < 8; ++i) S[i] = sp[(i * 8 + w) * 64 + lane];
    } else { const float* sp = in[4] + (((size_t)l * 32 + blk) * 4 + h) * 16384;
#pragma unroll
        for (int i = 0; i < 8; ++i)
#pragma unroll
            for (int j = 0; j < 4; ++j) S[i][j] = sp[(16 * i + 4 * fq + j) * 128 + 16 * w + fr];
    }
    float dsum = 0.f;
    const float ng = in[22][l * 128 + 16 * w + fr];
    float rq[8], rz[8], rv[8];
    auto load_raw = [&](int cidx) {
#pragma unroll
        for (int k = 0; k < 8; ++k) { const int tok = part * 8 + k;
            if (MODE == 2 && tok >= 8) { rq[k] = 0.f; rz[k] = 0.f; rv[k] = 0.f; }
            else { const bf16_t* z = Z + (size_t)(row_base + cidx * 32 + tok) * NIN + h * 128 + ch;
                rq[k] = MODE == 0 ? 0.f : bf2f(z[ZC_QB]); rz[k] = bf2f(z[ZC_FB]); rv[k] = bf2f(z[ZC_IB]); } }
    };
    float lf[8], kk[8];
    auto prep1 = [&]() {
        float run = 0.f;
#pragma unroll
        for (int k = 0; k < 8; ++k) { const bool pad = MODE == 2 && part * 8 + k >= 8;
            const float sg = __builtin_amdgcn_rcpf(1.f + __expf(-rz[k]));
            const float f = lb + omlb * sg; run += pad ? 0.f : __logf(f); lf[k] = run; kk[k] = pad ? 0.f : omlb * (1.f - sg); }
        ((LAS float*)(lds + H_CS))[part * 128 + ch] = run;
    };
    auto prep2 = [&](LAS unsigned char* hb) {
        float pre = 0.f, tot = 0.f;
#pragma unroll
        for (int p = 0; p < 4; ++p) { const float v = ((const LAS float*)(lds + H_CS))[p * 128 + ch]; tot += v; pre += p < part ? v : 0.f; }
        u32x4v kh, vt; unsigned khw[4], vtw[4];
#pragma unroll
        for (int k2 = 0; k2 < 4; ++k2) {
            float qa, ka, ha, qb, kb2, hb2;
            { const float b = pre + lf[2 * k2]; ha = kk[2 * k2] * __expf(tot - b); if (MODE != 0) { qa = rq[2 * k2] * __expf(b); ka = kk[2 * k2] * __expf(fminf(-b, 80.f)); } }
            { const float b = pre + lf[2 * k2 + 1]; hb2 = kk[2 * k2 + 1] * __expf(tot - b); if (MODE != 0) { qb = rq[2 * k2 + 1] * __expf(b); kb2 = kk[2 * k2 + 1] * __expf(fminf(-b, 80.f)); } }
            const int t0 = part * 8 + 2 * k2;
            if (MODE != 0) {
                *(LAS unsigned short*)(hb + H_QT + t0 * HQ_P + ch * 2) = f2bf(qa); *(LAS unsigned short*)(hb + H_QT + (t0 + 1) * HQ_P + ch * 2) = f2bf(qb);
                *(LAS unsigned short*)(hb + H_KT + t0 * HQ_P + ch * 2) = f2bf(ka); *(LAS unsigned short*)(hb + H_KT + (t0 + 1) * HQ_P + ch * 2) = f2bf(kb2); }
            khw[k2] = pk2(ha, hb2); vtw[k2] = pk2(rv[2 * k2], rv[2 * k2 + 1]); }
        kh.x = khw[0]; kh.y = khw[1]; kh.z = khw[2]; kh.w = khw[3]; vt.x = vtw[0]; vt.y = vtw[1]; vt.z = vtw[2]; vt.w = vtw[3];
        *(LAS u32x4v*)(hb + H_KH + ch * HK_P + part * 16) = kh; *(LAS u32x4v*)(hb + H_VT + ch * HK_P + part * 16) = vt;
        if (part == 0) { ((LAS float*)(hb + H_DV))[ch] = __expf(tot); dsum += tot; }
    };
    load_raw(0);
    prep1();
    __syncthreads();
    prep2(lds);
    if (NCH > 1) load_raw(1);
    __syncthreads();
#pragma unroll 1
    for (int cidx = 0; cidx < NCH; ++cidx) {
        LAS unsigned char* hb = lds + (cidx & 1) * HB_SZ;
        float rg[8];
        if (MODE != 0) {
#pragma unroll
            for (int mb = 0; mb < 2; ++mb)
#pragma unroll
                for (int j = 0; j < 4; ++j) { const int t = mb * 16 + fq * 4 + j;
                    rg[mb * 4 + j] = (MODE == 2 && t >= 8) ? 0.f : bf2f(Z[(size_t)(row_base + cidx * 32 + t) * NIN + ZC_GB + h * 128 + 16 * w + fr]); }
        }
        if (cidx + 1 < NCH) prep1();
        if (MODE != 0 && w < 4) {
            const int mb = w == 0 ? 0 : (w == 3 ? 0 : 1), nbk = w == 2 ? 1 : (w == 3 ? 1 : 0);
            f32x4v a = {0.f, 0.f, 0.f, 0.f};
            if (w < 3) {
#pragma unroll
                for (int ks = 0; ks < 4; ++ks) { const bf16x8v qa = *(const LAS bf16x8v*)(hb + H_QT + (mb * 16 + fr) * HQ_P + ks * 64 + fq * 16);
                    const bf16x8v kb = *(const LAS bf16x8v*)(hb + H_KT + (nbk * 16 + fr) * HQ_P + ks * 64 + fq * 16);
                    a = __builtin_amdgcn_mfma_f32_16x16x32_bf16(qa, kb, a, 0, 0, 0); }
            }
#pragma unroll
            for (int j = 0; j < 4; ++j) { const bool keep = w == 1 || (w != 3 && fr <= fq * 4 + j);
                *(LAS unsigned short*)(lds + H_AT + (mb * 16 + fq * 4 + j) * HK_P + (nbk * 16 + fr) * 2) = f2bf(keep ? a[j] : 0.f); }
        }
        __syncthreads();
        if (cidx + 1 < NCH) { prep2(lds + ((cidx + 1) & 1) * HB_SZ); if (cidx + 2 < NCH) load_raw(cidx + 2); }
        const bf16x8v vfrag = *(const LAS bf16x8v*)(hb + H_VT + (16 * w + fr) * HK_P + fq * 16);
        f32x4v o[2];
        if (MODE != 0) {
            bf16x8v sb[4];
#pragma unroll
            for (int pb = 0; pb < 4; ++pb) { u32x4v t; t.x = pk2(S[2 * pb][0], S[2 * pb][1]); t.y = pk2(S[2 * pb][2], S[2 * pb][3]); t.z = pk2(S[2 * pb + 1][0], S[2 * pb + 1][1]); t.w = pk2(S[2 * pb + 1][2], S[2 * pb + 1][3]);
                sb[pb] = __builtin_bit_cast(bf16x8v, t); }
#pragma unroll
            for (int mb = 0; mb < 2; ++mb) {
                const bf16x8v af = *(const LAS bf16x8v*)(lds + H_AT + (mb * 16 + fr) * HK_P + fq * 16);
                f32x4v a = __builtin_amdgcn_mfma_f32_16x16x32_bf16(af, vfrag, (f32x4v){0.f, 0.f, 0.f, 0.f}, 0, 0, 0);
#pragma unroll
                for (int pb = 0; pb < 4; ++pb) { const LAS unsigned char* qr = hb + H_QT + (mb * 16 + fr) * HQ_P + fq * 8;
                    const u32x2v q0 = *(const LAS u32x2v*)(qr + (2 * pb) * 32), q1 = *(const LAS u32x2v*)(qr + (2 * pb + 1) * 32);
                    u32x4v qa; qa.x = q0.x; qa.y = q0.y; qa.z = q1.x; qa.w = q1.y;
                    a = __builtin_amdgcn_mfma_f32_16x16x32_bf16(__builtin_bit_cast(bf16x8v, qa), sb[pb], a, 0, 0, 0); }
                o[mb] = a; }
        }
#pragma unroll
        for (int i = 0; i < 8; ++i) { const f32x4v dv = *(const LAS f32x4v*)(hb + H_DV + (16 * i + 4 * fq) * 4);
            const bf16x8v kf = *(const LAS bf16x8v*)(hb + H_KH + (16 * i + fr) * HK_P + fq * 16);
            S[i] = __builtin_amdgcn_mfma_f32_16x16x32_bf16(kf, vfrag, S[i] * dv, 0, 0, 0); }
        if (MODE != 0) {
#pragma unroll
            for (int mb = 0; mb < 2; ++mb)
#pragma unroll
                for (int j = 0; j < 4; ++j) { float q = o[mb][j] * o[mb][j];
                    q = row16_sum(q);
                    if (fr == 0) ((LAS float*)(lds + H_RS))[w * 32 + mb * 16 + fq * 4 + j] = q; }
        }
        __syncthreads();
        if (MODE != 0) {
#pragma unroll
            for (int mb = 0; mb < 2; ++mb)
#pragma unroll
                for (int j = 0; j < 4; ++j) { const int t = mb * 16 + fq * 4 + j; float q = 0.f;
#pragma unroll
                    for (int ww = 0; ww < 8; ++ww) q += ((const LAS float*)(lds + H_RS))[ww * 32 + t];
                    const float rinv = rsqrtf(q * (1.f / 128.f) + 1e-6f);
                    if (MODE == 2 && t >= 8) continue;
                    const size_t row = (size_t)(row_base + cidx * 32 + t);
                    Y[row * YK + 512 + h * 128 + 16 * w + fr] = f2bf(o[mb][j] * rinv * ng * rg[mb * 4 + j]); }
        }
    }
    __syncthreads();
    if (MODE == 0) { f32x4v* up = (f32x4v*)(ws + WS_HU) + (size_t)idx * 4096;
#pragma unroll
        for (int i = 0; i < 8; ++i) up[(i * 8 + w) * 64 + lane] = S[i];
        if (part == 0) ((float*)(ws + WS_HD))[(size_t)idx * 128 + ch] = __expf(dsum);
    } else if (MODE == 2) { float* sp = out + O_HGS + (((size_t)l * 32 + blk) * 4 + h) * 16384;
#pragma unroll
        for (int i = 0; i < 8; ++i)
#pragma unroll
            for (int j = 0; j < 4; ++j) sp[(16 * i + 4 * fq + j) * 128 + 16 * w + fr] = S[i][j];
    }
}
DEV void hgrn_scan(float* out, unsigned char* ws, int l, int item) {
    const int tid = tid_opaque(); const int p = item * 512 + tid;
    const int h = p >> 12, q = p & 4095, i = q >> 9, w = (q >> 6) & 7, lane = q & 63, fr = lane & 15, fq = lane >> 4;
    const f32x4v* U = (const f32x4v*)(ws + WS_HU); f32x4v* Sst = (f32x4v*)(ws + WS_HS); const float* D = (const float*)(ws + WS_HD);
    f32x4v s = {0.f, 0.f, 0.f, 0.f};
#pragma unroll 1
    for (int sc0 = 0; sc0 < 64; sc0 += 8) {
        f32x4v u[8], d[8];
#pragma unroll
        for (int k = 0; k < 8; ++k) { const size_t o4 = ((size_t)(sc0 + k) * 4 + h) * 4096 + q; u[k] = U[o4]; d[k] = *(const f32x4v*)(D + ((size_t)(sc0 + k) * 4 + h) * 128 + 16 * i + 4 * fq); }
#pragma unroll
        for (int k = 0; k < 8; ++k) { Sst[((size_t)(sc0 + k) * 4 + h) * 4096 + q] = s; s = s * d[k] + u[k]; }
    }
    float* sp = out + O_HGP + ((size_t)l * 4 + h) * 16384;
#pragma unroll
    for (int j = 0; j < 4; ++j) sp[(16 * i + 4 * fq + j) * 128 + 16 * w + fr] = s[j];
}
#define XB_TMO      128
#define XB_XCNT(j)  (256  + 64 * (j))
#define XB_XSUB(j)  (1280 + 64 * (j))
#define XB_XGEN(j)  (2304 + 64 * (j))
#define XB_TOP      3328
#define XB_TOPGEN   3392
#define XCD_BAR_WORDS 3456
#define XB_SPIN_CAP (1u << 18)

__device__ __forceinline__ unsigned xb_ld(unsigned* p)              { return __hip_atomic_load(p, __ATOMIC_RELAXED, __HIP_MEMORY_SCOPE_AGENT); }
__device__ __forceinline__ unsigned xb_add(unsigned* p, unsigned v) { return __hip_atomic_fetch_add(p, v, __ATOMIC_RELAXED, __HIP_MEMORY_SCOPE_AGENT); }
__device__ __forceinline__ unsigned xb_xcc_id() { return (unsigned)__builtin_amdgcn_s_getreg((3 << 11) | 20) & 0xFu; }
#define XB_SPIN(cond, bar) do { unsigned _sp = 0; while (cond) { __builtin_amdgcn_s_sleep(1); \
    if ((++_sp & 255u) == 0u) { if (xb_ld(&(bar)[XB_TMO])) break; if (_sp > XB_SPIN_CAP) { atomicAdd(&(bar)[XB_TMO], 1u); break; } } } } while (0)

struct XcdBarrier {
    unsigned* bar; unsigned x;
    volatile LAS unsigned* st;
};

__device__ __forceinline__ XcdBarrier xcd_barrier_post(unsigned* bar, volatile LAS unsigned* st) {
    XcdBarrier b; b.bar = bar; b.x = xb_xcc_id(); b.st = st;
    if (threadIdx.x == 0) (void)xb_add(&bar[XB_XCNT(b.x)], 1u);
    return b;
}
__device__ __forceinline__ void xcd_barrier_complete(unsigned* bar, unsigned x, unsigned& nloc, unsigned& nx) {
    const unsigned G = gridDim.x * gridDim.y * gridDim.z;
    unsigned sum, cnt, mine, sp = 0u;
    for (;;) {
        sum = 0u; cnt = 0u; mine = 0u;
#pragma unroll
        for (unsigned j = 0; j < 16; ++j) { const unsigned c = xb_ld(&bar[XB_XCNT(j)]); sum += c; cnt += (c > 0u) ? 1u : 0u; mine = (j == x) ? c : mine; }
        if (sum == G) break;
        __builtin_amdgcn_s_sleep(1);
        if ((++sp & 255u) == 0u) { if (xb_ld(&bar[XB_TMO])) break; if (sp > XB_SPIN_CAP) { atomicAdd(&bar[XB_TMO], 1u); break; } }
    }
    nloc = mine > 0u ? mine : 1u; nx = cnt > 0u ? cnt : 1u;
}

__device__ __forceinline__ void xcd_barrier(const XcdBarrier& b) {
    asm volatile("s_waitcnt vmcnt(0)" ::: "memory");
    __syncthreads();
    if (threadIdx.x == 0) {
        unsigned* bar = b.bar;
        __builtin_amdgcn_s_waitcnt(0);
        unsigned nloc = b.st[0], nx = b.st[1];
        if (nloc == 0u) { xcd_barrier_complete(bar, b.x, nloc, nx); b.st[0] = nloc; b.st[1] = nx; }
        const unsigned old = xb_add(&bar[XB_XSUB(b.x)], 1u);
        const unsigned gen = old / nloc;
        if (old + 1u == (gen + 1u) * nloc) {
            __builtin_amdgcn_fence(__ATOMIC_RELEASE, "agent");
            asm volatile("s_waitcnt vmcnt(0)" ::: "memory");
            const unsigned og = xb_add(&bar[XB_TOP], 1u);
            const unsigned tg = og / nx;
            if (og + 1u == (tg + 1u) * nx) xb_add(&bar[XB_TOPGEN], 1u);
            else XB_SPIN(xb_ld(&bar[XB_TOPGEN]) == tg, bar);
            __builtin_amdgcn_fence(__ATOMIC_ACQUIRE, "agent");
            xb_add(&bar[XB_XGEN(b.x)], 1u);
            asm volatile("s_waitcnt vmcnt(0)" ::: "memory");
        } else {
            XB_SPIN(xb_ld(&bar[XB_XGEN(b.x)]) == gen, bar);
            __builtin_amdgcn_fence(__ATOMIC_ACQUIRE, "agent");
            asm volatile("s_waitcnt vmcnt(0)" ::: "memory");
        }
    }
    __syncthreads();
}
namespace cg = cooperative_groups;
constexpr int LDS_BYTES = 147456, RING_OFF = 0;
constexpr int PH_PRO = 0, PH_LAYER0 = 1, PH_PER_LAYER = 10, PH_END = PH_LAYER0 + 2 * PH_PER_LAYER;
constexpr int P_G1 = 0, P_MIX1 = 1, P_MIX2 = 2, P_MIX3 = 3, P_G2 = 4, P_G3 = 5, P_E1 = 6, P_G4 = 7, P_G5 = 8, P_E2 = 9;
struct Args { const float* in[29]; float* out; unsigned char* ws; int ph_lo, ph_hi; };
static_assert(sizeof(Args) == 31 * 8 + 8, "Args has no padding");

__global__ void __launch_bounds__(NWAVES * 64, 2) mega(Args args) {
    extern __shared__ __attribute__((aligned(16))) unsigned char lds_raw[];
    LAS unsigned char* lds = (LAS unsigned char*)lds_raw;
    cg::grid_group grid = cg::this_grid();
    volatile LAS unsigned* bst = (volatile LAS unsigned*)(lds + LDS_BYTES - 64);
    if (threadIdx.x < 16) bst[threadIdx.x] = 0u;
    __syncthreads();
    const XcdBarrier xbar = xcd_barrier_post((unsigned*)(args.ws + WS_CTL + 4096), bst);
    const int G = gridDim.x, c = blockIdx.x;
    const int lo = args.ph_lo, hi = args.ph_hi;
#pragma unroll 1
    for (int ph = lo; ph < hi; ++ph) {
        unsigned char* ws = args.ws; asm volatile("" : "+s"(ws));
        const int l = ph >= PH_LAYER0 + PH_PER_LAYER ? 1 : 0, k = ph == PH_PRO ? -1 : ph - PH_LAYER0 - l * PH_PER_LAYER;
        bf16_t* XN = (bf16_t*)(ws + WS_XN); bf16_t* Z = (bf16_t*)(ws + WS_Z); bf16_t* Y = (bf16_t*)(ws + WS_Y); bf16_t* MIX = (bf16_t*)(ws + WS_MIX);
        bf16_t* OB = (bf16_t*)(ws + WS_OB); bf16_t* HID = (bf16_t*)(ws + WS_HID); float* X1 = (float*)(ws + WS_X1); float* X2 = (float*)(ws + WS_X2);
        unsigned char* wl = ws + WS_W + (size_t)l * WS_WL;
        if (ph == PH_PRO) {
            phase_prologue(args.in, args.out, ws, lds, G, c);
        }
        else if (k == P_G1) {
            pg8::Gemm g{XN, (const bf16_t*)(wl + W_IN), MT, NIN, DM}; pg8::StaticOrder S; S.init(MT, NIN, G, c, DM);
            pg8::EpiZ E{Z, args.in[13] + (size_t)l * 3072, (bf16_t*)(ws + WS_GF)};
            pg8::gemm_phase<pg8::EpiZ, pg8::StaticOrder, true, true>(lds + RING_OFF, g, S, E);
        } else if (k == P_MIX1) {
            { volatile LAS int* qslot = (volatile LAS int*)(lds + LDS_BYTES - 128); unsigned* qctr = (unsigned*)(ws + WS_CTL) + 64 * (1 + l);
                int it = c;
                for (;;) {
                    if (it >= 1440) break;
                    if (it < 256) lru_item<false>(args.in, args.out, ws, lds, l, false, it);
                    else if (it < 288) lru_item<true>(args.in, args.out, ws, lds, l, true, it - 256);
                    else if (it < 544) hgrn_item<0>(args.in, args.out, ws, lds, l, it - 288);
                    else if (it < 672) hgrn_item<2>(args.in, args.out, ws, lds, l, it - 544);
                    else attn_prompt_item(ws, lds, it - 672);
                    if (threadIdx.x == 0) qslot[0] = G + (int)__hip_atomic_fetch_add(qctr, 1u, __ATOMIC_RELAXED, __HIP_MEMORY_SCOPE_AGENT);
                    __syncthreads(); it = qslot[0]; __syncthreads();
                } }
        } else if (k == P_MIX2) {
            if (c < 32) hgrn_scan(args.out, ws, l, c); else if (c == 32) lru_scan(args.out, ws, l);
            else {
                const int c2 = c - 33, G2 = G - 33;
                { const int tid = tid_opaque(), lane = tid & 63, gw = c2 * NWAVES + (tid >> 6); for (int it = gw; it < 1536; it += G2 * NWAVES) attn_sample_item(args.in, ws, l, it, lane); }
                cache_new_rows(args.out, ws, l, G2, c2);
                attn_merge(ws, G2, c2, 0, MP * 4 / 8);
            }
        } else if (k == P_MIX3) {
            for (int it = c; it < 256; it += G) lru_item<true>(args.in, args.out, ws, lds, l, false, it);
            for (int it = c; it < 256; it += G) hgrn_item<1>(args.in, args.out, ws, lds, l, it);
            attn_merge_sample(ws, G, c);
        } else if (k == P_G2) {
            pg8::Gemm g{Y, (const bf16_t*)(wl + W_BR), MT, DM, YK}; pg8::SplitOrder S; S.init(MP, DM, G, c, YK, 4, 5);
            pg8::EpiMix E{(const bf16_t*)(ws + WS_GF), MIX, (float*)(ws + WS_PSM)};
            pg8::gemm_phase<pg8::EpiMix, pg8::SplitOrder, true, true>(lds + RING_OFF, g, S, E);
        } else if (k == P_G3) {
            pg8::Gemm g{MIX, (const bf16_t*)(wl + W_OUT), MT, DM, DM}; pg8::SplitOrder S; S.init(MP, DM, G, c, DM, 4, 4);
            S.fin = pg8::Finisher{(const float*)(ws + WS_PSM), 5, MIX + (size_t)MP * DM, DM, 0};
            pg8::EpiBf<0> E{OB, DM, (float*)(ws + WS_OS3)};
            pg8::gemm_phase<pg8::EpiBf<0>, pg8::SplitOrder, true, true>(lds + RING_OFF, g, S, E);
        } else if (k == P_E1) {
            phase_elt(l == 0 ? args.in[0] : X2, l == 0 ? args.in[1] : X2 + (size_t)MP * DM, OB, (const float*)(ws + WS_OS3), 4, args.in[9] + (size_t)l * DM, X1, XN, G, c);
        } else if (k == P_G4) {
            pg8::Gemm g{XN, (const bf16_t*)(wl + W_UP), MT, DFF, DM}; pg8::SplitOrder S; S.init(MP, DFF, G, c, DM, 16, 4);
            pg8::EpiBf<1> E{HID, DFF, (float*)(ws + WS_PSH)};
            pg8::gemm_phase<pg8::EpiBf<1>, pg8::SplitOrder, true, true>(lds + RING_OFF, g, S, E);
        } else if (k == P_G5) {
            pg8::Gemm g{HID, (const bf16_t*)(wl + W_DN), MT, DM, DFF}; pg8::SplitOrder S; S.init(MP, DM, G, c, DFF, 4, 16);
            S.fin = pg8::Finisher{(const float*)(ws + WS_PSH), 4, HID + (size_t)MP * DFF, DFF, 1};
            pg8::EpiBf<0> E{OB, DM, (float*)(ws + WS_OS5)};
            pg8::gemm_phase<pg8::EpiBf<0>, pg8::SplitOrder, true, true>(lds + RING_OFF, g, S, E);
        } else if (k == P_E2) {
            phase_elt(X1, X1 + (size_t)MP * DM, OB, (const float*)(ws + WS_OS5), 16, args.in[11] + (size_t)l * DM, l == 0 ? X2 : args.out, l == 0 ? XN : nullptr, G, c);
        }
        if (ph + 1 < hi) { if (lo < 0) grid.sync(); else xcd_barrier(xbar); }
    }
}
extern "C" void kernel_launch(void* const* d_in, const int* in_sizes, int n_in, void* d_out, int out_size, void* d_ws, size_t ws_size, hipStream_t stream) {
    static int grid = 0;
    if (grid == 0) {
        int dev = 0, cus = 0, per_cu = 0;
        (void)hipGetDevice(&dev); (void)hipDeviceGetAttribute(&cus, hipDeviceAttributeMultiprocessorCount, dev);
        (void)hipFuncSetAttribute((const void*)mega, hipFuncAttributeMaxDynamicSharedMemorySize, LDS_BYTES);
        (void)hipOccupancyMaxActiveBlocksPerMultiprocessor(&per_cu, (const void*)mega, NWAVES * 64, LDS_BYTES);
        if (per_cu < 1) per_cu = 1;
        grid = cus;
        (void)hipGetLastError();
    }
    Args a{};
    for (int i = 0; i < 29; ++i) a.in[i] = (const float*)d_in[i];
    a.out = (float*)d_out; a.ws = (unsigned char*)d_ws; a.ph_lo = 0; a.ph_hi = PH_END;
    (void)hipMemsetAsync((unsigned char*)d_ws + WS_CTL, 0, 65536, stream);
    void* kargs[] = {&a};
    (void)hipLaunchCooperativeKernel((const void*)mega, dim3(grid), dim3(NWAVES * 64), kargs, LDS_BYTES, stream);
}
```

```cpp
#include <hip/hip_runtime.h>
#include <stdint.h>

typedef unsigned short bf16_t;
#define DEV __device__ __forceinline__

DEV float bf2f(bf16_t b) { return __uint_as_float(((unsigned)b) << 16); }
typedef float f32x2c __attribute__((ext_vector_type(2)));
typedef __bf16 bf16x2c __attribute__((ext_vector_type(2)));
DEV unsigned cvt_pk_bf16_hw(float lo, float hi) { const f32x2c v = {lo, hi}; return __builtin_bit_cast(unsigned, __builtin_convertvector(v, bf16x2c)); }
DEV bf16_t f2bf(float f) { return (bf16_t)(cvt_pk_bf16_hw(f, 0.f) & 0xffffu); }
DEV float sigmoidf_(float x) { return 1.f / (1.f + expf(-x)); }
DEV float dpp_f(float v, const int ctrl_sel) {
    int r;
    if (ctrl_sel == 0) r = __builtin_amdgcn_update_dpp(0, __float_as_int(v), 0xB1, 0xf, 0xf, true);
    else if (ctrl_sel == 1) r = __builtin_amdgcn_update_dpp(0, __float_as_int(v), 0x4E, 0xf, 0xf, true);
    else if (ctrl_sel == 2) r = __builtin_amdgcn_update_dpp(0, __float_as_int(v), 0x141, 0xf, 0xf, true);
    else r = __builtin_amdgcn_update_dpp(0, __float_as_int(v), 0x140, 0xf, 0xf, true);
    return __int_as_float(r);
}
DEV float row16_sum(float v) { v += dpp_f(v, 0); v += dpp_f(v, 1); v += dpp_f(v, 2); v += dpp_f(v, 3); return v; }
DEV float row16_max(float v) { v = fmaxf(v, dpp_f(v, 0)); v = fmaxf(v, dpp_f(v, 1)); v = fmaxf(v, dpp_f(v, 2)); v = fmaxf(v, dpp_f(v, 3)); return v; }
DEV float wave_sum(float v) { v = row16_sum(v); v += __shfl_xor(v, 16); v += __shfl_xor(v, 32); return v; }
DEV float wave_max(float v) { v = row16_max(v); v = fmaxf(v, __shfl_xor(v, 16)); v = fmaxf(v, __shfl_xor(v, 32)); return v; }

constexpr int MP = 16384, MS = 256, MT = MP + MS;
constexpr int DM = 1024, NIN = 7936, DFF = 4096, YK = 1280;
constexpr int ZC_UA = 0, ZC_QB = 512, ZC_FB = 1024, ZC_IB = 1536, ZC_GB = 2048, ZC_QC = 2560, ZC_KC = 3328, ZC_VC = 4096, ZC_GATE = 4864;
constexpr int NB = 32, NT = 8;
constexpr size_t O_Y = 0, O_CONVP = 17039360, O_CONVS = 17042432, O_LRUP = 17140736, O_LRUS = 17141760, O_HGP = 17174528, O_HGS = 17305600,
                 O_W128P = 21499904, O_W128S = 21630976, O_W512P = 25825280, O_W512S = 26349568, O_W2048P = 43126784, O_W2048S = 45223936;
constexpr size_t MiB = 1u << 20;
constexpr size_t WS_W = 1 * MiB, WS_WL = 40 * MiB;
constexpr size_t W_IN = 0, W_BR = 16 * MiB, W_OUT = 19 * MiB, W_UP = 21 * MiB, W_DN = 29 * MiB;
constexpr size_t WS_XN = 82 * MiB, WS_Z = 116 * MiB, WS_Y = 368 * MiB, WS_MIX = 409 * MiB, WS_OB = 442 * MiB, WS_X1 = 475 * MiB, WS_X2 = 540 * MiB,
                 WS_HID = 605 * MiB, WS_XC = 735 * MiB, WS_LA = 768 * MiB, WS_LB = 801 * MiB, WS_HRAW = 834 * MiB;

#include <hip/hip_cooperative_groups.h>
namespace pg8 {
#define PG8_LAS __attribute__((address_space(3)))
typedef unsigned short bf16_t;
typedef short bf16x8 __attribute__((ext_vector_type(8)));
typedef float f32x4 __attribute__((ext_vector_type(4)));
typedef unsigned u32x4 __attribute__((ext_vector_type(4)));
constexpr int BM = 256, BK = 64, HALF = 128, HTB = HALF * BK * 2  , STAGE_BYTES = 8 * HTB, NXCD = 8, WGM = 4;

__host__ __device__ __forceinline__ int lds_byte(int r, int c) { const int st = (r >> 4) * 2 + (c >> 5), rr = r & 15, cc = c & 31, ob = rr * 64 + cc * 2; return st * 1024 + (ob ^ (((ob >> 9) & 1) << 5)); }
__host__ __device__ __forceinline__ void stage_rc(int b, int& R, int& C) { const int st = b / 1024, sb = b % 1024, swz = sb ^ (((sb >> 9) & 1) << 5); R = (st >> 1) * 16 + swz / 64; C = (st & 1) * 32 + (swz % 64) / 2; }
__host__ __device__ __forceinline__ int perm32(int rho) { const int n = rho >> 4, i = rho & 15; return 8 * (i >> 2) + 4 * n + (i & 3); }

__device__ __forceinline__ unsigned cvt_pk_bf16(float lo, float hi) { return ::cvt_pk_bf16_hw(lo, hi); }
struct Unit { int pm, pn, k0, nt, split; };
struct Gemm { const bf16_t* A; const bf16_t* Bt; int M, N, K; };

struct StaticOrder {
    int nM, nN, nwg, G, c, ntK; bool perm31 = false;
    __host__ __device__ void init(int M, int N, int G_, int c_, int K_ = 0) { nM = M / BM; nN = N / BM; nwg = nM * nN; G = G_; c = c_; ntK = K_ / BK; }
    __host__ __device__ bool next(int i, Unit& u) const {
        const long L = (long)i * G + c; if (L >= nwg) return false;
        int wgid = (int)L; { const int q = nwg / NXCD, r = nwg % NXCD, xcd = wgid % NXCD, off = wgid / NXCD; wgid = (xcd < r ? xcd * (q + 1) : r * (q + 1) + (xcd - r) * q) + off; }
        const int nig = WGM * nN, gid = wgid / nig, fm = gid * WGM, gsz = (nM - fm) < WGM ? (nM - fm) : WGM;
        u.pm = fm + ((wgid % nig) % gsz); u.pn = (wgid % nig) / gsz; u.k0 = 0; u.nt = ntK; u.split = 0;
        if (perm31) { const int p = u.pn, s = 5 * (p % 12); const unsigned long long t0 = 0x1d05349544384c0ull, t1 = 0x5da55c361bd3d0eull, t2 = 0x7b3d8f2ecull; u.pn = (int)(((p < 12 ? t0 : (p < 24 ? t1 : t2)) >> s) & 31ull); }
        return true;
    }
    __device__ __forceinline__ void a_ready(const Unit&) const {}
    __device__ __forceinline__ void done(const Unit&) const {}
};
struct Finisher { const float* part; int nks; bf16_t* dst; int ld; int act; };
struct SplitOrder {
    StaticOrder P; int npieces, npn, c; Finisher fin; unsigned* pub;
    __host__ __device__ void init(int Mp, int N, int G_, int c_, int K_, int npn_, int nsplit_) { P.init(Mp, N, G_, c_, K_); c = c_; npn = npn_; npieces = npn_ * nsplit_; fin.part = nullptr; pub = nullptr; }
    __host__ __device__ bool next(int i, Unit& u) const {
        if (c < npieces) { if (i == 0) { u.pm = P.nM; u.pn = c % npn; u.k0 = (c / npn) * 4; u.nt = 4; u.split = 1; return true; } return P.next(i - 1, u); }
        return P.next(i, u);
    }
    __device__ __forceinline__ void a_ready(const Unit& u) const {
        if (fin.part == nullptr || !u.split) return;
        int tid = threadIdx.x; asm volatile("" : "+v"(tid));
        const int colb = u.k0 * BK;
        const int nks = fin.nks;
#pragma unroll 1
        for (int i0 = 0; i0 < 32; i0 += 4) { f32x4 v[4][5];
#pragma unroll
            for (int ii = 0; ii < 4; ++ii) { const int idx4 = (i0 + ii) * 512 + tid, row = idx4 >> 6, c4 = idx4 & 63;
                const float* p = fin.part + (size_t)row * fin.ld + colb + c4 * 4;
#pragma unroll
                for (int ks = 0; ks < 5; ++ks) v[ii][ks] = *(const f32x4*)(p + (size_t)(ks < nks ? ks : nks - 1) * 256 * fin.ld); }
            __builtin_amdgcn_sched_barrier(0);
#pragma unroll
            for (int ii = 0; ii < 4; ++ii) { const int idx4 = (i0 + ii) * 512 + tid, row = idx4 >> 6, c4 = idx4 & 63;
                f32x4 s = (v[ii][0] + v[ii][1]) + (v[ii][2] + v[ii][3]);
                if (nks > 4) s = s + v[ii][4];
                if (fin.act == 1) {
#pragma unroll
                    for (int j = 0; j < 4; ++j) { const float a = fmaxf(s[j], 0.f); s[j] = a * a; } }
                unsigned w0 = cvt_pk_bf16(s[0], s[1]), w1 = cvt_pk_bf16(s[2], s[3]);
                unsigned long long w = (unsigned long long)w0 | ((unsigned long long)w1 << 32);
                *(unsigned long long*)(fin.dst + (size_t)row * fin.ld + colb + c4 * 4) = w; }
            __builtin_amdgcn_sched_barrier(0); }
        asm volatile("s_waitcnt vmcnt(0)" ::: "memory");
        __syncthreads();
        __builtin_amdgcn_fence(__ATOMIC_ACQUIRE, "agent");
        asm volatile("s_waitcnt vmcnt(0)" ::: "memory");
        __syncthreads();
    }
    __device__ __forceinline__ void done(const Unit& u) const {
        if (pub == nullptr || !u.split) return;
        asm volatile("s_waitcnt vmcnt(0)" ::: "memory");
        __builtin_amdgcn_s_barrier();
        if (threadIdx.x == 0) { __builtin_amdgcn_fence(__ATOMIC_RELEASE, "agent"); __hip_atomic_fetch_add(pub, 1u, __ATOMIC_RELAXED, __HIP_MEMORY_SCOPE_AGENT); }
    }
};
__device__ __forceinline__ float fsig(float x) { return __builtin_amdgcn_rcpf(1.f + __expf(-x)); }
__device__ __forceinline__ float bflo(unsigned w) { return __uint_as_float(w << 16); }
__device__ __forceinline__ float bfhi(unsigned w) { return __uint_as_float(w & 0xffff0000u); }
typedef unsigned u32x2 __attribute__((ext_vector_type(2)));
__device__ __forceinline__ unsigned pk_u8x4(float a, float b, float c, float d) { unsigned r = 0u; r = __builtin_amdgcn_cvt_pk_u8_f32(a * 255.f, 0, r); r = __builtin_amdgcn_cvt_pk_u8_f32(b * 255.f, 1, r); r = __builtin_amdgcn_cvt_pk_u8_f32(c * 255.f, 2, r); r = __builtin_amdgcn_cvt_pk_u8_f32(d * 255.f, 3, r); return r; }
__device__ __forceinline__ float gq(unsigned w, const int k) { return fmaxf((float)((w >> (8 * k)) & 0xffu), 0.5f); }
constexpr int ZP = 7936;
struct EpiZ {
    static constexpr bool PERM = true, AFTER_DRAIN = false, HOOK = false;
    bf16_t* Z; const float* bgate; bf16_t* GF;
    __device__ __forceinline__ void operator()(const f32x4 (&acc)[2][2][4][2], const Unit& u, int wr, int wc, int fr, int fq) const {
        const int colt = u.pn * BM;
        const int mode = colt >= 4864 ? 3 : (((colt >= 512 && colt < 1024) || (colt >= 2048 && colt < 2560)) ? 1 : ((colt >= 2560 && colt < 3328) ? 2 : 0));
        const int row0 = u.pm * BM + wr * 64 + fr, col0 = colt + wc * 32 + 8 * fq;
        f32x4 bv[2][2];
#pragma unroll
        for (int bj = 0; bj < 2; ++bj)
#pragma unroll
            for (int n = 0; n < 2; ++n) bv[bj][n] = mode == 3 ? *(const f32x4*)(bgate + (col0 - 4864) + bj * HALF + 4 * n) : (f32x4){0.f, 0.f, 0.f, 0.f};
        int row0l = row0; asm volatile("" : "+v"(row0l));
        int tidl = (wr * 4 + wc) * 64 + fq * 16 + fr; asm volatile("" : "+v"(tidl));
#pragma unroll
        for (int ai = 0; ai < 2; ++ai)
#pragma unroll
            for (int m = 0; m < 4; ++m) { bf16_t* rowp = (bf16_t*)((char*)Z + (unsigned)(((row0l + ai * HALF + m * 16) * ZP + col0) * 2));
#pragma unroll
                for (int bj = 0; bj < 2; ++bj) { f32x4 v0 = acc[ai][bj][m][0] + bv[bj][0], v1 = acc[ai][bj][m][1] + bv[bj][1];
                    if (mode == 3) {
#pragma unroll
                        for (int j = 0; j < 4; ++j) { v0[j] = fsig(v0[j]); v1[j] = fsig(v1[j]); } }
                    else if (mode == 1) {
#pragma unroll
                        for (int j = 0; j < 4; ++j) { v0[j] = v0[j] * fsig(v0[j]); v1[j] = v1[j] * fsig(v1[j]); } }
                    else if (mode == 2) { v0 = v0 * 0.125f; v1 = v1 * 0.125f; }
                    u32x4 w; w.x = cvt_pk_bf16(v0[0], v0[1]); w.y = cvt_pk_bf16(v0[2], v0[3]); w.z = cvt_pk_bf16(v1[0], v1[1]); w.w = cvt_pk_bf16(v1[2], v1[3]);
                    if (mode == 3) { u32x2 g8; g8.x = pk_u8x4(v0[0], v0[1], v0[2], v0[3]); g8.y = pk_u8x4(v1[0], v1[1], v1[2], v1[3]);
                        *(u32x2*)((char*)GF + ((size_t)(((u.pn - 19) * 65 + u.pm) * 16 + ai * 8 + m * 2 + bj) * 512 + tidl) * 8) = g8; }
                    else *(u32x4*)(rowp + bj * HALF) = w; } }
    }
};
template <int ACT  > struct EpiBf {
    static constexpr bool PERM = true, AFTER_DRAIN = false, HOOK = false;
    bf16_t* O; int ldc; float* OS;
    __device__ __forceinline__ void operator()(const f32x4 (&acc)[2][2][4][2], const Unit& u, int wr, int wc, int fr, int fq) const {
        const int row0 = u.pm * BM + wr * 64 + fr, col0 = u.pn * BM + wc * 32 + 8 * fq;
        if (u.split) {
            int r0 = wr * 64 + fr; asm volatile("" : "+v"(r0));
            float* ps = OS + (size_t)(u.k0 >> 2) * 256 * ldc;
#pragma unroll
            for (int ai = 0; ai < 2; ++ai)
#pragma unroll
                for (int m = 0; m < 4; ++m) { float* rowp = (float*)((char*)ps + (unsigned)(((r0 + ai * HALF + m * 16) * ldc + col0) * 4));
#pragma unroll
                    for (int bj = 0; bj < 2; ++bj) { *(f32x4*)(rowp + bj * HALF) = acc[ai][bj][m][0]; *(f32x4*)(rowp + bj * HALF + 4) = acc[ai][bj][m][1]; } }
            return;
        }
        int row0l = row0; asm volatile("" : "+v"(row0l));
#pragma unroll
        for (int ai = 0; ai < 2; ++ai)
#pragma unroll
            for (int m = 0; m < 4; ++m) { bf16_t* rowp = (bf16_t*)((char*)O + (unsigned)(((row0l + ai * HALF + m * 16) * ldc + col0) * 2));
#pragma unroll
                for (int bj = 0; bj < 2; ++bj) { f32x4 v0 = acc[ai][bj][m][0], v1 = acc[ai][bj][m][1];
                    if (ACT == 1) {
#pragma unroll
                        for (int j = 0; j < 4; ++j) { const float a = fmaxf(v0[j], 0.f), b = fmaxf(v1[j], 0.f); v0[j] = a * a; v1[j] = b * b; } }
                    u32x4 w; w.x = cvt_pk_bf16(v0[0], v0[1]); w.y = cvt_pk_bf16(v0[2], v0[3]); w.z = cvt_pk_bf16(v1[0], v1[1]); w.w = cvt_pk_bf16(v1[2], v1[3]);
                    *(u32x4*)(rowp + bj * HALF) = w; } }
    }
};
struct EpiMix {
    static constexpr bool PERM = true, AFTER_DRAIN = false, HOOK = true;
    const bf16_t* GF; bf16_t* O; float* PS;
    __device__ __forceinline__ void hook(f32x4 (&acc)[2][2][4][2], const Unit& u, int wr, int wc, int fr, int fq, int t) const {
        const int seg = t == 8 ? 0 : 1;
        int tidl = (wr * 4 + wc) * 64 + fq * 16 + fr; asm volatile("" : "+v"(tidl));
        const char* ga_p = (const char*)GF + ((size_t)(((seg * 4 + u.pn) * 65 + u.pm) * 16) * 512 + tidl) * 8; const char* gb_p = ga_p + (size_t)4 * 65 * 16 * 512 * 8;
#pragma unroll
        for (int ai = 0; ai < 2; ++ai) {
            u32x2 ga[4][2], gb[4][2];
#pragma unroll
            for (int m = 0; m < 4; ++m)
#pragma unroll
                for (int bj = 0; bj < 2; ++bj) { ga[m][bj] = *(const u32x2*)(ga_p + (ai * 8 + m * 2 + bj) * 4096); gb[m][bj] = *(const u32x2*)(gb_p + (ai * 8 + m * 2 + bj) * 4096); }
            __builtin_amdgcn_sched_barrier(0);
#pragma unroll
            for (int m = 0; m < 4; ++m)
#pragma unroll
                for (int bj = 0; bj < 2; ++bj) { f32x4 r0, r1;
#pragma unroll
                    for (int k = 0; k < 4; ++k) { r0[k] = gq(ga[m][bj].x, k) * __builtin_amdgcn_rcpf(gq(gb[m][bj].x, k)); r1[k] = gq(ga[m][bj].y, k) * __builtin_amdgcn_rcpf(gq(gb[m][bj].y, k)); }
                    acc[ai][bj][m][0] = acc[ai][bj][m][0] * r0; acc[ai][bj][m][1] = acc[ai][bj][m][1] * r1; }
            __builtin_amdgcn_sched_barrier(0);
        }
    }
    __device__ __forceinline__ void operator()(const f32x4 (&acc)[2][2][4][2], const Unit& u, int wr, int wc, int fr, int fq) const {
        int row0 = u.pm * BM + wr * 64 + fr; const int col0 = u.pn * BM + wc * 32 + 8 * fq;
        asm volatile("" : "+v"(row0));
        int tidl = (wr * 4 + wc) * 64 + fq * 16 + fr; asm volatile("" : "+v"(tidl));
        if (u.split) {
            const int br = u.k0 >= 16 ? 2 : (u.k0 >= 8 ? 1 : 0);
            float* ps = PS + (size_t)(u.k0 >> 2) * (256 * 1024);
            u32x2 gs[2][4][2];
#pragma unroll
            for (int ai = 0; ai < 2; ++ai)
#pragma unroll
                for (int m = 0; m < 4; ++m)
#pragma unroll
                    for (int bj = 0; bj < 2; ++bj) gs[ai][m][bj] = *(const u32x2*)((const char*)GF + ((size_t)(((br * 4 + u.pn) * 65 + u.pm) * 16 + ai * 8 + m * 2 + bj) * 512 + tidl) * 8);
            __builtin_amdgcn_sched_barrier(0);
#pragma unroll
            for (int ai = 0; ai < 2; ++ai)
#pragma unroll
                for (int m = 0; m < 4; ++m) { const int row = row0 + ai * HALF + m * 16;
                    float* rowp = (float*)((char*)ps + (unsigned)(((row - u.pm * BM) * 1024 + col0) * 4));
#pragma unroll
                    for (int bj = 0; bj < 2; ++bj) { const u32x2 g = gs[ai][m][bj];
                        f32x4 v0 = acc[ai][bj][m][0], v1 = acc[ai][bj][m][1];
#pragma unroll
                        for (int k = 0; k < 4; ++k) { v0[k] *= gq(g.x, k) * (1.f / 255.f); v1[k] *= gq(g.y, k) * (1.f / 255.f); }
                        *(f32x4*)(rowp + bj * HALF) = v0; *(f32x4*)(rowp + bj * HALF + 4) = v1; }
                    asm volatile("" ::: "memory"); }
            return;
        }
        u32x2 gs[2][4][2];
#pragma unroll
        for (int ai = 0; ai < 2; ++ai)
#pragma unroll
            for (int m = 0; m < 4; ++m)
#pragma unroll
                for (int bj = 0; bj < 2; ++bj) gs[ai][m][bj] = *(const u32x2*)((const char*)GF + ((size_t)(((8 + u.pn) * 65 + u.pm) * 16 + ai * 8 + m * 2 + bj) * 512 + tidl) * 8);
        __builtin_amdgcn_sched_barrier(0);
#pragma unroll
        for (int ai = 0; ai < 2; ++ai)
#pragma unroll
            for (int m = 0; m < 4; ++m) { const int row = row0 + ai * HALF + m * 16; bf16_t* rowp = (bf16_t*)((char*)O + (unsigned)((row * 1024 + col0) * 2));
#pragma unroll
                for (int bj = 0; bj < 2; ++bj) { const u32x2 g = gs[ai][m][bj];
                    f32x4 v0 = acc[ai][bj][m][0], v1 = acc[ai][bj][m][1];
#pragma unroll
                    for (int k = 0; k < 4; ++k) { v0[k] *= gq(g.x, k) * (1.f / 255.f); v1[k] *= gq(g.y, k) * (1.f / 255.f); }
                    u32x4 w; w.x = cvt_pk_bf16(v0[0], v0[1]); w.y = cvt_pk_bf16(v0[2], v0[3]); w.z = cvt_pk_bf16(v1[0], v1[1]); w.w = cvt_pk_bf16(v1[2], v1[3]);
                    *(u32x4*)(rowp + bj * HALF) = w; }
                asm volatile("" ::: "memory"); }
    }
};
template <class Epi, class Sched, bool ALIGN_EPI = false, bool SP2 = false>
__device__ __forceinline__ void gemm_phase(PG8_LAS unsigned char* lds, const Gemm g, const Sched& S, const Epi& E) {
    int tid_ = threadIdx.x; asm volatile("" : "+v"(tid_));
    const int tid = tid_, wid = __builtin_amdgcn_readfirstlane(tid >> 6), lane = tid & 63, wr = wid >> 2, wc = wid & 3, fr = lane & 15, fq = lane >> 4;
    const int K = g.K;
    unsigned voffA[2], voffB[2];
#pragma unroll
    for (int i = 0; i < 2; ++i) { int R, C; stage_rc(tid * 16 + i * 8192, R, C); const int Rb = Epi::PERM ? ((R & ~31) + perm32(R & 31)) : R;
        voffA[i] = (unsigned)(R * K + C) * 2u; voffB[i] = (unsigned)(Rb * K + C) * 2u; }
    const size_t kstep = (size_t)(BK * 2);
    const size_t hstep = (size_t)HALF * K * 2;
    const size_t tstep = 2 * hstep;
    const unsigned ldsw = (unsigned)wid * 1024u;
    const int aoff = lds_byte(wr * 64 + fr, fq * 8), boff = lds_byte(wc * 32 + fr, fq * 8);
#define PG8_SA(b, h) (((b) * 2 + (h)) * HTB)
#define PG8_SB(b, h) ((4 + (b) * 2 + (h)) * HTB)
#define PG8_STAGE(bufoff, gbase, voff) do { _Pragma("unroll") for (int _i = 0; _i < 2; ++_i) \
        __builtin_amdgcn_global_load_lds((const unsigned*)((const char*)(gbase) + (voff)[_i]), (PG8_LAS unsigned*)(lds + (bufoff) + ldsw + _i * 8192), 16, 0, 0); } while (0)
#define PG8_LDA(dst, b, h) do { _Pragma("unroll") for (int m = 0; m < 4; ++m) _Pragma("unroll") for (int k = 0; k < 2; ++k) dst[m][k] = *(const PG8_LAS bf16x8*)(lds + PG8_SA(b, h) + aoff + m * 2048 + k * 1024); } while (0)
#define PG8_LDB(dst, b, h) do { _Pragma("unroll") for (int n = 0; n < 2; ++n) _Pragma("unroll") for (int k = 0; k < 2; ++k) dst[n][k] = *(const PG8_LAS bf16x8*)(lds + PG8_SB(b, h) + boff + n * 2048 + k * 1024); } while (0)
#define PG8_MMA(ai, bj, At, Bt) do { __builtin_amdgcn_s_setprio(1); _Pragma("unroll") for (int m = 0; m < 4; ++m) _Pragma("unroll") for (int n = 0; n < 2; ++n) _Pragma("unroll") for (int k = 0; k < 2; ++k) \
        acc[ai][bj][m][n] = __builtin_amdgcn_mfma_f32_16x16x32_bf16(Bt[n][k], At[m][k], acc[ai][bj][m][n], 0, 0, 0); __builtin_amdgcn_s_setprio(0); } while (0)
#define PG8_WAIT_V(n) asm volatile("s_waitcnt vmcnt(" #n ")" ::: "memory")
#define PG8_WAIT_L(n) asm volatile("s_waitcnt lgkmcnt(" #n ")" ::: "memory")
#define PG8_BAR __builtin_amdgcn_s_barrier()
#define PG8_SCHED __builtin_amdgcn_sched_barrier(0)
    Unit cur, nxt; int ui = 0;
    if (!S.next(0, cur)) return;
    f32x4 acc[2][2][4][2];
#pragma unroll
    for (int a = 0; a < 2; ++a)
#pragma unroll
        for (int b = 0; b < 2; ++b)
#pragma unroll
            for (int m = 0; m < 4; ++m)
#pragma unroll
                for (int n = 0; n < 2; ++n) acc[a][b][m][n] = (f32x4){0.f, 0.f, 0.f, 0.f};
    bf16x8 At[4][2], B0[2][2], B1[2][2];
    const char* cA = (const char*)g.A + (size_t)cur.pm * tstep + (size_t)cur.k0 * kstep; const char* cB = (const char*)g.Bt + (size_t)cur.pn * tstep + (size_t)cur.k0 * kstep;
    S.a_ready(cur);
    if constexpr (SP2) {
        PG8_STAGE(PG8_SB(0, 0), cB, voffB); PG8_STAGE(PG8_SB(0, 1), cB + hstep, voffB); PG8_STAGE(PG8_SA(0, 0), cA, voffA); PG8_STAGE(PG8_SA(0, 1), cA + hstep, voffA);
        if (wr == 1) PG8_BAR;
        PG8_WAIT_V(2); PG8_BAR;
        PG8_STAGE(PG8_SB(1, 0), cB + kstep, voffB); PG8_STAGE(PG8_SA(1, 0), cA + kstep, voffA); PG8_STAGE(PG8_SB(1, 1), cB + hstep + kstep, voffB);
        PG8_WAIT_V(6); PG8_BAR;
    } else {
        PG8_STAGE(PG8_SB(0, 0), cB, voffB); PG8_STAGE(PG8_SA(0, 0), cA, voffA); PG8_STAGE(PG8_SB(0, 1), cB + hstep, voffB); PG8_STAGE(PG8_SA(0, 1), cA + hstep, voffA);
        if (wr == 1) PG8_BAR;
        PG8_WAIT_V(4); PG8_BAR;
        PG8_STAGE(PG8_SB(1, 0), cB + kstep, voffB); PG8_STAGE(PG8_SA(1, 0), cA + kstep, voffA); PG8_STAGE(PG8_SB(1, 1), cB + hstep + kstep, voffB);
        PG8_WAIT_V(6); PG8_BAR;
    }
    for (;;) {
        const bool has_next = S.next(ui + 1, nxt);
        const char* nA = has_next ? (const char*)g.A + (size_t)nxt.pm * tstep + (size_t)nxt.k0 * kstep : cA; const char* nB = has_next ? (const char*)g.Bt + (size_t)nxt.pn * tstep + (size_t)nxt.k0 * kstep : cB;
        const int nt = cur.nt;
        for (int t = 0; t < nt; t += 2) {
            if constexpr (Epi::HOOK) { if (t == 8 || t == 16) { PG8_SCHED; E.hook(acc, cur, wr, wc, fr, fq, t); PG8_SCHED; } }
            const bool last = (t == nt - 2);
            const char* a1 = cA + (size_t)(t + 1) * kstep;
            const char* a2 = last ? nA : cA + (size_t)(t + 2) * kstep; const char* b2 = last ? nB : cB + (size_t)(t + 2) * kstep;
            const char* a3 = a2 + kstep; const char* b3 = b2 + kstep;
            if (last && has_next) S.a_ready(nxt);
            if constexpr (SP2) {
            PG8_LDB(B0, 0, 0); PG8_LDB(B1, 0, 1); PG8_SCHED; PG8_LDA(At, 0, 0); PG8_STAGE(PG8_SA(1, 1), a1 + hstep, voffA);
            PG8_WAIT_V(8); PG8_WAIT_L(0); PG8_BAR; PG8_MMA(0, 0, At, B0); PG8_MMA(0, 1, At, B1); PG8_BAR; PG8_SCHED;
            PG8_LDA(At, 0, 1); PG8_STAGE(PG8_SB(0, 0), b2, voffB); PG8_STAGE(PG8_SB(0, 1), b2 + hstep, voffB); PG8_STAGE(PG8_SA(0, 0), a2, voffA);
            PG8_WAIT_V(8); PG8_WAIT_L(0); PG8_BAR; PG8_MMA(1, 0, At, B0); PG8_MMA(1, 1, At, B1); PG8_BAR; PG8_SCHED;
            PG8_LDB(B0, 1, 0); PG8_LDB(B1, 1, 1); PG8_SCHED; PG8_LDA(At, 1, 0); PG8_STAGE(PG8_SA(0, 1), a2 + hstep, voffA);
            PG8_WAIT_V(8); PG8_WAIT_L(0); PG8_BAR; PG8_MMA(0, 0, At, B0); PG8_MMA(0, 1, At, B1); PG8_BAR; PG8_SCHED;
            PG8_LDA(At, 1, 1); PG8_STAGE(PG8_SB(1, 0), b3, voffB); PG8_STAGE(PG8_SB(1, 1), b3 + hstep, voffB); PG8_STAGE(PG8_SA(1, 0), a3, voffA);
            PG8_WAIT_V(8); PG8_WAIT_L(0); PG8_BAR; PG8_MMA(1, 0, At, B0); PG8_MMA(1, 1, At, B1); PG8_BAR; PG8_SCHED;
            } else {
            PG8_LDB(B0, 0, 0); PG8_SCHED; PG8_LDA(At, 0, 0); PG8_STAGE(PG8_SA(1, 1), a1 + hstep, voffA);
            PG8_WAIT_L(8); PG8_BAR; PG8_WAIT_L(0); PG8_MMA(0, 0, At, B0); PG8_BAR; PG8_SCHED;
            PG8_LDB(B1, 0, 1); PG8_STAGE(PG8_SB(0, 0), b2, voffB);
            PG8_BAR; PG8_WAIT_L(0); PG8_MMA(0, 1, At, B1); PG8_BAR;
            PG8_LDA(At, 0, 1); PG8_STAGE(PG8_SA(0, 0), a2, voffA);
            PG8_BAR; PG8_WAIT_L(0); PG8_MMA(1, 0, At, B0); PG8_BAR; PG8_SCHED;
            PG8_STAGE(PG8_SB(0, 1), b2 + hstep, voffB);
            PG8_WAIT_V(6); PG8_BAR; PG8_MMA(1, 1, At, B1); PG8_BAR;
            PG8_LDB(B0, 1, 0); PG8_SCHED; PG8_LDA(At, 1, 0); PG8_STAGE(PG8_SA(0, 1), a2 + hstep, voffA);
            PG8_WAIT_L(8); PG8_BAR; PG8_WAIT_L(0); PG8_MMA(0, 0, At, B0); PG8_BAR; PG8_SCHED;
            PG8_LDB(B1, 1, 1); PG8_STAGE(PG8_SB(1, 0), b3, voffB);
            PG8_BAR; PG8_WAIT_L(0); PG8_MMA(0, 1, At, B1); PG8_BAR;
            PG8_LDA(At, 1, 1); PG8_STAGE(PG8_SA(1, 0), a3, voffA);
            PG8_BAR; PG8_WAIT_L(0); PG8_MMA(1, 0, At, B0); PG8_BAR; PG8_SCHED;
            PG8_STAGE(PG8_SB(1, 1), b3 + hstep, voffB);
            PG8_WAIT_V(6); PG8_BAR; PG8_MMA(1, 1, At, B1); PG8_BAR;
            }
        }
        if constexpr (ALIGN_EPI) { if (wr == 0) PG8_BAR; }
        if constexpr (!Epi::AFTER_DRAIN) { E(acc, cur, wr, wc, fr, fq); S.done(cur); }
        if (!has_next) break;
#pragma unroll
        for (int a = 0; a < 2; ++a)
#pragma unroll
            for (int b = 0; b < 2; ++b)
#pragma unroll
                for (int m = 0; m < 4; ++m)
#pragma unroll
                    for (int n = 0; n < 2; ++n) acc[a][b][m][n] = (f32x4){0.f, 0.f, 0.f, 0.f};
        cur = nxt; cA = nA; cB = nB; ++ui;
        if constexpr (ALIGN_EPI) { if (wr == 1) PG8_BAR; }
    }
    PG8_WAIT_V(0);
    if constexpr (!ALIGN_EPI) { if (wr == 0) PG8_BAR; }
    PG8_BAR;
    if constexpr (Epi::AFTER_DRAIN) { E.fused(acc, cur, wr, wc, fr, fq, lds, wid, lane); S.done(cur); }
#undef PG8_SA
#undef PG8_SB
#undef PG8_STAGE
#undef PG8_LDA
#undef PG8_LDB
#undef PG8_MMA
#undef PG8_WAIT_V
#undef PG8_WAIT_L
#undef PG8_BAR
#undef PG8_SCHED
}
}
#define LAS __attribute__((address_space(3)))
constexpr int NWAVES = 8;
constexpr size_t WS_LAGG = 870 * MiB;
constexpr size_t WS_LHIN = 871 * MiB;
constexpr size_t WS_LAB = 991 * MiB;
constexpr size_t WS_LRUW = 872 * MiB;
typedef float f32x4v __attribute__((ext_vector_type(4)));
typedef unsigned u32x4v __attribute__((ext_vector_type(4)));
typedef unsigned u32x2v __attribute__((ext_vector_type(2)));
DEV unsigned pk2(float lo, float hi) { return cvt_pk_bf16_hw(lo, hi); }
DEV int tid_opaque() { int t = threadIdx.x; asm volatile("" : "+v"(t)); return t; }
DEV void lds_wait() { asm volatile("s_waitcnt lgkmcnt(0)" ::: "memory"); }

DEV void wt_item(const float* __restrict__ W, int N, bf16_t* __restrict__ WT, int P, int koff, const float* __restrict__ scale, LAS float* scr, int item, int lane) {
    const int nblk = N / 64, kb = item / nblk, nb = item % nblk, k0 = 64 * kb, n0 = 64 * nb;
    { float v[64];
#pragma unroll
      for (int i = 0; i < 64; ++i) v[i] = __builtin_nontemporal_load(W + (size_t)(k0 + i) * N + n0 + lane);
      const float sc0 = scale ? scale[k0 + lane] : 1.f;
#pragma unroll
      for (int i = 0; i < 64; ++i) scr[i * 65 + lane] = v[i] * __shfl(sc0, i); }
    lds_wait();
    const int c = lane & 7;
#pragma unroll
    for (int j = 0; j < 8; ++j) { const int n = (lane >> 3) + 8 * j; const LAS float* s = scr + (8 * c) * 65 + n;
        u32x4v o; o.x = pk2(s[0 * 65], s[1 * 65]); o.y = pk2(s[2 * 65], s[3 * 65]); o.z = pk2(s[4 * 65], s[5 * 65]); o.w = pk2(s[6 * 65], s[7 * 65]);
        *(u32x4v*)(WT + (size_t)(n0 + n) * P + koff + k0 + 8 * c) = o; }
    lds_wait();
}
DEV void xn_finish(const f32x4v (&v)[4], bf16_t* __restrict__ o, int lane) {
    float s = 0.f;
#pragma unroll
    for (int j = 0; j < 4; ++j) s += (v[j].x * v[j].x + v[j].y * v[j].y) + (v[j].z * v[j].z + v[j].w * v[j].w);
    const float rinv = rsqrtf(wave_sum(s) * (1.f / DM) + 1e-6f);
    u32x2v* o8 = (u32x2v*)o + lane;
#pragma unroll
    for (int j = 0; j < 4; ++j) { u32x2v w; w.x = pk2(v[j].x * rinv, v[j].y * rinv); w.y = pk2(v[j].z * rinv, v[j].w * rinv); o8[64 * j] = w; }
}
DEV void xn_row(const float* __restrict__ x, bf16_t* __restrict__ o, int lane) {
    const f32x4v* xr = (const f32x4v*)x + lane; f32x4v v[4]; float s = 0.f;
#pragma unroll
    for (int j = 0; j < 4; ++j) { v[j] = xr[64 * j]; s += (v[j].x * v[j].x + v[j].y * v[j].y) + (v[j].z * v[j].z + v[j].w * v[j].w); }
    const float rinv = rsqrtf(wave_sum(s) * (1.f / DM) + 1e-6f);
    u32x2v* o8 = (u32x2v*)o + lane;
#pragma unroll
    for (int j = 0; j < 4; ++j) { u32x2v w; w.x = pk2(v[j].x * rinv, v[j].y * rinv); w.y = pk2(v[j].z * rinv, v[j].w * rinv); o8[64 * j] = w; }
}
struct EltRow { u32x2v o[4]; f32x4v x[4]; };
DEV f32x4v bf4(u32x2v w) { return (f32x4v){__uint_as_float(w.x << 16), __uint_as_float(w.x & 0xffff0000u), __uint_as_float(w.y << 16), __uint_as_float(w.y & 0xffff0000u)}; }
DEV void elt_load(EltRow& r, const float* __restrict__ x, const bf16_t* __restrict__ xb, const bf16_t* __restrict__ O, int lane) {
    const u32x2v* orow = (const u32x2v*)O + lane;
#pragma unroll
    for (int j = 0; j < 4; ++j) r.o[j] = __builtin_nontemporal_load(orow + 64 * j);
    if (xb) { const u32x2v* xr = (const u32x2v*)xb + lane;
#pragma unroll
        for (int j = 0; j < 4; ++j) r.x[j] = bf4(__builtin_nontemporal_load(xr + 64 * j)); }
    else { const f32x4v* xr = (const f32x4v*)x + lane;
#pragma unroll
        for (int j = 0; j < 4; ++j) r.x[j] = __builtin_nontemporal_load(xr + 64 * j); }
}
DEV void elt_load_f32(EltRow& r, f32x4v (&of)[4], const float* __restrict__ x, const bf16_t* __restrict__ xb, const float* __restrict__ O, int nks, int lane) {
    const f32x4v* orow = (const f32x4v*)O + lane;
#pragma unroll
    for (int j = 0; j < 4; ++j) of[j] = orow[64 * j];
    if (xb) { const u32x2v* xr = (const u32x2v*)xb + lane;
#pragma unroll
        for (int j = 0; j < 4; ++j) r.x[j] = bf4(xr[64 * j]); }
    else { const f32x4v* xr = (const f32x4v*)x + lane;
#pragma unroll
        for (int j = 0; j < 4; ++j) r.x[j] = xr[64 * j]; }
    { orow += 65536; f32x4v t[4];
#pragma unroll
      for (int j = 0; j < 4; ++j) t[j] = orow[64 * j];
      __builtin_amdgcn_sched_barrier(0);
#pragma unroll
      for (int j = 0; j < 4; ++j) of[j] += t[j];
      __builtin_amdgcn_sched_barrier(0); }
#pragma unroll 1
    for (int ks = 2; ks < nks; ks += 2) { f32x4v t[2][4];
#pragma unroll
        for (int u = 0; u < 2; ++u)
#pragma unroll
            for (int j = 0; j < 4; ++j) t[u][j] = orow[(size_t)(u + 1) * 65536 + 64 * j];
        orow += 2 * 65536;
        __builtin_amdgcn_sched_barrier(0);
#pragma unroll
        for (int j = 0; j < 4; ++j) of[j] += t[0][j] + t[1][j];
        __builtin_amdgcn_sched_barrier(0); }
}
DEV void elt_finish(const f32x4v (&o)[4], const f32x4v (&x)[4], const f32x4v (&gv)[4], float* __restrict__ xout, bf16_t* __restrict__ xob, bf16_t* __restrict__ xn, int lane) {
    float s = 0.f;
#pragma unroll
    for (int j = 0; j < 4; ++j) s += (o[j].x * o[j].x + o[j].y * o[j].y) + (o[j].z * o[j].z + o[j].w * o[j].w);
    const float rinv = rsqrtf(wave_sum(s) * (1.f / DM) + 1e-6f);
    f32x4v v[4]; float s2 = 0.f;
#pragma unroll
    for (int j = 0; j < 4; ++j) { v[j] = x[j] + o[j] * rinv * gv[j]; s2 += (v[j].x * v[j].x + v[j].y * v[j].y) + (v[j].z * v[j].z + v[j].w * v[j].w); }
    f32x4v* xo = (f32x4v*)xout + lane;
    if (xn == nullptr) {
#pragma unroll
        for (int j = 0; j < 4; ++j) __builtin_nontemporal_store(v[j], xo + 64 * j);
        return;
    }
    const float rinv2 = rsqrtf(wave_sum(s2) * (1.f / DM) + 1e-6f);
    u32x2v* o8 = (u32x2v*)xn + lane;
#pragma unroll
    for (int j = 0; j < 4; ++j) { if (xob) { u32x2v wx; wx.x = pk2(v[j].x, v[j].y); wx.y = pk2(v[j].z, v[j].w); __builtin_nontemporal_store(wx, (u32x2v*)xob + lane + 64 * j); } else __builtin_nontemporal_store(v[j], xo + 64 * j);
        u32x2v w; w.x = pk2(v[j].x * rinv2, v[j].y * rinv2); w.y = pk2(v[j].z * rinv2, v[j].w * rinv2); o8[64 * j] = w; }
}
constexpr size_t WS_OS3 = 933 * MiB, WS_OS5 = 937 * MiB;
constexpr size_t WS_PSM = 966 * MiB, WS_PSH = 972 * MiB;
constexpr size_t WS_GF = 735 * MiB;
constexpr size_t WS_CTL = 0;
DEV void sample_finish(unsigned* ctr, unsigned need, const float* part, int nks, bf16_t* dst, int ld, int act, int s) {
    const int tid = tid_opaque();
    if (tid == 0) { while (__hip_atomic_load(ctr, __ATOMIC_RELAXED, __HIP_MEMORY_SCOPE_AGENT) < need) __builtin_amdgcn_s_sleep(2); }
    __syncthreads();
    __builtin_amdgcn_fence(__ATOMIC_ACQUIRE, "agent");
    asm volatile("s_waitcnt vmcnt(0)" ::: "memory");
    const int q = ld >> 2, ngrp = (256 * q) >> 16;
#pragma unroll 1
    for (int g0 = 0; g0 < ngrp; g0 += 2) { f32x4v v[2][5];
#pragma unroll
        for (int gg = 0; gg < 2; ++gg) { const int g = g0 + gg < ngrp ? g0 + gg : ngrp - 1; const int idx4 = (s * ngrp + g) * 512 + tid, row = idx4 / q, c4 = idx4 - row * q;
            const float* p = part + (size_t)row * ld + c4 * 4;
#pragma unroll
            for (int ks = 0; ks < 5; ++ks) v[gg][ks] = *(const f32x4v*)(p + (size_t)(ks < nks ? ks : nks - 1) * 256 * ld); }
        __builtin_amdgcn_sched_barrier(0);
#pragma unroll
        for (int gg = 0; gg < 2; ++gg) { if (g0 + gg < ngrp) { const int idx4 = (s * ngrp + g0 + gg) * 512 + tid, row = idx4 / q, c4 = idx4 - row * q;
            f32x4v sm = (v[gg][0] + v[gg][1]) + (v[gg][2] + v[gg][3]);
            if (nks > 4) sm = sm + v[gg][4];
            if (act == 1) { sm.x = fmaxf(sm.x, 0.f); sm.x *= sm.x; sm.y = fmaxf(sm.y, 0.f); sm.y *= sm.y; sm.z = fmaxf(sm.z, 0.f); sm.z *= sm.z; sm.w = fmaxf(sm.w, 0.f); sm.w *= sm.w; }
            u32x2v w; w.x = pk2(sm.x, sm.y); w.y = pk2(sm.z, sm.w);
            *(u32x2v*)(dst + (size_t)row * ld + c4 * 4) = w; } }
        __builtin_amdgcn_sched_barrier(0); }
}
DEV void phase_prologue(const float* const* in, float* out, unsigned char* ws, LAS unsigned char* lds, int G, int c) {
    const int tid = tid_opaque(), lane = tid & 63, wave = tid >> 6;
    {
        const int gw = c * NWAVES + wave, NGW = G * NWAVES;
        LAS float* scr = (LAS float*)(lds + wave * 16896);
        bf16_t* XN = (bf16_t*)(ws + WS_XN);
        for (int m = gw; m < MT; m += 2 * NGW) {
            const int m1 = m + NGW; const float* x0 = m < MP ? in[0] + (size_t)m * DM : in[1] + (size_t)(m - MP) * DM;
            const float* x1 = m1 < MP ? in[0] + (size_t)m1 * DM : in[1] + (size_t)(m1 - MP) * DM;
            f32x4v a0[4], a1[4];
#pragma unroll
            for (int j = 0; j < 4; ++j) { a0[j] = ((const f32x4v*)x0)[lane + 64 * j]; if (m1 < MT) a1[j] = ((const f32x4v*)x1)[lane + 64 * j]; }
            xn_finish(a0, XN + (size_t)m * DM, lane);
            if (m1 < MT) xn_finish(a1, XN + (size_t)m1 * DM, lane);
        }
        constexpr int I_IN = 16 * 124, I_BA = 8 * 16, I_BC = 4 * 16, I_OUT = 16 * 16, I_UP = 16 * 64, I_DN = 64 * 16, I_L = I_IN + 2 * I_BA + I_BC + I_OUT + I_UP + I_DN;
        for (int it = gw; it < 2 * I_L; it += NGW) {
            const int l = it / I_L; int r = it % I_L; unsigned char* wl = ws + WS_W + (size_t)l * WS_WL;
            if (r < I_IN) { wt_item(in[12] + (size_t)l * DM * NIN, NIN, (bf16_t*)(wl + W_IN), DM, 0, in[8] + l * DM, scr, r, lane); continue; } r -= I_IN;
            if (r < I_BA) { wt_item(in[23] + (size_t)l * 512 * DM, DM, (bf16_t*)(wl + W_BR), YK, 0, nullptr, scr, r, lane); continue; } r -= I_BA;
            if (r < I_BA) { wt_item(in[24] + (size_t)l * 512 * DM, DM, (bf16_t*)(wl + W_BR), YK, 512, nullptr, scr, r, lane); continue; } r -= I_BA;
            if (r < I_BC) { wt_item(in[25] + (size_t)l * 256 * DM, DM, (bf16_t*)(wl + W_BR), YK, 1024, nullptr, scr, r, lane); continue; } r -= I_BC;
            if (r < I_OUT) { wt_item(in[26] + (size_t)l * DM * DM, DM, (bf16_t*)(wl + W_OUT), DM, 0, nullptr, scr, r, lane); continue; } r -= I_OUT;
            if (r < I_UP) { wt_item(in[27] + (size_t)l * DM * DFF, DFF, (bf16_t*)(wl + W_UP), DM, 0, in[10] + l * DM, scr, r, lane); continue; } r -= I_UP;
            wt_item(in[28] + (size_t)l * DFF * DM, DM, (bf16_t*)(wl + W_DN), DFF, 0, nullptr, scr, r, lane);
        }
        { bf16_t* lw = (bf16_t*)(ws + WS_LRUW);
          for (int i = c * 512 + tid; i < 2 * 2 * 8 * 4096; i += G * 512) { const int d = i & 63, e = (i >> 6) & 63, n = (i >> 12) & 7, k = (i >> 15) & 1, l = i >> 16;
              lw[i] = f2bf(in[k ? 18 : 16][((size_t)(l * 8 + n) * 64 + d) * 64 + e]); } }
    }
    unsigned* qctr = (unsigned*)(ws + WS_CTL);
    for (;;) {
        unsigned q = 0; if (lane == 0) q = __hip_atomic_fetch_add(qctr, 1u, __ATOMIC_RELAXED, __HIP_MEMORY_SCOPE_AGENT);
        q = (unsigned)__builtin_amdgcn_readfirstlane((int)q);
        if (q >= 2048u) break;
        const unsigned blk = q >> 5, m0 = (q & 31u) * 4u;
        const f32x4v* src = (const f32x4v*)in[7] + (size_t)blk * 262144 + (size_t)(16u * m0 + 8u) * 128; f32x4v* dst = (f32x4v*)(out + O_W2048S) + (size_t)blk * 262144 + (size_t)(16u * m0) * 128;
#pragma unroll 1
        for (int it8 = 0; it8 < 4; ++it8) { f32x4v v[16]; const unsigned o = (unsigned)it8 * 2048u + lane;
#pragma unroll
            for (int k = 0; k < 16; ++k) v[k] = __builtin_nontemporal_load(src + o + k * 64);
#pragma unroll
            for (int k = 0; k < 16; ++k) __builtin_nontemporal_store(v[k], dst + o + k * 64); }
    }
}
#ifndef ELT_STEP
#define ELT_STEP 1
#endif
DEV void phase_elt(const float* xp, const float* xs, const bf16_t* xb  , const bf16_t* O, const float* OS, int nks, const float* g,
                   float* xout  , bf16_t* xob  , bf16_t* XN, int G, int c) {
    const int tid = tid_opaque(), lane = tid & 63, wave = tid >> 6, gw = c * NWAVES + wave, NGW = G * NWAVES;
    f32x4v gv[4];
#pragma unroll
    for (int j = 0; j < 4; ++j) gv[j] = ((const f32x4v*)g)[lane + 64 * j];
    EltRow r0, r1;
    const bool xmap = (G == 256);
    int m = xmap ? 2048 * (c & 7) + (ELT_STEP == 1 ? ((c >> 3) * NWAVES + wave) * 8 : (ELT_STEP == 8 ? (c >> 3) * 64 + wave : (c >> 3) * NWAVES + wave)) : gw;
    const int mstep = xmap ? ELT_STEP : NGW, mend = xmap ? (ELT_STEP == 1 ? m + 8 : (ELT_STEP == 8 ? 2048 * (c & 7) + (c >> 3) * 64 + 64 : 2048 * (c & 7) + 2048)) : MP;
    if (m < mend) elt_load(r0, xp + (size_t)m * DM, xb ? xb + (size_t)m * DM : nullptr, O + (size_t)m * DM, lane);
#pragma unroll 1
    for (; m < mend; m += 2 * mstep) {
        const int m1 = m + mstep, m2 = m + 2 * mstep;
        if (m1 < mend) elt_load(r1, xp + (size_t)m1 * DM, xb ? xb + (size_t)m1 * DM : nullptr, O + (size_t)m1 * DM, lane);
        { f32x4v o[4];
#pragma unroll
          for (int j = 0; j < 4; ++j) { o[j].x = __uint_as_float(r0.o[j].x << 16); o[j].y = __uint_as_float(r0.o[j].x & 0xffff0000u); o[j].z = __uint_as_float(r0.o[j].y << 16); o[j].w = __uint_as_float(r0.o[j].y & 0xffff0000u); }
          elt_finish(o, r0.x, gv, xout + (size_t)m * DM, xob ? xob + (size_t)m * DM : nullptr, XN ? XN + (size_t)m * DM : nullptr, lane); }
        if (m2 < mend) elt_load(r0, xp + (size_t)m2 * DM, xb ? xb + (size_t)m2 * DM : nullptr, O + (size_t)m2 * DM, lane);
        if (m1 < mend) { f32x4v o[4];
#pragma unroll
          for (int j = 0; j < 4; ++j) { o[j].x = __uint_as_float(r1.o[j].x << 16); o[j].y = __uint_as_float(r1.o[j].x & 0xffff0000u); o[j].z = __uint_as_float(r1.o[j].y << 16); o[j].w = __uint_as_float(r1.o[j].y & 0xffff0000u); }
          elt_finish(o, r1.x, gv, xout + (size_t)m1 * DM, xob ? xob + (size_t)m1 * DM : nullptr, XN ? XN + (size_t)m1 * DM : nullptr, lane); }
    }
    for (int ms = gw; ms < MS; ms += NGW) { const int mm = MP + ms; f32x4v o[4];
        if (OS) { elt_load_f32(r0, o, xs + (size_t)ms * DM, xb ? xb + (size_t)mm * DM : nullptr, OS + (size_t)ms * DM, nks, lane); }
        else { elt_load(r0, xs + (size_t)ms * DM, xb ? xb + (size_t)mm * DM : nullptr, O + (size_t)mm * DM, lane);
#pragma unroll
          for (int j = 0; j < 4; ++j) { o[j].x = __uint_as_float(r0.o[j].x << 16); o[j].y = __uint_as_float(r0.o[j].x & 0xffff0000u); o[j].z = __uint_as_float(r0.o[j].y << 16); o[j].w = __uint_as_float(r0.o[j].y & 0xffff0000u); } }
        elt_finish(o, r0.x, gv, xout + (size_t)mm * DM, xob ? xob + (size_t)mm * DM : nullptr, XN ? XN + (size_t)mm * DM : nullptr, lane); }
}

constexpr int XC_P = 516;
typedef short bf16x8l __attribute__((ext_vector_type(8)));
template <bool FINAL>
DEV void lru_item(const float* const* in, float* out, unsigned char* ws, LAS unsigned char* lds, int l, bool sample, int idx) {
    const int tid = tid_opaque(), c = tid, w = tid >> 6, lane = tid & 63, fr = lane & 15, fq = lane >> 4;
    const bf16_t* Z = (const bf16_t*)(ws + WS_Z); bf16_t* Y = (bf16_t*)(ws + WS_Y);
    LAS float* xc = (LAS float*)lds;
    const int T = sample ? 8 : 64, NMT = sample ? 1 : 4, row0 = sample ? MP + idx * 8 : idx * 64;
    { const float* cw = in[14] + (size_t)l * 4 * 512; const float cb = in[15][l * 512 + c];
      const float w0 = cw[c], w1 = cw[512 + c], w2 = cw[1024 + c], w3 = cw[1536 + c];
      float u0, u1, u2;
      if (sample) { const float* st = in[2] + ((size_t)l * 32 + idx) * 3 * 512; u0 = st[c]; u1 = st[512 + c]; u2 = st[1024 + c]; }
      else if (idx == 0) { u0 = 0.f; u1 = 0.f; u2 = 0.f; }
      else { u0 = 0.f; u1 = 0.f; u2 = 0.f; }
      if (!sample) { bf16_t ur[64], up[3];
#pragma unroll
          for (int t = 0; t < 3; ++t) up[t] = Z[(size_t)(idx > 0 ? row0 - 3 + t : t) * NIN + c];
#pragma unroll
          for (int t = 0; t < 64; ++t) ur[t] = Z[(size_t)(row0 + t) * NIN + c];
          __builtin_amdgcn_sched_barrier(0);
          if (idx > 0) { u0 = bf2f(up[0]); u1 = bf2f(up[1]); u2 = bf2f(up[2]); }
#pragma unroll
          for (int t = 0; t < 64; ++t) { const float u3 = bf2f(ur[t]); xc[t * XC_P + c] = cb + w0 * u0 + w1 * u1 + w2 * u2 + w3 * u3; u0 = u1; u1 = u2; u2 = u3; }
      } else {
          bf16_t ur8[8];
#pragma unroll
          for (int t = 0; t < 8; ++t) ur8[t] = Z[(size_t)(row0 + t) * NIN + c];
          __builtin_amdgcn_sched_barrier(0);
#pragma unroll
          for (int t = 0; t < 8; ++t) { const float u3 = bf2f(ur8[t]); xc[t * XC_P + c] = cb + w0 * u0 + w1 * u1 + w2 * u2 + w3 * u3; u0 = u1; u1 = u2; u2 = u3; }
      }
      if (FINAL && sample) { float* o = out + O_CONVS + ((size_t)l * 32 + idx) * 3 * 512; o[c] = u0; o[512 + c] = u1; o[1024 + c] = u2; }
      else if (!FINAL && !sample && idx == 255) { float* o = out + O_CONVP + (size_t)l * 3 * 512; o[c] = u0; o[512 + c] = u1; o[1024 + c] = u2; }
    }
    bf16x8l bw[2][4][2];
    { const bf16_t* wb = (const bf16_t*)(ws + WS_LRUW) + ((size_t)(l * 2) * 8 + w) * 4096 + fr * 64 + fq * 8;
#pragma unroll
      for (int g = 0; g < 2; ++g)
#pragma unroll
          for (int nt = 0; nt < 4; ++nt)
#pragma unroll
              for (int ks = 0; ks < 2; ++ks) bw[g][nt][ks] = *(const bf16x8l*)(wb + (size_t)g * 8 * 4096 + nt * 16 * 64 + ks * 32); }
    float br[4], bi[4], sp[4], Hc[4], Ac[4];
#pragma unroll
    for (int nt = 0; nt < 4; ++nt) { const int cc = w * 64 + nt * 16 + fr;
        br[nt] = in[17][l * 512 + cc]; bi[nt] = in[19][l * 512 + cc]; { const float xl = __expf(-in[20][l * 512 + cc]);
          sp[nt] = -8.f * (xl < 0.1f ? xl * (1.f - xl * (0.5f - xl * (0.33333334f - xl * (0.25f - xl * (0.2f - xl * 0.16666667f))))) : __logf(1.f + xl)); } Ac[nt] = 1.f;
        Hc[nt] = FINAL ? (sample ? in[3][((size_t)l * 32 + idx) * 512 + cc] : ((const float*)(ws + WS_LHIN))[(size_t)idx * 512 + cc]) : 0.f; }
    __syncthreads();
#pragma unroll 1
    for (int mt = 0; mt < NMT; ++mt) {
        bf16x8l af[2];
#pragma unroll
        for (int ks = 0; ks < 2; ++ks) { const LAS f32x4v* xp = (const LAS f32x4v*)(xc + (mt * 16 + fr) * XC_P + w * 64 + ks * 32 + fq * 8);
            const f32x4v x0 = xp[0], x1 = xp[1]; u32x4v p; p.x = pk2(x0.x, x0.y); p.y = pk2(x0.z, x0.w); p.z = pk2(x1.x, x1.y); p.w = pk2(x1.z, x1.w);
            af[ks] = __builtin_bit_cast(bf16x8l, p); }
#pragma unroll
        for (int nt = 0; nt < 4; ++nt) {
            f32x4v rp = {0.f, 0.f, 0.f, 0.f}, ip = {0.f, 0.f, 0.f, 0.f};
#pragma unroll
            for (int ks = 0; ks < 2; ++ks) { rp = __builtin_amdgcn_mfma_f32_16x16x32_bf16(af[ks], bw[0][nt][ks], rp, 0, 0, 0); ip = __builtin_amdgcn_mfma_f32_16x16x32_bf16(af[ks], bw[1][nt][ks], ip, 0, 0, 0); }
            const int cc = w * 64 + nt * 16 + fr;
            float aj[4], bj[4], lgj[4];
#pragma unroll
            for (int j = 0; j < 4; ++j) { const int t = mt * 16 + fq * 4 + j;
                const float x = xc[t * XC_P + cc];
                const float r = __builtin_amdgcn_rcpf(1.f + __expf(-(rp[j] + br[nt]))), ig = __builtin_amdgcn_rcpf(1.f + __expf(-(ip[j] + bi[nt])));
                const float log_a = sp[nt] * r, a = __expf(log_a), x2 = 2.f * log_a;
                const float em = x2 > -0.25f ? -x2 * (1.f + x2 * (0.5f + x2 * (0.16666667f + x2 * (0.041666668f + x2 * (0.0083333333f + x2 * 0.0013888889f))))) : 1.f - a * a;
                const float mult = (!sample && idx == 0 && t == 0) ? 1.f : __builtin_sqrtf(em);
                const bool valid = t < T;
                aj[j] = valid ? a : 1.f; bj[j] = valid ? mult * ig * x : 0.f; lgj[j] = log_a; }
            if (!FINAL) {
#pragma unroll
                for (int j = 0; j < 4; ++j) ((unsigned*)(ws + WS_LAB))[(size_t)(row0 + mt * 16 + fq * 4 + j) * 512 + cc] = pk2(lgj[j], bj[j]); }
            float A4 = aj[0] * aj[1] * aj[2] * aj[3], B4 = ((bj[0] * aj[1] + bj[1]) * aj[2] + bj[2]) * aj[3] + bj[3];
            { const float A1 = __shfl(A4, (lane - 16) & 63), B1 = __shfl(B4, (lane - 16) & 63); if (fq >= 1) { B4 = B1 * A4 + B4; A4 = A1 * A4; } }
            { const float A2 = __shfl(A4, (lane - 32) & 63), B2 = __shfl(B4, (lane - 32) & 63); if (fq >= 2) { B4 = B2 * A4 + B4; A4 = A2 * A4; } }
            const float At = __shfl(A4, 48 + fr), Bt = __shfl(B4, 48 + fr);
            if (FINAL) {
                const float Ae = __shfl(A4, (lane - 16) & 63), Be = __shfl(B4, (lane - 16) & 63);
                float h = fq == 0 ? Hc[nt] : Ae * Hc[nt] + Be;
#pragma unroll
                for (int j = 0; j < 4; ++j) { const int t = mt * 16 + fq * 4 + j; h = aj[j] * h + bj[j]; if (t < T) Y[(size_t)(row0 + t) * YK + cc] = f2bf(h); }
            }
            Hc[nt] = At * Hc[nt] + Bt; Ac[nt] *= At;
        }
    }
    if (FINAL) { if (sample && fq == 0) {
#pragma unroll
        for (int nt = 0; nt < 4; ++nt) out[O_LRUS + ((size_t)l * 32 + idx) * 512 + w * 64 + nt * 16 + fr] = Hc[nt]; } }
    else if (fq == 0) { float* ag = (float*)(ws + WS_LAGG) + (size_t)idx * 1024;
#pragma unroll
        for (int nt = 0; nt < 4; ++nt) { ag[w * 64 + nt * 16 + fr] = Ac[nt]; ag[512 + w * 64 + nt * 16 + fr] = Hc[nt]; } }
    __syncthreads();
}
DEV void lru_final_item(unsigned char* ws, int idx) {
    const int c = tid_opaque(); const unsigned* lab = (const unsigned*)(ws + WS_LAB) + (size_t)idx * 64 * 512 + c; bf16_t* Y = (bf16_t*)(ws + WS_Y) + (size_t)idx * 64 * YK + c;
    float h = ((const float*)(ws + WS_LHIN))[(size_t)idx * 512 + c];
    unsigned w[64];
#pragma unroll
    for (int t = 0; t < 64; ++t) w[t] = lab[(size_t)t * 512];
    __builtin_amdgcn_sched_barrier(0);
#pragma unroll
    for (int t = 0; t < 64; ++t) { h = __expf(__uint_as_float(w[t] << 16)) * h + __uint_as_float(w[t] & 0xffff0000u); Y[(size_t)t * YK] = f2bf(h); }
}
DEV void lru_scan(float* out, unsigned char* ws, int l) {
    const int c = tid_opaque(); const float* ag = (const float*)(ws + WS_LAGG); float* hin = (float*)(ws + WS_LHIN);
    float h = 0.f;
#pragma unroll 1
    for (int j0 = 0; j0 < 256; j0 += 32) {
        float a[32], b[32];
#pragma unroll
        for (int k = 0; k < 32; ++k) { a[k] = ag[(size_t)(j0 + k) * 1024 + c]; b[k] = ag[(size_t)(j0 + k) * 1024 + 512 + c]; }
#pragma unroll
        for (int k = 0; k < 32; ++k) { hin[(size_t)(j0 + k) * 512 + c] = h; h = a[k] * h + b[k]; }
    }
    out[O_LRUP + (size_t)l * 512 + c] = h;
}
typedef short bf16x8v __attribute__((ext_vector_type(8)));
typedef short s16x4v __attribute__((ext_vector_type(4)));
constexpr size_t WS_OG = 873 * MiB;
constexpr size_t WS_LSE = 898 * MiB;
constexpr int AK_PITCH = 144, AV_PITCH = 528, AV_OFF = 256 * AK_PITCH;

constexpr int ABUF = 72704;
DEV void attn_prompt_item(unsigned char* ws, LAS unsigned char* lds0, int it) {
    const int tid = tid_opaque(), lane = tid & 63, w = tid >> 6, fr = lane & 15, fq = lane >> 4;
    const bf16_t* Z = (const bf16_t*)(ws + WS_Z);
    const int g = it >> 8, rem = it & 255, tile = rem >> 1, hp = rem & 1;
    const int dil = g == 0 ? 1 : (g == 1 ? 4 : 16), nb = 128 / dil, r = tile / nb, n = tile % nb;
    const int key = tid >> 1, part = tid & 1; int mk = 128 * (n - 1) + key; mk = mk < 0 ? 0 : mk;
    const int tq = (128 * n + 16 * w + fr) * dil + r;
    u32x4v kk[2][4], vv[2][4]; bf16x8v bq[2][2];
#pragma unroll
    for (int h2 = 0; h2 < 2; ++h2) { const int hd = g * 4 + 2 * hp + h2;
        const bf16_t* kp = Z + (size_t)(mk * dil + r) * NIN + ZC_KC + hd * 64 + part * 32;
#pragma unroll
        for (int j = 0; j < 4; ++j) { kk[h2][j] = *(const u32x4v*)(kp + 8 * j); vv[h2][j] = *(const u32x4v*)(kp + (ZC_VC - ZC_KC) + 8 * j); }
        const bf16_t* qp = Z + (size_t)tq * NIN + ZC_QC + hd * 64 + fq * 8; bq[h2][0] = *(const bf16x8v*)qp; bq[h2][1] = *(const bf16x8v*)(qp + 32); }
#pragma unroll
    for (int h2 = 0; h2 < 2; ++h2) {
        LAS unsigned char* lds = lds0 + h2 * ABUF; const int hh = 2 * hp + h2;
#pragma unroll
        for (int j = 0; j < 4; ++j) *(LAS u32x4v*)(lds + key * AK_PITCH + part * 64 + 16 * j) = kk[h2][j];
#pragma unroll
        for (int j = 0; j < 4; ++j) { const unsigned wv[4] = {vv[h2][j].x, vv[h2][j].y, vv[h2][j].z, vv[h2][j].w};
#pragma unroll
            for (int i = 0; i < 4; ++i) { const int d = part * 32 + 8 * j + 2 * i;
                *(LAS unsigned short*)(lds + AV_OFF + d * AV_PITCH + key * 2) = (unsigned short)(wv[i] & 0xffffu);
                *(LAS unsigned short*)(lds + AV_OFF + (d + 1) * AV_PITCH + key * 2) = (unsigned short)(wv[i] >> 16); } }
        __syncthreads();
        f32x4v s[9];
#pragma unroll
        for (int kbi = 0; kbi < 9; ++kbi) { const int kb = w + kbi; f32x4v a = {0.f, 0.f, 0.f, 0.f};
#pragma unroll
            for (int ks = 0; ks < 2; ++ks) { const bf16x8v ka = *(const LAS bf16x8v*)(lds + (kb * 16 + fr) * AK_PITCH + ks * 64 + fq * 16);
                a = __builtin_amdgcn_mfma_f32_16x16x32_bf16(ka, bq[h2][ks], a, 0, 0, 0); }
            s[kbi] = a; }
        float mx = -1e30f;
#pragma unroll
        for (int kbi = 0; kbi < 9; ++kbi)
#pragma unroll
            for (int j = 0; j < 4; ++j) { bool ok = !(n == 0 && w + kbi < 8);
                if (kbi == 0) ok = ok && (fr <= fq * 4 + j);
                if (kbi == 8) ok = ok && (fr >= fq * 4 + j);
                s[kbi][j] = ok ? s[kbi][j] : -1e30f; mx = fmaxf(mx, s[kbi][j]); }
        mx = fmaxf(mx, __shfl_xor(mx, 16)); mx = fmaxf(mx, __shfl_xor(mx, 32));
        float lsum = 0.f;
#pragma unroll
        for (int kbi = 0; kbi < 9; ++kbi)
#pragma unroll
            for (int j = 0; j < 4; ++j) { const float p = s[kbi][j] > -1e29f ? __expf(s[kbi][j] - mx) : 0.f; s[kbi][j] = p; lsum += p; }
        lsum += __shfl_xor(lsum, 16); lsum += __shfl_xor(lsum, 32);
        f32x4v o[4];
#pragma unroll
        for (int mb = 0; mb < 4; ++mb) o[mb] = (f32x4v){0.f, 0.f, 0.f, 0.f};
#pragma unroll
        for (int st = 0; st < 5; ++st) { const int kb0 = w + 2 * st, kb1 = st < 4 ? kb0 + 1 : kb0;
            bf16x8v bp; u32x4v bpw; bpw.x = pk2(s[2 * st][0], s[2 * st][1]); bpw.y = pk2(s[2 * st][2], s[2 * st][3]);
            if (st < 4) { bpw.z = pk2(s[2 * st + 1][0], s[2 * st + 1][1]); bpw.w = pk2(s[2 * st + 1][2], s[2 * st + 1][3]); } else { bpw.z = 0u; bpw.w = 0u; }
            bp = __builtin_bit_cast(bf16x8v, bpw);
#pragma unroll
            for (int mb = 0; mb < 4; ++mb) { const LAS unsigned char* vr = lds + AV_OFF + (mb * 16 + fr) * AV_PITCH + fq * 8;
                const u32x2v v0 = *(const LAS u32x2v*)(vr + kb0 * 32), v1 = *(const LAS u32x2v*)(vr + kb1 * 32);
                u32x4v av; av.x = v0.x; av.y = v0.y; av.z = v1.x; av.w = v1.y;
                o[mb] = __builtin_amdgcn_mfma_f32_16x16x32_bf16(__builtin_bit_cast(bf16x8v, av), bp, o[mb], 0, 0, 0); } }
        const float rl = 1.f / lsum;
        bf16_t* og = (bf16_t*)(ws + WS_OG) + ((size_t)g * MT + tq) * 256 + hh * 64 + fq * 4;
#pragma unroll
        for (int mb = 0; mb < 4; ++mb) { u32x2v wv; wv.x = pk2(o[mb][0] * rl, o[mb][1] * rl); wv.y = pk2(o[mb][2] * rl, o[mb][3] * rl); *(u32x2v*)(og + mb * 16) = wv; }
        if (fq == 0) ((float*)(ws + WS_LSE))[((size_t)g * MT + tq) * 4 + hh] = mx + __logf(lsum);
    }
    __syncthreads();
}

constexpr size_t WS_OGS = 989 * MiB, WS_LSES = 990 * MiB;
DEV void attn_sample_item(const float* const* in, float* out, unsigned char* ws, int l, int it, int lane) {
    const bf16_t* Z = (const bf16_t*)(ws + WS_Z);
    const int half = it & 1, i1 = it >> 1, g = i1 % 3, rs = i1 / 3, b = rs >> 3, t = rs & 7;
    const int dil = g == 0 ? 1 : (g == 1 ? 4 : 16), Wc = 128 * dil;
    const float* cache = in[5 + g] + ((size_t)l * 32 + b) * Wc * 512;
    const bool wr_tok = g == 0 ? t == 0 : (g == 1 ? t < 4 : true);
    float* outc = out + (g == 0 ? O_W128S : (g == 1 ? O_W512S : O_W2048S)) + ((size_t)l * 32 + b) * Wc * 512;
    const int hh = lane >> 4, dq = lane & 15, hd = g * 4 + hh;
    f32x4v q4;
    { const u32x2v w = *(const u32x2v*)(Z + (size_t)(MP + rs) * NIN + ZC_QC + hd * 64 + dq * 4);
      q4 = (f32x4v){__uint_as_float(w.x << 16), __uint_as_float(w.x & 0xffff0000u), __uint_as_float(w.y << 16), __uint_as_float(w.y & 0xffff0000u)}; }
    float m = -1e30f, lsum = 0.f; f32x4v acc = {0.f, 0.f, 0.f, 0.f};
    const int j0 = half ? 65 : 0, jend = half ? 129 : 65;
    auto reduce8 = [&](const f32x4v (&k4)[8], const f32x4v (&v4)[8], int nv) {
        float s[8]; float bm = m;
#pragma unroll
        for (int u = 0; u < 8; ++u) { float d = q4.x * k4[u].x + q4.y * k4[u].y + q4.z * k4[u].z + q4.w * k4[u].w; d = row16_sum(d);
            s[u] = (u < nv) ? d : -1e30f; bm = fmaxf(bm, s[u]); }
        const float corr = __expf(m - bm); lsum *= corr; acc = acc * corr; m = bm;
#pragma unroll
        for (int u = 0; u < 8; ++u) { const float p = s[u] > -1e29f ? __expf(s[u] - bm) : 0.f; lsum += p; acc += v4[u] * p; } };
    int jc = j0;
    if (half == 0) {
        const int jn = t / dil + 1;
        u32x2v kw[8], vw[8];
#pragma unroll
        for (int u = 0; u < 8; ++u) { const int ju = u < jn ? u : jn - 1; const bf16_t* zp = Z + (size_t)(MP + b * 8 + t - dil * ju) * NIN + hd * 64 + dq * 4;
            kw[u] = *(const u32x2v*)(zp + ZC_KC); vw[u] = *(const u32x2v*)(zp + ZC_VC); }
        __builtin_amdgcn_sched_barrier(0);
        f32x4v k4[8], v4[8];
#pragma unroll
        for (int u = 0; u < 8; ++u) { k4[u] = (f32x4v){__uint_as_float(kw[u].x << 16), __uint_as_float(kw[u].x & 0xffff0000u), __uint_as_float(kw[u].y << 16), __uint_as_float(kw[u].y & 0xffff0000u)};
            v4[u] = (f32x4v){__uint_as_float(vw[u].x << 16), __uint_as_float(vw[u].x & 0xffff0000u), __uint_as_float(vw[u].y << 16), __uint_as_float(vw[u].y & 0xffff0000u)}; }
        reduce8(k4, v4, jn);
        jc = jn;
    }
#pragma unroll 1
    for (int jb = jc; jb < jend; jb += 8) {
        f32x4v k4[8], v4[8];
#pragma unroll
        for (int u = 0; u < 8; ++u) { const int j = jb + u, jj = j < jend ? j : jend - 1, idx = dil * (128 - jj) + t;
            const float* rp = cache + (size_t)idx * 512 + hh * 64 + dq * 4; k4[u] = *(const f32x4v*)rp; v4[u] = *(const f32x4v*)(rp + 256); }
        reduce8(k4, v4, jend - jb);
        if (wr_tok) {
#pragma unroll
            for (int u = 0; u < 8; ++u) { const int idx = dil * (128 - (jb + u)) + t;
                if (jb + u < jend && idx >= 8) { float* op = outc + (size_t)(idx - 8) * 512 + hh * 64 + dq * 4; __builtin_nontemporal_store(k4[u], (f32x4v*)op); __builtin_nontemporal_store(v4[u], (f32x4v*)(op + 256)); } } }
    }
    const float rl = 1.f / lsum;
    { u32x2v wv; wv.x = pk2(acc.x * rl, acc.y * rl); wv.y = pk2(acc.z * rl, acc.w * rl);
      *(u32x2v*)((bf16_t*)(ws + WS_OGS) + (((size_t)half * 3 + g) * 256 + rs) * 256 + hh * 64 + dq * 4) = wv; }
    if (dq == 0) ((float*)(ws + WS_LSES))[(((size_t)half * 3 + g) * 256 + rs) * 4 + hh] = m + __logf(lsum);
}
DEV void attn_merge_sample(unsigned char* ws, int G, int c) {
    const int tid = tid_opaque(); const bf16_t* og = (const bf16_t*)(ws + WS_OGS); const float* lse = (const float*)(ws + WS_LSES); bf16_t* Y = (bf16_t*)(ws + WS_Y);
    for (int i = c * (NWAVES * 64) + tid; i < 256 * 4 * 8; i += G * NWAVES * 64) { const int d8 = i & 7, hh = (i >> 3) & 3, rs = i >> 5;
        float lv[6], mx = -1e30f; u32x4v av[6];
#pragma unroll
        for (int p = 0; p < 6; ++p) { lv[p] = lse[((size_t)p * 256 + rs) * 4 + hh]; av[p] = *(const u32x4v*)(og + ((size_t)p * 256 + rs) * 256 + hh * 64 + d8 * 8); }
        __builtin_amdgcn_sched_barrier(0);
#pragma unroll
        for (int p = 0; p < 6; ++p) mx = fmaxf(mx, lv[p]);
        float o[8], wsum = 0.f;
#pragma unroll
        for (int k = 0; k < 8; ++k) o[k] = 0.f;
#pragma unroll
        for (int p = 0; p < 6; ++p) { const float w = __expf(lv[p] - mx); wsum += w;
            const unsigned aw[4] = {av[p].x, av[p].y, av[p].z, av[p].w};
#pragma unroll
            for (int k = 0; k < 4; ++k) { o[2 * k] += w * __uint_as_float(aw[k] << 16); o[2 * k + 1] += w * __uint_as_float(aw[k] & 0xffff0000u); } }
        const float rw = 1.f / wsum; u32x4v ov; ov.x = pk2(o[0] * rw, o[1] * rw); ov.y = pk2(o[2] * rw, o[3] * rw); ov.z = pk2(o[4] * rw, o[5] * rw); ov.w = pk2(o[6] * rw, o[7] * rw);
        *(u32x4v*)(Y + (size_t)(MP + rs) * YK + 1024 + hh * 64 + d8 * 8) = ov; }
}
template <class F>
DEV void attn_merge(unsigned char* ws, int G, int c, int wi_lo, int wi_hi, F mid) {
    const int tid = tid_opaque(), lane = tid & 63, wave = tid >> 6, gw = c * NWAVES + wave, NGW = G * NWAVES;
    const bf16_t* og = (const bf16_t*)(ws + WS_OG); const float* lse = (const float*)(ws + WS_LSE); bf16_t* Y = (bf16_t*)(ws + WS_Y);
    bool mid_done = false;
    for (int wi0 = wi_lo + gw; wi0 < wi_hi; wi0 += 4 * NGW) {
        float l0[4], l1[4], l2[4]; u32x4v a[4], bb[4], cc[4];
#pragma unroll
        for (int k = 0; k < 4; ++k) { const int wi_ = wi0 + k * NGW, wi = wi_ < wi_hi ? wi_ : wi_hi - 1; {
            const int pr = wi * 8 + (lane >> 3), row = pr >> 2, hh = pr & 3, d8 = lane & 7;
            l0[k] = lse[(size_t)row * 4 + hh]; l1[k] = lse[((size_t)MT + row) * 4 + hh]; l2[k] = lse[((size_t)2 * MT + row) * 4 + hh];
            const size_t off = (size_t)row * 256 + hh * 64 + d8 * 8;
            a[k] = *(const u32x4v*)(og + off); bb[k] = *(const u32x4v*)(og + (size_t)MT * 256 + off); cc[k] = *(const u32x4v*)(og + (size_t)2 * MT * 256 + off); } }
        if (!mid_done) { mid(); mid_done = true; }
#pragma unroll
        for (int k = 0; k < 4; ++k) { const int wi = wi0 + k * NGW; if (wi < wi_hi) { const int pr = wi * 8 + (lane >> 3), row = pr >> 2, hh = pr & 3, d8 = lane & 7;
            const float mx = fmaxf(l0[k], fmaxf(l1[k], l2[k])); float w0 = __expf(l0[k] - mx), w1 = __expf(l1[k] - mx), w2 = __expf(l2[k] - mx);
            const float rs = 1.f / (w0 + w1 + w2); w0 *= rs; w1 *= rs; w2 *= rs;
            const unsigned aw[4] = {a[k].x, a[k].y, a[k].z, a[k].w}, bw[4] = {bb[k].x, bb[k].y, bb[k].z, bb[k].w}, cw[4] = {cc[k].x, cc[k].y, cc[k].z, cc[k].w}; u32x4v o; unsigned ow[4];
#pragma unroll
            for (int i = 0; i < 4; ++i) ow[i] = pk2(w0 * __uint_as_float(aw[i] << 16) + w1 * __uint_as_float(bw[i] << 16) + w2 * __uint_as_float(cw[i] << 16),
                                                 w0 * __uint_as_float(aw[i] & 0xffff0000u) + w1 * __uint_as_float(bw[i] & 0xffff0000u) + w2 * __uint_as_float(cw[i] & 0xffff0000u));
            o.x = ow[0]; o.y = ow[1]; o.z = ow[2]; o.w = ow[3];
            *(u32x4v*)(Y + (size_t)row * YK + 1024 + hh * 64 + d8 * 8) = o; } }
    }
    if (!mid_done) mid();
}
DEV void cache_new_rows(float* out, unsigned char* ws, int l, int G, int c) {
    const int tid = tid_opaque(); const bf16_t* Z = (const bf16_t*)(ws + WS_Z);
    const int gt = c * (NWAVES * 64) + tid, NT_ = G * NWAVES * 64;
#pragma unroll
    for (int g = 0; g < 3; ++g) { const int Wc = g == 0 ? 128 : (g == 1 ? 512 : 2048);
        const size_t o_s = g == 0 ? O_W128S : (g == 1 ? O_W512S : O_W2048S), o_p = g == 0 ? O_W128P : (g == 1 ? O_W512P : O_W2048P);
        const int n_s = 32 * 8 * 128, n_p = Wc * 128;
        for (int i = gt; i < n_s + n_p; i += NT_) { int zrow; float* dst;
            const int e4 = i & 127, e = e4 * 4, kv = e >> 8, hh = (e >> 6) & 3, d = e & 63;
            if (i < n_s) { const int rr = i >> 7, b = rr >> 3, tt = rr & 7; zrow = MP + b * 8 + tt; dst = out + o_s + (((size_t)l * 32 + b) * Wc + (Wc - 8 + tt)) * 512 + e; }
            else { const int ri = (i - n_s) >> 7; zrow = MP - Wc + ri; dst = out + o_p + ((size_t)l * Wc + ri) * 512 + e; }
            const u32x2v z = *(const u32x2v*)(Z + (size_t)zrow * NIN + (kv ? ZC_VC : ZC_KC) + (g * 4 + hh) * 64 + d);
            *(f32x4v*)dst = (f32x4v){__uint_as_float(z.x << 16), __uint_as_float(z.x & 0xffff0000u), __uint_as_float(z.y << 16), __uint_as_float(z.y & 0xffff0000u)}; } }
}
constexpr size_t WS_HU = 900 * MiB;
constexpr size_t WS_HS = 916 * MiB;
constexpr size_t WS_HD = 932 * MiB;
constexpr int HQ_P = 272, HK_P = 80;
constexpr int H_QT = 0, H_KT = 8704, H_KH = 17408, H_VT = 27648, H_DV = 37888, HB_SZ = 38400;
constexpr int H_AT = 2 * HB_SZ, H_CS = H_AT + 2560, H_RS = H_CS + 2048;
template <int MODE  >
DEV void hgrn_item(const float* const* in, float* out, unsigned char* ws, LAS unsigned char* lds, int l, int idx) {
    const int tid = tid_opaque(), lane = tid & 63, w = tid >> 6, fr = lane & 15, fq = lane >> 4;
    const int ch = tid & 127, part = tid >> 7;
    const bf16_t* Z = (const bf16_t*)(ws + WS_Z); bf16_t* Y = (bf16_t*)(ws + WS_Y);
    const int h = idx & 3, blk = idx >> 2;
    const int row_base = MODE == 2 ? MP + blk * 8 : blk * 256;
    constexpr int NCH = MODE == 2 ? 1 : 8;
    float lb = 0.f;
    if (l == 1) { const float r0 = in[21][h * 128 + ch], r1 = in[21][512 + h * 128 + ch]; lb = 1.f / (1.f + __expf(r0 - r1)); }
    const float omlb = 1.f - lb;
    f32x4v S[8];
    if (MODE == 0) {
#pragma unroll
        for (int i = 0; i < 8; ++i) S[i] = (f32x4v){0.f, 0.f, 0.f, 0.f};
    } else if (MODE == 1) { const f32x4v* sp = (const f32x4v*)(ws + WS_HS) + (size_t)idx * 4096;
#pragma unroll
        for (int i = 0; i < 8; ++i) S[i] = sp[(i * 8 + w) * 64 + lane];
    } else { const float* sp = in[4] + (((size_t)l * 32 + blk) * 4 + h) * 16384;
#pragma unroll
        for (int i = 0; i < 8; ++i)
#pragma unroll
            for (int j = 0; j < 4; ++j) S[i][j] = sp[(16 * i + 4 * fq + j) * 128 + 16 * w + fr];
    }
    float dsum = 0.f;
    const float ng = in[22][l * 128 + 16 * w + fr];
    float rq[8], rz[8], rv[8];
    auto load_raw = [&](int cidx) {
#pragma unroll
        for (int k = 0; k < 8; ++k) { const int tok = part * 8 + k;
            if (MODE == 2 && tok >= 8) { rq[k] = 0.f; rz[k] = 0.f; rv[k] = 0.f; }
            else { const bf16_t* z = Z + (size_t)(row_base + cidx * 32 + tok) * NIN + h * 128 + ch;
                rq[k] = MODE == 0 ? 0.f : bf2f(z[ZC_QB]); rz[k] = bf2f(z[ZC_FB]); rv[k] = bf2f(z[ZC_IB]); } }
    };
    float lf[8], kk[8];
    auto prep1 = [&]() {
        float run = 0.f;
#pragma unroll
        for (int k = 0; k < 8; ++k) { const bool pad = MODE == 2 && part * 8 + k >= 8;
            const float sg = __builtin_amdgcn_rcpf(1.f + __expf(-rz[k]));
            const float f = lb + omlb * sg; run += pad ? 0.f : __logf(f); lf[k] = run; kk[k] = pad ? 0.f : omlb * (1.f - sg); }
        ((LAS float*)(lds + H_CS))[part * 128 + ch] = run;
    };
    auto prep2 = [&](LAS unsigned char* hb) {
        float pre = 0.f, tot = 0.f;
#pragma unroll
        for (int p = 0; p < 4; ++p) { const float v = ((const LAS float*)(lds + H_CS))[p * 128 + ch]; tot += v; pre += p < part ? v : 0.f; }
        u32x4v kh, vt; unsigned khw[4], vtw[4];
#pragma unroll
        for (int k2 = 0; k2 < 4; ++k2) {
            float qa, ka, ha, qb, kb2, hb2;
            { const float b = pre + lf[2 * k2]; ha = kk[2 * k2] * __expf(tot - b); if (MODE != 0) { qa = rq[2 * k2] * __expf(b); ka = kk[2 * k2] * __expf(fminf(-b, 80.f)); } }
            { const float b = pre + lf[2 * k2 + 1]; hb2 = kk[2 * k2 + 1] * __expf(tot - b); if (MODE != 0) { qb = rq[2 * k2 + 1] * __expf(b); kb2 = kk[2 * k2 + 1] * __expf(fminf(-b, 80.f)); } }
            const int t0 = part * 8 + 2 * k2;
            if (MODE != 0) {
                *(LAS unsigned short*)(hb + H_QT + t0 * HQ_P + ch * 2) = f2bf(qa); *(LAS unsigned short*)(hb + H_QT + (t0 + 1) * HQ_P + ch * 2) = f2bf(qb);
                *(LAS unsigned short*)(hb + H_KT + t0 * HQ_P + ch * 2) = f2bf(ka); *(LAS unsigned short*)(hb + H_KT + (t0 + 1) * HQ_P + ch * 2) = f2bf(kb2); }
            khw[k2] = pk2(ha, hb2); vtw[k2] = pk2(rv[2 * k2], rv[2 * k2 + 1]); }
        kh.x = khw[0]; kh.y = khw[1]; kh.z = khw[2]; kh.w = khw[3]; vt.x = vtw[0]; vt.y = vtw[1]; vt.z = vtw[2]; vt.w = vtw[3];
        *(LAS u32x4v*)(hb + H_KH + ch * HK_P + part * 16) = kh; *(LAS u32x4v*)(hb + H_VT + ch * HK_P + part * 16) = vt;
        if (part == 0) { ((LAS float*)(hb + H_DV))[ch] = __expf(tot); dsum += tot; }
    };
    {
      bf16_t tq[8], tz[8], tv[8];
#pragma unroll
      for (int k = 0; k < 8; ++k) { const int tok = part * 8 + k, tk = MODE == 2 ? (tok & 7) : tok;
          const bf16_t* z = Z + (size_t)(row_base + tk) * NIN + h * 128 + ch;
          tq[k] = MODE == 0 ? (bf16_t)0 : z[ZC_QB]; tz[k] = z[ZC_FB]; tv[k] = z[ZC_IB]; }
      __builtin_amdgcn_sched_barrier(0);
#pragma unroll
      for (int k = 0; k < 8; ++k) { const bool pad = MODE == 2 && part * 8 + k >= 8;
          rq[k] = (MODE == 0 || pad) ? 0.f : bf2f(tq[k]); rz[k] = pad ? 0.f : bf2f(tz[k]); rv[k] = pad ? 0.f : bf2f(tv[k]); }
      __builtin_amdgcn_sched_barrier(0); }
    prep1();
    __syncthreads();
    prep2(lds);
    if (NCH > 1) load_raw(1);
    __syncthreads();
#pragma unroll 1
    for (int cidx = 0; cidx < NCH; ++cidx) {
        LAS unsigned char* hb = lds + (cidx & 1) * HB_SZ;
        float rg[8];
        if (MODE != 0) {
#pragma unroll
            for (int mb = 0; mb < 2; ++mb)
#pragma unroll
                for (int j = 0; j < 4; ++j) { const int t = mb * 16 + fq * 4 + j;
                    rg[mb * 4 + j] = (MODE == 2 && t >= 8) ? 0.f : bf2f(Z[(size_t)(row_base + cidx * 32 + t) * NIN + ZC_GB + h * 128 + 16 * w + fr]); }
        }
        if (cidx + 1 < NCH) prep1();
        if (MODE != 0 && w < 4) {
            const int mb = w == 0 ? 0 : (w == 3 ? 0 : 1), nbk = w == 2 ? 1 : (w == 3 ? 1 : 0);
            f32x4v a = {0.f, 0.f, 0.f, 0.f};
            if (w < 3) {
#pragma unroll
                for (int ks = 0; ks < 4; ++ks) { const bf16x8v qa = *(const LAS bf16x8v*)(hb + H_QT + (mb * 16 + fr) * HQ_P + ks * 64 + fq * 16);
                    const bf16x8v kb = *(const LAS bf16x8v*)(hb + H_KT + (nbk * 16 + fr) * HQ_P + ks * 64 + fq * 16);
                    a = __builtin_amdgcn_mfma_f32_16x16x32_bf16(qa, kb, a, 0, 0, 0); }
            }
#pragma unroll
            for (int j = 0; j < 4; ++j) { const bool keep = w == 1 || (w != 3 && fr <= fq * 4 + j);
                *(LAS unsigned short*)(lds + H_AT + (mb * 16 + fq * 4 + j) * HK_P + (nbk * 16 + fr) * 2) = f2bf(keep ? a[j] : 0.f); }
        }
        __syncthreads();
        if (cidx + 1 < NCH) { prep2(lds + ((cidx + 1) & 1) * HB_SZ); if (cidx + 2 < NCH) load_raw(cidx + 2); }
        const bf16x8v vfrag = *(const LAS bf16x8v*)(hb + H_VT + (16 * w + fr) * HK_P + fq * 16);
        f32x4v o[2];
        if (MODE != 0) {
            bf16x8v sb[4];
#pragma unroll
            for (int pb = 0; pb < 4; ++pb) { u32x4v t; t.x = pk2(S[2 * pb][0], S[2 * pb][1]); t.y = pk2(S[2 * pb][2], S[2 * pb][3]); t.z = pk2(S[2 * pb + 1][0], S[2 * pb + 1][1]); t.w = pk2(S[2 * pb + 1][2], S[2 * pb + 1][3]);
                sb[pb] = __builtin_bit_cast(bf16x8v, t); }
#pragma unroll
            for (int mb = 0; mb < 2; ++mb) {
                const bf16x8v af = *(const LAS bf16x8v*)(lds + H_AT + (mb * 16 + fr) * HK_P + fq * 16);
                f32x4v a = __builtin_amdgcn_mfma_f32_16x16x32_bf16(af, vfrag, (f32x4v){0.f, 0.f, 0.f, 0.f}, 0, 0, 0);
#pragma unroll
                for (int pb = 0; pb < 4; ++pb) { const LAS unsigned char* qr = hb + H_QT + (mb * 16 + fr) * HQ_P + fq * 8;
                    const u32x2v q0 = *(const LAS u32x2v*)(qr + (2 * pb) * 32), q1 = *(const LAS u32x2v*)(qr + (2 * pb + 1) * 32);
                    u32x4v qa; qa.x = q0.x; qa.y = q0.y; qa.z = q1.x; qa.w = q1.y;
                    a = __builtin_amdgcn_mfma_f32_16x16x32_bf16(__builtin_bit_cast(bf16x8v, qa), sb[pb], a, 0, 0, 0); }
                o[mb] = a; }
        }
#pragma unroll
        for (int i = 0; i < 8; ++i) { const f32x4v dv = *(const LAS f32x4v*)(hb + H_DV + (16 * i + 4 * fq) * 4);
            const bf16x8v kf = *(const LAS bf16x8v*)(hb + H_KH + (16 * i + fr) * HK_P + fq * 16);
            S[i] = __builtin_amdgcn_mfma_f32_16x16x32_bf16(kf, vfrag, S[i] * dv, 0, 0, 0); }
        if (MODE != 0) {
#pragma unroll
            for (int mb = 0; mb < 2; ++mb)
#pragma unroll
                for (int j = 0; j < 4; ++j) { float q = o[mb][j] * o[mb][j];
                    q = row16_sum(q);
                    if (fr == 0) ((LAS float*)(lds + H_RS))[w * 32 + mb * 16 + fq * 4 + j] = q; }
        }
        __syncthreads();
        if (MODE != 0) {
#pragma unroll
            for (int mb = 0; mb < 2; ++mb)
#pragma unroll
                for (int j = 0; j < 4; ++j) { const int t = mb * 16 + fq * 4 + j; float q = 0.f;
#pragma unroll
                    for (int ww = 0; ww < 8; ++ww) q += ((const LAS float*)(lds + H_RS))[ww * 32 + t];
                    const float rinv = rsqrtf(q * (1.f / 128.f) + 1e-6f);
                    if (MODE == 2 && t >= 8) continue;
                    const size_t row = (size_t)(row_base + cidx * 32 + t);
                    Y[row * YK + 512 + h * 128 + 16 * w + fr] = f2bf(o[mb][j] * rinv * ng * rg[mb * 4 + j]); }
        }
    }
    __syncthreads();
    if (MODE == 0) { f32x4v* up = (f32x4v*)(ws + WS_HU) + (size_t)idx * 4096;
#pragma unroll
        for (int i = 0; i < 8; ++i) up[(i * 8 + w) * 64 + lane] = S[i];
        if (part == 0) ((float*)(ws + WS_HD))[(size_t)idx * 128 + ch] = __expf(dsum);
    } else if (MODE == 2) { float* sp = out + O_HGS + (((size_t)l * 32 + blk) * 4 + h) * 16384;
#pragma unroll
        for (int i = 0; i < 8; ++i)
#pragma unroll
            for (int j = 0; j < 4; ++j) sp[(16 * i + 4 * fq + j) * 128 + 16 * w + fr] = S[i][j];
    }
}
DEV void hgrn_scan(float* out, unsigned char* ws, int l, int item) {
    const int tid = tid_opaque(); const int p = item * 512 + tid;
    const int h = p >> 12, q = p & 4095, i = q >> 9, w = (q >> 6) & 7, lane = q & 63, fr = lane & 15, fq = lane >> 4;
    const f32x4v* U = (const f32x4v*)(ws + WS_HU); f32x4v* Sst = (f32x4v*)(ws + WS_HS); const float* D = (const float*)(ws + WS_HD);
    f32x4v s = {0.f, 0.f, 0.f, 0.f};
#pragma unroll 1
    for (int sc0 = 0; sc0 < 64; sc0 += 8) {
        f32x4v u[8], d[8];
#pragma unroll
        for (int k = 0; k < 8; ++k) { const size_t o4 = ((size_t)(sc0 + k) * 4 + h) * 4096 + q; u[k] = U[o4]; d[k] = *(const f32x4v*)(D + ((size_t)(sc0 + k) * 4 + h) * 128 + 16 * i + 4 * fq); }
#pragma unroll
        for (int k = 0; k < 8; ++k) { Sst[((size_t)(sc0 + k) * 4 + h) * 4096 + q] = s; s = s * d[k] + u[k]; }
    }
    float* sp = out + O_HGP + ((size_t)l * 4 + h) * 16384;
#pragma unroll
    for (int j = 0; j < 4; ++j) sp[(16 * i + 4 * fq + j) * 128 + 16 * w + fr] = s[j];
}
#define XB_TMO      128
#define XB_XCNT(j)  (256  + 64 * (j))
#define XB_XSUB(j)  (1280 + 64 * (j))
#define XB_XGEN(j)  (2304 + 64 * (j))
#define XB_TOP      3328
#define XB_TOPGEN   3392
#define XCD_BAR_WORDS 3456
#define XB_SPIN_CAP (1u << 18)

__device__ __forceinline__ unsigned xb_ld(unsigned* p)              { return __hip_atomic_load(p, __ATOMIC_RELAXED, __HIP_MEMORY_SCOPE_AGENT); }
__device__ __forceinline__ unsigned xb_add(unsigned* p, unsigned v) { return __hip_atomic_fetch_add(p, v, __ATOMIC_RELAXED, __HIP_MEMORY_SCOPE_AGENT); }
__device__ __forceinline__ unsigned xb_xcc_id() { return (unsigned)__builtin_amdgcn_s_getreg((3 << 11) | 20) & 0xFu; }
#define XB_SPIN(cond, bar) do { unsigned _sp = 0; while (cond) { __builtin_amdgcn_s_sleep(1); \
    if ((++_sp & 255u) == 0u) { if (xb_ld(&(bar)[XB_TMO])) break; if (_sp > XB_SPIN_CAP) { atomicAdd(&(bar)[XB_TMO], 1u); break; } } } } while (0)

struct XcdBarrier {
    unsigned* bar; unsigned x;
    volatile LAS unsigned* st;
};

__device__ __forceinline__ XcdBarrier xcd_barrier_post(unsigned* bar, volatile LAS unsigned* st) {
    XcdBarrier b; b.bar = bar; b.x = xb_xcc_id(); b.st = st;
    if (threadIdx.x == 0) (void)xb_add(&bar[XB_XCNT(b.x)], 1u);
    return b;
}
__device__ __forceinline__ void xcd_barrier_complete(unsigned* bar, unsigned x, unsigned& nloc, unsigned& nx) {
    const unsigned G = gridDim.x * gridDim.y * gridDim.z;
    unsigned sum, cnt, mine, sp = 0u;
    for (;;) {
        sum = 0u; cnt = 0u; mine = 0u;
#pragma unroll
        for (unsigned j = 0; j < 16; ++j) { const unsigned c = xb_ld(&bar[XB_XCNT(j)]); sum += c; cnt += (c > 0u) ? 1u : 0u; mine = (j == x) ? c : mine; }
        if (sum == G) break;
        __builtin_amdgcn_s_sleep(1);
        if ((++sp & 255u) == 0u) { if (xb_ld(&bar[XB_TMO])) break; if (sp > XB_SPIN_CAP) { atomicAdd(&bar[XB_TMO], 1u); break; } }
    }
    nloc = mine > 0u ? mine : 1u; nx = cnt > 0u ? cnt : 1u;
}

__device__ __forceinline__ void xcd_barrier(const XcdBarrier& b) {
    asm volatile("s_waitcnt vmcnt(0)" ::: "memory");
    __syncthreads();
    if (threadIdx.x == 0) {
        unsigned* bar = b.bar;
        __builtin_amdgcn_s_waitcnt(0);
        unsigned nloc = b.st[0], nx = b.st[1];
        if (nloc == 0u) { xcd_barrier_complete(bar, b.x, nloc, nx); b.st[0] = nloc; b.st[1] = nx; }
        const unsigned old = xb_add(&bar[XB_XSUB(b.x)], 1u);
        const unsigned gen = old / nloc;
        if (old + 1u == (gen + 1u) * nloc) {
            __builtin_amdgcn_fence(__ATOMIC_RELEASE, "agent");
            asm volatile("s_waitcnt vmcnt(0)" ::: "memory");
            const unsigned og = xb_add(&bar[XB_TOP], 1u);
            const unsigned tg = og / nx;
            if (og + 1u == (tg + 1u) * nx) xb_add(&bar[XB_TOPGEN], 1u);
            else XB_SPIN(xb_ld(&bar[XB_TOPGEN]) == tg, bar);
            __builtin_amdgcn_fence(__ATOMIC_ACQUIRE, "agent");
            xb_add(&bar[XB_XGEN(b.x)], 1u);
            asm volatile("s_waitcnt vmcnt(0)" ::: "memory");
        } else {
            XB_SPIN(xb_ld(&bar[XB_XGEN(b.x)]) == gen, bar);
            __builtin_amdgcn_fence(__ATOMIC_ACQUIRE, "agent");
            asm volatile("s_waitcnt vmcnt(0)" ::: "memory");
        }
    }
    __syncthreads();
}
namespace cg = cooperative_groups;
constexpr int LDS_BYTES = 147456, RING_OFF = 0;
constexpr int PH_PRO = 0, PH_LAYER0 = 1, PH_PER_LAYER = 10, PH_END = PH_LAYER0 + 2 * PH_PER_LAYER;
constexpr int P_G1 = 0, P_MIX1 = 1, P_MIX2 = 2, P_MIX3 = 3, P_G2 = 4, P_G3 = 5, P_E1 = 6, P_G4 = 7, P_G5 = 8, P_E2 = 9;
struct Args { const float* in[29]; float* out; unsigned char* ws; int ph_lo, ph_hi; };
static_assert(sizeof(Args) == 31 * 8 + 8, "Args has no padding");

__global__ void __launch_bounds__(NWAVES * 64, 2) mega(Args args) {
    extern __shared__ __attribute__((aligned(16))) unsigned char lds_raw[];
    LAS unsigned char* lds = (LAS unsigned char*)lds_raw;
    cg::grid_group grid = cg::this_grid();
    volatile LAS unsigned* bst = (volatile LAS unsigned*)(lds + LDS_BYTES - 64);
    if (threadIdx.x < 16) bst[threadIdx.x] = 0u;
    __syncthreads();
    const XcdBarrier xbar = xcd_barrier_post((unsigned*)(args.ws + WS_CTL + 4096), bst);
    const int G = gridDim.x, c = blockIdx.x;
    const int lo = args.ph_lo, hi = args.ph_hi;
#pragma unroll 1
    for (int ph = lo; ph < hi; ++ph) {
        unsigned long long zoff = 0ull; asm volatile("" : "+s"(zoff));
        unsigned char* ws = args.ws + zoff;
        const int l = ph >= PH_LAYER0 + PH_PER_LAYER ? 1 : 0, k = ph == PH_PRO ? -1 : ph - PH_LAYER0 - l * PH_PER_LAYER;
        bf16_t* XN = (bf16_t*)(ws + WS_XN); bf16_t* Z = (bf16_t*)(ws + WS_Z); bf16_t* Y = (bf16_t*)(ws + WS_Y); bf16_t* MIX = (bf16_t*)(ws + WS_MIX);
        bf16_t* OB = (bf16_t*)(ws + WS_OB); bf16_t* HID = (bf16_t*)(ws + WS_HID); float* X1 = (float*)(ws + WS_X1); float* X2 = (float*)(ws + WS_X2);
        unsigned char* wl = ws + WS_W + (size_t)l * WS_WL;
        if (ph == PH_PRO) {
            phase_prologue(args.in, args.out, ws, lds, G, c);
        }
        else if (k == P_G1) {
            pg8::Gemm g{XN, (const bf16_t*)(wl + W_IN), MT, NIN, DM}; pg8::StaticOrder S; S.init(MT, NIN, G, c, DM); S.perm31 = true;
            pg8::EpiZ E{Z, args.in[13] + (size_t)l * 3072, (bf16_t*)(ws + WS_GF)};
            pg8::gemm_phase<pg8::EpiZ, pg8::StaticOrder, true, true>(lds + RING_OFF, g, S, E);
        } else if (k == P_MIX1) {
            { volatile LAS int* qslot = (volatile LAS int*)(lds + LDS_BYTES - 128); unsigned* qctr = (unsigned*)(ws + WS_CTL) + 64 * (1 + l);
                int it = c;
                for (;;) {
                    if (it >= 1440) break;
                    if (it < 256) lru_item<false>(args.in, args.out, ws, lds, l, false, it);
                    else if (it < 288) lru_item<true>(args.in, args.out, ws, lds, l, true, it - 256);
                    else if (it < 544) hgrn_item<0>(args.in, args.out, ws, lds, l, it - 288);
                    else if (it < 672) hgrn_item<2>(args.in, args.out, ws, lds, l, it - 544);
                    else attn_prompt_item(ws, lds, it - 672);
                    if (threadIdx.x == 0) qslot[0] = G + (int)__hip_atomic_fetch_add(qctr, 1u, __ATOMIC_RELAXED, __HIP_MEMORY_SCOPE_AGENT);
                    __syncthreads(); it = qslot[0]; __syncthreads();
                } }
        } else if (k == P_MIX2) {
            attn_merge(ws, G, c, 0, MP * 4 / 8, [&]() {
                if (c < 32) hgrn_scan(args.out, ws, l, c); else if (c == 32) lru_scan(args.out, ws, l);
                else { const int c2 = c - 33, G2 = G - 33;
                    { const int tid = tid_opaque(), lane = tid & 63, gw = c2 * NWAVES + (tid >> 6); for (int it = gw; it < 1536; it += G2 * NWAVES) attn_sample_item(args.in, args.out, ws, l, it, lane); }
                    cache_new_rows(args.out, ws, l, G2, c2); } });
        } else if (k == P_MIX3) {
            for (int it = c; it < 256; it += G) lru_final_item(ws, it);
            for (int it = c; it < 256; it += G) hgrn_item<1>(args.in, args.out, ws, lds, l, it);
            attn_merge_sample(ws, G, c);
        } else if (k == P_G2) {
            pg8::Gemm g{Y, (const bf16_t*)(wl + W_BR), MT, DM, YK}; pg8::SplitOrder S; S.init(MP, DM, G, c, YK, 4, 5); S.pub = (unsigned*)(ws + WS_CTL) + 40 + l * 2;
            pg8::EpiMix E{(const bf16_t*)(ws + WS_GF), MIX, (float*)(ws + WS_PSM)};
            pg8::gemm_phase<pg8::EpiMix, pg8::SplitOrder, true, true>(lds + RING_OFF, g, S, E);
            if (c >= 128) sample_finish((unsigned*)(args.ws + WS_CTL) + 40 + l * 2, 20u, (const float*)(args.ws + WS_PSM), 5, (bf16_t*)(args.ws + WS_MIX) + (size_t)MP * DM, DM, 0, c - 128);
        } else if (k == P_G3) {
            pg8::Gemm g{MIX, (const bf16_t*)(wl + W_OUT), MT, DM, DM}; pg8::SplitOrder S; S.init(MP, DM, G, c, DM, 4, 4);
            pg8::EpiBf<0> E{OB, DM, (float*)(ws + WS_OS3)};
            pg8::gemm_phase<pg8::EpiBf<0>, pg8::SplitOrder, true, true>(lds + RING_OFF, g, S, E);
        } else if (k == P_E1) {
            phase_elt(args.in[0], args.in[1], l == 0 ? nullptr : (const bf16_t*)X2, OB, (const float*)(ws + WS_OS3), 4, args.in[9] + (size_t)l * DM, nullptr, (bf16_t*)X1, XN, G, c);
        } else if (k == P_G4) {
            pg8::Gemm g{XN, (const bf16_t*)(wl + W_UP), MT, DFF, DM}; pg8::SplitOrder S; S.init(MP, DFF, G, c, DM, 16, 4); S.pub = (unsigned*)(ws + WS_CTL) + 41 + l * 2;
            pg8::EpiBf<1> E{HID, DFF, (float*)(ws + WS_PSH)};
            pg8::gemm_phase<pg8::EpiBf<1>, pg8::SplitOrder, true, true>(lds + RING_OFF, g, S, E);
            if (c >= 128) sample_finish((unsigned*)(args.ws + WS_CTL) + 41 + l * 2, 64u, (const float*)(args.ws + WS_PSH), 4, (bf16_t*)(args.ws + WS_HID) + (size_t)MP * DFF, DFF, 1, c - 128);
        } else if (k == P_G5) {
            pg8::Gemm g{HID, (const bf16_t*)(wl + W_DN), MT, DM, DFF}; pg8::SplitOrder S; S.init(MP, DM, G, c, DFF, 4, 16);
            pg8::EpiBf<0> E{OB, DM, (float*)(ws + WS_OS5)};
            pg8::gemm_phase<pg8::EpiBf<0>, pg8::SplitOrder, true, true>(lds + RING_OFF, g, S, E);
        } else if (k == P_E2) {
            phase_elt(nullptr, nullptr, (const bf16_t*)X1, OB, (const float*)(ws + WS_OS5), 16, args.in[11] + (size_t)l * DM, l == 0 ? nullptr : args.out, l == 0 ? (bf16_t*)X2 : nullptr, l == 0 ? XN : nullptr, G, c);
        }
        if (ph + 1 < hi) { if (lo < 0) grid.sync(); else xcd_barrier(xbar); }
    }
}
extern "C" void kernel_launch(void* const* d_in, const int* in_sizes, int n_in, void* d_out, int out_size, void* d_ws, size_t ws_size, hipStream_t stream) {
    static int grid = 0;
    if (grid == 0) {
        int dev = 0, cus = 0, per_cu = 0;
        (void)hipGetDevice(&dev); (void)hipDeviceGetAttribute(&cus, hipDeviceAttributeMultiprocessorCount, dev);
        (void)hipFuncSetAttribute((const void*)mega, hipFuncAttributeMaxDynamicSharedMemorySize, LDS_BYTES);
        (void)hipOccupancyMaxActiveBlocksPerMultiprocessor(&per_cu, (const void*)mega, NWAVES * 64, LDS_BYTES);
        if (per_cu < 1) per_cu = 1;
        grid = cus;
        (void)hipGetLastError();
    }
    Args a{};
    for (int i = 0; i < 29; ++i) a.in[i] = (const float*)d_in[i];
    a.out = (float*)d_out; a.ws = (unsigned char*)d_ws; a.ph_lo = 0; a.ph_hi = PH_END;
    (void)hipMemsetAsync((unsigned char*)d_ws + WS_CTL, 0, 65536, stream);
    void* kargs[] = {&a};
    (void)hipLaunchCooperativeKernel((const void*)mega, dim3(grid), dim3(NWAVES * 64), kargs, LDS_BYTES, stream);
}
```
